# Optimizing an MI355X kernel written in HIP

```python
import math
import jax, jax.numpy as jnp
from jax import lax
import numpy as np

D_MODEL = 1024
BATCH = 8
SEQ = 4096
DEPTH = 4
DEC_BATCH = 8
DEC_SEQ = 16
PAST_LEN = 2048

CHUNK = 64
EPS = 1e-6
N_AB = (DEPTH + 1) // 2
N_C = DEPTH // 2
DN_HEADS = 8
DN_DK = 64
DN_DV = 64
CONV_W = 4
DN_QKV = DN_HEADS * (2 * DN_DK + DN_DV)
GLA_HEADS = 8
GLA_DK = 32
GLA_DV = 64
GLA_RANK = 16
GLA_NORMALIZER = 16.0
AB_SIZES = (DN_HEADS * DN_DK, DN_HEADS * DN_DK, DN_HEADS * DN_DV,
            DN_HEADS, DN_HEADS, DN_HEADS * DN_DV,
            GLA_HEADS * GLA_DK, GLA_HEADS * GLA_DK, GLA_HEADS * GLA_DV,
            GLA_RANK, GLA_HEADS * GLA_DV)
AB_IN = sum(AB_SIZES)
AB_MIX = DN_HEADS * DN_DV + GLA_HEADS * GLA_DV
C_HEADS = 16
C_HD = 64
C_BAND_CHUNKS = 8
C_PAST = C_BAND_CHUNKS * CHUNK
C_BAND = C_PAST + CHUNK
MAX_REL = 128
D_FF = ((8 * D_MODEL // 3 + 255) // 256) * 256

kernel_name = 'hybrid_streaming_gdn_gla_chunkattn_step'


def _rmsnorm(x, g):
    xf = x.astype(jnp.float32)
    y = xf * lax.rsqrt(jnp.mean(xf * xf, axis=-1, keepdims=True) + EPS)
    return (y * g.astype(jnp.float32)).astype(x.dtype)


def _l2norm(x):
    return x * lax.rsqrt(jnp.sum(x * x, axis=-1, keepdims=True) + EPS)


def _split(x, sizes):
    return jnp.split(x, [int(s) for s in np.cumsum(sizes)[:-1]], axis=-1)


def _causal_conv(x, buf, w):
    L = x.shape[1]
    xp = jnp.concatenate([buf.astype(x.dtype), x], axis=1)
    y = xp[:, 0:L] * w[0]
    for i in range(1, CONV_W):
        y = y + xp[:, i:i + L] * w[i]
    return jax.nn.silu(y), xp[:, L:]


def _chunks(x, c):
    b, l, h = x.shape[:3]
    x = x.reshape((b, l // c, c, h) + tuple(x.shape[3:]))
    return jnp.moveaxis(x, (1, 3), (0, 2))


def _unchunks(o):
    n, b, h, c, d = o.shape
    return jnp.moveaxis(o, (0, 2), (1, 3)).reshape(b, n * c, h, d)


def _gated_delta(q, k, v, g, beta, s0):
    L = q.shape[1]
    c = min(CHUNK, L)
    causal = jnp.tril(jnp.ones((c, c), dtype=bool))
    strict = jnp.tril(jnp.ones((c, c), dtype=bool), -1)
    eye = jnp.eye(c, dtype=jnp.float32)

    def step(s, inp):
        qc, kc, vc, gc, bc = inp
        gcum = jnp.cumsum(gc, axis=-1)
        decay = jnp.exp(jnp.where(causal, gcum[..., :, None] - gcum[..., None, :], -jnp.inf))
        kb = kc * bc[..., None]
        a = jnp.where(strict, jnp.einsum('bhid,bhjd->bhij', kb, kc) * decay, 0.0)
        rhs = jnp.concatenate([vc * bc[..., None], kb * jnp.exp(gcum)[..., None]], axis=-1)
        sol = lax.linalg.triangular_solve(eye + a, rhs, left_side=True, lower=True)
        dv = vc.shape[-1]
        u, wk = sol[..., :dv], sol[..., dv:]
        v_new = u - jnp.einsum('bhcd,bhde->bhce', wk, s)
        o = (jnp.einsum('bhcd,bhde->bhce', qc * jnp.exp(gcum)[..., None], s)
             + jnp.einsum('bhij,bhje->bhie', jnp.einsum('bhid,bhjd->bhij', qc, kc) * decay, v_new))
        glast = gcum[..., -1:]
        s = (s * jnp.exp(glast)[..., None]
             + jnp.einsum('bhcd,bhce->bhde', kc * jnp.exp(glast - gcum)[..., None], v_new))
        return s, o

    xs = (_chunks(q, c), _chunks(k, c), _chunks(v, c), _chunks(g, c), _chunks(beta, c))
    s, o = lax.scan(step, s0.astype(jnp.float32), xs)
    return _unchunks(o), s


def _gla(q, k, v, gk, s0):
    L = q.shape[1]
    c = min(CHUNK, L)
    causal = jnp.tril(jnp.ones((c, c), dtype=bool))

    def step(s, inp):
        qc, kc, vc, gc = inp
        b = jnp.cumsum(gc, axis=2)
        o_inter = jnp.einsum('bhcd,bhde->bhce', qc * jnp.exp(b), s)
        diff = b[:, :, :, None, :] - b[:, :, None, :, :]
        decay = jnp.exp(jnp.where(causal[:, :, None], diff, -jnp.inf))
        a = jnp.einsum('bhid,bhjd,bhijd->bhij', qc, kc, decay)
        o = o_inter + jnp.einsum('bhij,bhje->bhie', a, vc)
        blast = b[:, :, -1:, :]
        s = (s * jnp.exp(blast[:, :, 0, :])[..., None]
             + jnp.einsum('bhcd,bhce->bhde', kc * jnp.exp(blast - b), vc))
        return s, o

    xs = (_chunks(q, c), _chunks(k, c), _chunks(v, c), _chunks(gk, c))
    s, o = lax.scan(step, s0.astype(jnp.float32), xs)
    return _unchunks(o), s


def _ab_mixer(h, conv_buf, dn_s0, gla_s0, w_in, conv_w, a_log, dt_bias, dn_onorm,
              gk_w2, gk_b, gla_onorm, w_out):
    B, L, _ = h.shape
    f32 = jnp.float32
    proj = h @ w_in
    qkv_raw, dn_a, dn_b, dn_gate, gla_q, gla_k, gla_v, gla_lr, gla_gate = _split(
        proj, (DN_QKV,) + AB_SIZES[3:])
    qkv, conv_new = _causal_conv(qkv_raw, conv_buf, conv_w)
    dq, dk, dv = _split(qkv, (DN_HEADS * DN_DK, DN_HEADS * DN_DK, DN_HEADS * DN_DV))
    q = _l2norm(dq.reshape(B, L, DN_HEADS, DN_DK).astype(f32)) * (DN_DK ** -0.5)
    k = _l2norm(dk.reshape(B, L, DN_HEADS, DN_DK).astype(f32))
    v = dv.reshape(B, L, DN_HEADS, DN_DV).astype(f32)
    beta = jax.nn.sigmoid(dn_b.astype(f32))
    g = -jnp.exp(a_log.astype(f32)) * jax.nn.softplus(dn_a.astype(f32) + dt_bias.astype(f32))
    o_dn, dn_s = _gated_delta(q, k, v, g, beta, dn_s0)
    o_dn = _rmsnorm(o_dn, dn_onorm) * jax.nn.silu(dn_gate.reshape(B, L, DN_HEADS, DN_DV).astype(f32))
    q2 = gla_q.reshape(B, L, GLA_HEADS, GLA_DK).astype(f32) * (GLA_DK ** -0.5)
    k2 = gla_k.reshape(B, L, GLA_HEADS, GLA_DK).astype(f32)
    v2 = gla_v.reshape(B, L, GLA_HEADS, GLA_DV).astype(f32)
    glog = jax.nn.log_sigmoid((gla_lr @ gk_w2 + gk_b).astype(f32)) / GLA_NORMALIZER
    glog = glog.reshape(B, L, GLA_HEADS, GLA_DK)
    o_gla, gla_s = _gla(q2, k2, v2, glog, gla_s0)
    o_gla = _rmsnorm(o_gla, gla_onorm) * jax.nn.silu(gla_gate.reshape(B, L, GLA_HEADS, GLA_DV).astype(f32))
    o = jnp.concatenate([o_dn.reshape(B, L, -1), o_gla.reshape(B, L, -1)], axis=-1).astype(h.dtype)
    return o @ w_out, conv_new, dn_s, gla_s


def _rel_bias(table, rel):
    return table[:, jnp.clip(rel, -MAX_REL, MAX_REL) + MAX_REL].astype(jnp.float32)


def _band_attn_prompt(q, k, v, table):
    B, L, H, hd = q.shape
    n = L // CHUNK
    zpad = jnp.zeros((B, C_PAST, H, hd), k.dtype)
    kp = jnp.concatenate([zpad, k], axis=1)
    vp = jnp.concatenate([zpad, v], axis=1)
    qi = jnp.arange(CHUNK)
    kj = jnp.arange(C_BAND)
    bias = _rel_bias(table, qi[:, None] + C_PAST - kj[None, :])
    qc = jnp.moveaxis(q.reshape(B, n, CHUNK, H, hd), 1, 0)

    def one(args):
        c, qb = args
        kb = lax.dynamic_slice_in_dim(kp, c * CHUNK, C_BAND, axis=1)
        vb = lax.dynamic_slice_in_dim(vp, c * CHUNK, C_BAND, axis=1)
        valid = (c * CHUNK - C_PAST + kj) >= 0
        s = jnp.einsum('bqhd,bkhd->bhqk', qb, kb).astype(jnp.float32) * (hd ** -0.5) + bias
        p = jax.nn.softmax(jnp.where(valid, s, -jnp.inf), axis=-1).astype(vb.dtype)
        return jnp.einsum('bhqk,bkhd->bqhd', p, vb)

    o = lax.map(one, (jnp.arange(n), qc))
    return jnp.moveaxis(o, 0, 1).reshape(B, L, H * hd)


def _band_attn_sample(q, k, v, k_cache, v_cache, table):
    B, L, H, hd = q.shape
    nc = k_cache.shape[1]
    kk = jnp.concatenate([k_cache.astype(k.dtype), k], axis=1)
    vv = jnp.concatenate([v_cache.astype(v.dtype), v], axis=1)
    qpos = PAST_LEN + jnp.arange(L)
    kpos = jnp.concatenate([PAST_LEN - nc + jnp.arange(nc), PAST_LEN + jnp.arange(L)])
    bias = _rel_bias(table, qpos[:, None] - kpos[None, :])
    qch = qpos // CHUNK
    kch = kpos // CHUNK
    valid = (kch[None, :] <= qch[:, None]) & (kch[None, :] >= qch[:, None] - C_BAND_CHUNKS)
    s = jnp.einsum('bqhd,bkhd->bhqk', q, kk).astype(jnp.float32) * (hd ** -0.5) + bias
    p = jax.nn.softmax(jnp.where(valid, s, -jnp.inf), axis=-1).astype(vv.dtype)
    return jnp.einsum('bhqk,bkhd->bqhd', p, vv).reshape(B, L, H * hd)


def _swiglu(h, w_gu, w_down):
    gate, up = jnp.split(h @ w_gu, 2, axis=-1)
    return (jax.nn.silu(gate) * up) @ w_down


def _trunk(x, conv0, dn0, gla0, ck, cv, w, prompt):
    B, L, _ = x.shape
    convs, dns, glas, ks, vs = [], [], [], [], []
    for layer in range(DEPTH):
        i = layer // 2
        if layer % 2 == 0:
            h = _rmsnorm(x, w['ab_norm'][i])
            y, cb, sd, sg = _ab_mixer(h, conv0[i], dn0[i], gla0[i], w['ab_w_in'][i], w['dn_conv_w'][i],
                                      w['dn_a_log'][i], w['dn_dt_bias'][i], w['dn_out_norm'][i],
                                      w['gla_gk_w2'][i], w['gla_gk_b'][i], w['gla_out_norm'][i],
                                      w['ab_w_out'][i])
            convs.append(cb)
            dns.append(sd)
            glas.append(sg)
        else:
            h = _rmsnorm(x, w['c_norm'][i])
            q, k, v = jnp.split(h @ w['c_w_qkv'][i], 3, axis=-1)
            q = q.reshape(B, L, C_HEADS, C_HD)
            k = k.reshape(B, L, C_HEADS, C_HD)
            v = v.reshape(B, L, C_HEADS, C_HD)
            if prompt:
                o = _band_attn_prompt(q, k, v, w['c_rel_bias'][i])
                rows = min(C_PAST, L)
                ks.append(k[:, L - rows:])
                vs.append(v[:, L - rows:])
            else:
                o = _band_attn_sample(q, k, v, ck[i], cv[i], w['c_rel_bias'][i])
                ks.append(k)
                vs.append(v)
            y = o.astype(x.dtype) @ w['c_w_out'][i]
        x = x + y.astype(x.dtype)
        x = x + _swiglu(_rmsnorm(x, w['ffn_norm'][layer]), w['ffn_w_gu'][layer],
                        w['ffn_w_down'][layer]).astype(x.dtype)
    y_out = _rmsnorm(x, w['final_norm'])
    dt = x.dtype
    return (y_out, jnp.stack(convs).astype(dt), jnp.stack(dns).astype(dt), jnp.stack(glas).astype(dt),
            jnp.stack(ks).astype(dt), jnp.stack(vs).astype(dt))


def setup_inputs(seed: int = 0) -> dict:
    key = jax.random.key(seed)
    ks = jax.random.split(key, 32)
    f32 = jnp.float32

    def nrm(k, shape, scale):
        return scale * jax.random.normal(k, shape, f32)

    c_rows = min(C_PAST, PAST_LEN)
    dt = jnp.exp(jax.random.uniform(ks[10], (N_AB, DN_HEADS), f32, math.log(1e-3), math.log(1e-1)))
    return {
        'x_prompt': nrm(ks[0], (BATCH, SEQ, D_MODEL), 1.0),
        'x_sample': nrm(ks[1], (DEC_BATCH, DEC_SEQ, D_MODEL), 1.0),
        'state_dn_conv': nrm(ks[2], (N_AB, DEC_BATCH, CONV_W - 1, DN_QKV), 1.0),
        'state_dn': nrm(ks[3], (N_AB, DEC_BATCH, DN_HEADS, DN_DK, DN_DV), 0.5),
        'state_gla': nrm(ks[4], (N_AB, DEC_BATCH, GLA_HEADS, GLA_DK, GLA_DV), 1.0),
        'cache_c_k': nrm(ks[5], (N_C, DEC_BATCH, c_rows, C_HEADS, C_HD), 1.0),
        'cache_c_v': nrm(ks[6], (N_C, DEC_BATCH, c_rows, C_HEADS, C_HD), 1.0),
        'ab_norm': 1.0 + nrm(ks[7], (N_AB, D_MODEL), 0.01),
        'ab_w_in': nrm(ks[8], (N_AB, D_MODEL, AB_IN), D_MODEL ** -0.5),
        'dn_conv_w': nrm(ks[9], (N_AB, CONV_W, DN_QKV), CONV_W ** -0.5),
        'dn_a_log': jnp.log(jax.random.uniform(ks[11], (N_AB, DN_HEADS), f32, 1.0, 16.0)),
        'dn_dt_bias': dt + jnp.log(-jnp.expm1(-dt)),
        'dn_out_norm': 1.0 + nrm(ks[12], (N_AB, DN_DV), 0.01),
        'gla_gk_w2': nrm(ks[13], (N_AB, GLA_RANK, GLA_HEADS * GLA_DK), GLA_RANK ** -0.5),
        'gla_gk_b': nrm(ks[14], (N_AB, GLA_HEADS * GLA_DK), 0.1),
        'gla_out_norm': 1.0 + nrm(ks[15], (N_AB, GLA_DV), 0.01),
        'ab_w_out': nrm(ks[16], (N_AB, AB_MIX, D_MODEL), AB_MIX ** -0.5),
        'c_norm': 1.0 + nrm(ks[17], (N_C, D_MODEL), 0.01),
        'c_w_qkv': nrm(ks[18], (N_C, D_MODEL, 3 * C_HEADS * C_HD), D_MODEL ** -0.5),
        'c_rel_bias': nrm(ks[19], (N_C, C_HEADS, 2 * MAX_REL + 1), 0.5),
        'c_w_out': nrm(ks[20], (N_C, C_HEADS * C_HD, D_MODEL), (C_HEADS * C_HD) ** -0.5),
        'ffn_norm': 1.0 + nrm(ks[21], (DEPTH, D_MODEL), 0.01),
        'ffn_w_gu': nrm(ks[22], (DEPTH, D_MODEL, 2 * D_FF), D_MODEL ** -0.5),
        'ffn_w_down': nrm(ks[23], (DEPTH, D_FF, D_MODEL), D_FF ** -0.5),
        'final_norm': 1.0 + nrm(ks[24], (D_MODEL,), 0.01),
    }


def reference(x_prompt, x_sample, state_dn_conv, state_dn, state_gla, cache_c_k, cache_c_v,
              ab_norm, ab_w_in, dn_conv_w, dn_a_log, dn_dt_bias, dn_out_norm, gla_gk_w2, gla_gk_b,
              gla_out_norm, ab_w_out, c_norm, c_w_qkv, c_rel_bias, c_w_out, ffn_norm, ffn_w_gu,
              ffn_w_down, final_norm):
    w = {'ab_norm': ab_norm, 'ab_w_in': ab_w_in, 'dn_conv_w': dn_conv_w, 'dn_a_log': dn_a_log,
         'dn_dt_bias': dn_dt_bias, 'dn_out_norm': dn_out_norm, 'gla_gk_w2': gla_gk_w2,
         'gla_gk_b': gla_gk_b, 'gla_out_norm': gla_out_norm, 'ab_w_out': ab_w_out, 'c_norm': c_norm,
         'c_w_qkv': c_w_qkv, 'c_rel_bias': c_rel_bias, 'c_w_out': c_w_out, 'ffn_norm': ffn_norm,
         'ffn_w_gu': ffn_w_gu, 'ffn_w_down': ffn_w_down, 'final_norm': final_norm}
    B = x_prompt.shape[0]
    conv0 = jnp.zeros((N_AB, B, CONV_W - 1, DN_QKV), x_prompt.dtype)
    dn0 = jnp.zeros((N_AB, B, DN_HEADS, DN_DK, DN_DV), jnp.float32)
    gla0 = jnp.zeros((N_AB, B, GLA_HEADS, GLA_DK, GLA_DV), jnp.float32)
    y_prompt, conv_p, dn_p, gla_p, ck_p, cv_p = _trunk(x_prompt, conv0, dn0, gla0, None, None, w, True)
    y_sample, conv_s, dn_s, gla_s, ck_s, cv_s = _trunk(x_sample, state_dn_conv, state_dn, state_gla,
                                                       cache_c_k, cache_c_v, w, False)
    return (y_prompt, y_sample, conv_p, conv_s, dn_p, dn_s, gla_p, gla_s, ck_p, ck_s, cv_p, cv_s)
```

```cpp
#include <hip/hip_runtime.h>
#include <hip/hip_cooperative_groups.h>
#include <cstdio>
#include <cstdint>
namespace cg = cooperative_groups;

#ifndef MK_MULTI
#define MK_MULTI 0
#endif

#define LAS __attribute__((address_space(3)))
#define GAS __attribute__((address_space(1)))
typedef unsigned short bf16_t;
typedef short bf16x8 __attribute__((ext_vector_type(8)));
typedef float f32x2 __attribute__((ext_vector_type(2)));
typedef float f32x4 __attribute__((ext_vector_type(4)));
typedef float f32x16 __attribute__((ext_vector_type(16)));
typedef unsigned u32x2 __attribute__((ext_vector_type(2)));
typedef unsigned u32x4 __attribute__((ext_vector_type(4)));

constexpr int DM = 1024, NB = 8, SEQ = 4096, SB = 8, SSEQ = 16, PAST = 2048;
constexpr int TP = NB * SEQ;
constexpr int TS = SB * SSEQ;
constexpr int TR = TP + TS;
constexpr int ABIN = 3616, ABPAD = 3840, DFF = 2816, NGU = 5632, NQKV = 3072, DNQKV = 1536;
constexpr float EPS = 1e-6f;
constexpr float LOG2E = 1.4426950408889634f;

constexpr size_t O_Y = 0;
constexpr size_t O_CONVP = (size_t)TR * DM;
constexpr size_t O_CONVS = O_CONVP + 2 * 8 * 3 * 1536;
constexpr size_t O_DNP = O_CONVS + 2 * 8 * 3 * 1536;
constexpr size_t O_DNS = O_DNP + 2 * 8 * 8 * 64 * 64;
constexpr size_t O_GLAP = O_DNS + 2 * 8 * 8 * 64 * 64;
constexpr size_t O_GLAS = O_GLAP + 2 * 8 * 8 * 32 * 64;
constexpr size_t O_CKP = O_GLAS + 2 * 8 * 8 * 32 * 64;
constexpr size_t O_CKS = O_CKP + (size_t)2 * 8 * 512 * 1024;
constexpr size_t O_CVP = O_CKS + 2 * 8 * 16 * 1024;
constexpr size_t O_CVS = O_CVP + (size_t)2 * 8 * 512 * 1024;
constexpr size_t O_END = O_CVS + 2 * 8 * 16 * 1024;

constexpr size_t SZ_WIN = (size_t)ABPAD * 1024 * 2, SZ_W1K = (size_t)1024 * 1024 * 2, SZ_WQKV = (size_t)NQKV * 1024 * 2, SZ_WGU = (size_t)NGU * 1024 * 2, SZ_WDN = (size_t)1024 * DFF * 2;
constexpr size_t WS_WIN = 0;
constexpr size_t WS_WOUT = WS_WIN + 2 * SZ_WIN;
constexpr size_t WS_WQKV = WS_WOUT + 2 * SZ_W1K;
constexpr size_t WS_WCOUT = WS_WQKV + 2 * SZ_WQKV;
constexpr size_t WS_WGU = WS_WCOUT + 2 * SZ_W1K;
constexpr size_t WS_WDN = WS_WGU + 4 * SZ_WGU;
constexpr size_t WS_XB = WS_WDN + 4 * SZ_WDN;
constexpr size_t WS_R1 = WS_XB + (size_t)TR * 1024 * 2;
constexpr size_t WS_MIX = WS_R1 + (size_t)TR * ABIN * 2;
constexpr size_t WS_GATES = WS_MIX + (size_t)TR * 1024 * 2;
constexpr size_t WS_SSP = WS_GATES + (size_t)TR * 32 * 4;
constexpr size_t WS_END = WS_SSP + (size_t)TR * 16 * 4;

constexpr int LDS_BYTES = 147456;
constexpr int NPHASE = 22;

struct Params { const float* in[25]; float* out; unsigned char* ws; int ph_lo, ph_hi; };

__device__ __forceinline__ unsigned f2bf(float f) { unsigned u = __builtin_bit_cast(unsigned, f); return (u + 0x7fffu + ((u >> 16) & 1u)) >> 16; }
__device__ __forceinline__ unsigned pk2(float lo, float hi) { return f2bf(lo) | (f2bf(hi) << 16); }
__device__ __forceinline__ float bf2f(bf16_t b) { return __builtin_bit_cast(float, ((unsigned)b) << 16); }
__device__ __forceinline__ float wave_sum(float v) {
#pragma unroll
    for (int o = 1; o < 64; o <<= 1) v += __shfl_xor(v, o);
    return v;
}
__device__ __forceinline__ float silu_f(float x) { return x / (1.0f + __expf(-x)); }
__device__ __forceinline__ float sigmoid_f(float x) { return 1.0f / (1.0f + __expf(-x)); }
__device__ __forceinline__ float softplus_f(float x) { return fmaxf(x, 0.f) + log1pf(__expf(-fabsf(x))); }

namespace pg8 {
constexpr int BM = 256, BK = 64, HALF = 128, HTB = HALF * BK * 2, STAGE_BYTES = 8 * HTB, NXCD = 8, WGM = 8;
__host__ __device__ __forceinline__ int lds_byte(int r, int c) { const int st = (r >> 4) * 2 + (c >> 5), rr = r & 15, cc = c & 31, ob = rr * 64 + cc * 2; return st * 1024 + (ob ^ (((ob >> 9) & 1) << 5)); }
__host__ __device__ __forceinline__ void stage_rc(int b, int& R, int& C) { const int st = b / 1024, sb = b % 1024, swz = sb ^ (((sb >> 9) & 1) << 5); R = (st >> 1) * 16 + swz / 64; C = (st & 1) * 32 + (swz % 64) / 2; }
__host__ __device__ __forceinline__ int perm32(int rho) { const int n = rho >> 4, i = rho & 15; return 8 * (i >> 2) + 4 * n + (i & 3); }
struct Unit { int pm, pn; };
struct Gemm { const bf16_t* A; const bf16_t* Bt; int M, N, K; };
struct StaticOrder {
    int nM, nN, nwg, G, c;
    __host__ __device__ void init(int M, int N, int G_, int c_) { nM = M / BM; nN = N / BM; nwg = nM * nN; G = G_; c = c_; }
    __host__ __device__ bool next(int i, Unit& u) const {
        const long L = (long)i * G + c; if (L >= nwg) return false;
        int wgid = (int)L; { const int q = nwg / NXCD, r = nwg % NXCD, xcd = wgid % NXCD, off = wgid / NXCD; wgid = (xcd < r ? xcd * (q + 1) : r * (q + 1) + (xcd - r) * q) + off; }
        const int nig = WGM * nN, gid = wgid / nig, fm = gid * WGM, gsz = (nM - fm) < WGM ? (nM - fm) : WGM;
        u.pm = fm + ((wgid % nig) % gsz); u.pn = (wgid % nig) / gsz; return true;
    }
};

template <class Epi, bool ALIGN_EPI, bool SP2>
__device__ __forceinline__ void gemm_phase(LAS unsigned char* lds, const Gemm g, const StaticOrder& S, const Epi& E, const int tid) {
    const int wid = __builtin_amdgcn_readfirstlane(tid >> 6), lane = tid & 63, wr = wid >> 2, wc = wid & 3, fr = lane & 15, fq = lane >> 4;
    const int K = g.K, nt = K / BK;
    unsigned voffA[2], voffB[2];
#pragma unroll
    for (int i = 0; i < 2; ++i) { int R, C; stage_rc(tid * 16 + i * 8192, R, C); voffA[i] = (unsigned)(R * K + C) * 2u; voffB[i] = (unsigned)(R * K + C) * 2u; }
    const size_t kstep = (size_t)(BK * 2);
    const size_t hstep = (size_t)HALF * K * 2;
    const size_t tstep = 2 * hstep;
    const unsigned ldsw = (unsigned)wid * 1024u;
    const int aoff = lds_byte(wr * 64 + fr, fq * 8), boff = lds_byte(wc * 32 + fr, fq * 8);
#define PG8_SA(b, h) (((b) * 2 + (h)) * HTB)
#define PG8_SB(b, h) ((4 + (b) * 2 + (h)) * HTB)
#define PG8_STAGE(bufoff, gbase, voff) do { _Pragma("unroll") for (int _i = 0; _i < 2; ++_i) \
        __builtin_amdgcn_global_load_lds((const unsigned*)((const char*)(gbase) + (voff)[_i]), (LAS unsigned*)(lds + (bufoff) + ldsw + _i * 8192), 16, 0, 0); } while (0)
#define PG8_LDA(dst, b, h) do { _Pragma("unroll") for (int m = 0; m < 4; ++m) _Pragma("unroll") for (int k = 0; k < 2; ++k) dst[m][k] = *(const LAS bf16x8*)(lds + PG8_SA(b, h) + aoff + m * 2048 + k * 1024); } while (0)
#define PG8_LDB(dst, b, h) do { _Pragma("unroll") for (int n = 0; n < 2; ++n) _Pragma("unroll") for (int k = 0; k < 2; ++k) dst[n][k] = *(const LAS bf16x8*)(lds + PG8_SB(b, h) + boff + n * 2048 + k * 1024); } while (0)
#define PG8_MMA(ai, bj, At, Bt) do { __builtin_amdgcn_s_setprio(1); _Pragma("unroll") for (int m = 0; m < 4; ++m) _Pragma("unroll") for (int n = 0; n < 2; ++n) _Pragma("unroll") for (int k = 0; k < 2; ++k) \
        acc[ai][bj][m][n] = __builtin_amdgcn_mfma_f32_16x16x32_bf16(Bt[n][k], At[m][k], acc[ai][bj][m][n], 0, 0, 0); __builtin_amdgcn_s_setprio(0); } while (0)
#define PG8_WAIT_V(n) asm volatile("s_waitcnt vmcnt(" #n ")" ::: "memory")
#define PG8_WAIT_L(n) asm volatile("s_waitcnt lgkmcnt(" #n ")" ::: "memory")
#define PG8_BAR __builtin_amdgcn_s_barrier()
#define PG8_SCHED __builtin_amdgcn_sched_barrier(0)
    Unit cur, nxt; int ui = 0;
    if (!S.next(0, cur)) return;
    f32x4 acc[2][2][4][2];
#pragma unroll
    for (int a = 0; a < 2; ++a)
#pragma unroll
        for (int b = 0; b < 2; ++b)
#pragma unroll
            for (int m = 0; m < 4; ++m)
#pragma unroll
                for (int n = 0; n < 2; ++n) acc[a][b][m][n] = (f32x4){0.f, 0.f, 0.f, 0.f};
    bf16x8 At[4][2], B0[2][2], B1[2][2];
    const char* cA = (const char*)g.A + (size_t)cur.pm * tstep; const char* cB = (const char*)g.Bt + (size_t)cur.pn * tstep;
    if constexpr (SP2) {
        PG8_STAGE(PG8_SB(0, 0), cB, voffB); PG8_STAGE(PG8_SB(0, 1), cB + hstep, voffB); PG8_STAGE(PG8_SA(0, 0), cA, voffA); PG8_STAGE(PG8_SA(0, 1), cA + hstep, voffA);
        if (wr == 1) PG8_BAR;
        PG8_WAIT_V(2); PG8_BAR;
        PG8_STAGE(PG8_SB(1, 0), cB + kstep, voffB); PG8_STAGE(PG8_SA(1, 0), cA + kstep, voffA); PG8_STAGE(PG8_SB(1, 1), cB + hstep + kstep, voffB);
        PG8_WAIT_V(6); PG8_BAR;
    } else {
        PG8_STAGE(PG8_SB(0, 0), cB, voffB); PG8_STAGE(PG8_SA(0, 0), cA, voffA); PG8_STAGE(PG8_SB(0, 1), cB + hstep, voffB); PG8_STAGE(PG8_SA(0, 1), cA + hstep, voffA);
        if (wr == 1) PG8_BAR;
        PG8_WAIT_V(4); PG8_BAR;
        PG8_STAGE(PG8_SB(1, 0), cB + kstep, voffB); PG8_STAGE(PG8_SA(1, 0), cA + kstep, voffA); PG8_STAGE(PG8_SB(1, 1), cB + hstep + kstep, voffB);
        PG8_WAIT_V(6); PG8_BAR;
    }
    for (;;) {
        const bool has_next = S.next(ui + 1, nxt);
        const char* nA = has_next ? (const char*)g.A + (size_t)nxt.pm * tstep : cA; const char* nB = has_next ? (const char*)g.Bt + (size_t)nxt.pn * tstep : cB;
        for (int t = 0; t < nt; t += 2) {
            const bool last = (t == nt - 2);
            const char* a1 = cA + (size_t)(t + 1) * kstep;
            const char* a2 = last ? nA : cA + (size_t)(t + 2) * kstep; const char* b2 = last ? nB : cB + (size_t)(t + 2) * kstep;
            const char* a3 = a2 + kstep; const char* b3 = b2 + kstep;
            if constexpr (SP2) {
            PG8_LDB(B0, 0, 0); PG8_LDB(B1, 0, 1); PG8_SCHED; PG8_LDA(At, 0, 0); PG8_STAGE(PG8_SA(1, 1), a1 + hstep, voffA);
            PG8_WAIT_V(8); PG8_WAIT_L(0); PG8_BAR; PG8_MMA(0, 0, At, B0); PG8_MMA(0, 1, At, B1); PG8_BAR; PG8_SCHED;
            PG8_LDA(At, 0, 1); PG8_STAGE(PG8_SB(0, 0), b2, voffB); PG8_STAGE(PG8_SB(0, 1), b2 + hstep, voffB); PG8_STAGE(PG8_SA(0, 0), a2, voffA);
            PG8_WAIT_V(8); PG8_WAIT_L(0); PG8_BAR; PG8_MMA(1, 0, At, B0); PG8_MMA(1, 1, At, B1); PG8_BAR; PG8_SCHED;
            PG8_LDB(B0, 1, 0); PG8_LDB(B1, 1, 1); PG8_SCHED; PG8_LDA(At, 1, 0); PG8_STAGE(PG8_SA(0, 1), a2 + hstep, voffA);
            PG8_WAIT_V(8); PG8_WAIT_L(0); PG8_BAR; PG8_MMA(0, 0, At, B0); PG8_MMA(0, 1, At, B1); PG8_BAR; PG8_SCHED;
            PG8_LDA(At, 1, 1); PG8_STAGE(PG8_SB(1, 0), b3, voffB); PG8_STAGE(PG8_SB(1, 1), b3 + hstep, voffB); PG8_STAGE(PG8_SA(1, 0), a3, voffA);
            PG8_WAIT_V(8); PG8_WAIT_L(0); PG8_BAR; PG8_MMA(1, 0, At, B0); PG8_MMA(1, 1, At, B1); PG8_BAR; PG8_SCHED;
            } else {
            PG8_LDB(B0, 0, 0); PG8_SCHED; PG8_LDA(At, 0, 0); PG8_STAGE(PG8_SA(1, 1), a1 + hstep, voffA);
            PG8_WAIT_L(8); PG8_BAR; PG8_WAIT_L(0); PG8_MMA(0, 0, At, B0); PG8_BAR; PG8_SCHED;
            PG8_LDB(B1, 0, 1); PG8_STAGE(PG8_SB(0, 0), b2, voffB);
            PG8_BAR; PG8_WAIT_L(0); PG8_MMA(0, 1, At, B1); PG8_BAR;
            PG8_LDA(At, 0, 1); PG8_STAGE(PG8_SA(0, 0), a2, voffA);
            PG8_BAR; PG8_WAIT_L(0); PG8_MMA(1, 0, At, B0); PG8_BAR; PG8_SCHED;
            PG8_STAGE(PG8_SB(0, 1), b2 + hstep, voffB);
            PG8_WAIT_V(6); PG8_BAR; PG8_MMA(1, 1, At, B1); PG8_BAR;
            PG8_LDB(B0, 1, 0); PG8_SCHED; PG8_LDA(At, 1, 0); PG8_STAGE(PG8_SA(0, 1), a2 + hstep, voffA);
            PG8_WAIT_L(8); PG8_BAR; PG8_WAIT_L(0); PG8_MMA(0, 0, At, B0); PG8_BAR; PG8_SCHED;
            PG8_LDB(B1, 1, 1); PG8_STAGE(PG8_SB(1, 0), b3, voffB);
            PG8_BAR; PG8_WAIT_L(0); PG8_MMA(0, 1, At, B1); PG8_BAR;
            PG8_LDA(At, 1, 1); PG8_STAGE(PG8_SA(1, 0), a3, voffA);
            PG8_BAR; PG8_WAIT_L(0); PG8_MMA(1, 0, At, B0); PG8_BAR; PG8_SCHED;
            PG8_STAGE(PG8_SB(1, 1), b3 + hstep, voffB);
            PG8_WAIT_V(6); PG8_BAR; PG8_MMA(1, 1, At, B1); PG8_BAR;
            }
        }
        if constexpr (ALIGN_EPI) { if (wr == 0) PG8_BAR; }
        E(acc, cur, wr, wc, fr, fq);
        if (!has_next) break;
#pragma unroll
        for (int a = 0; a < 2; ++a)
#pragma unroll
            for (int b = 0; b < 2; ++b)
#pragma unroll
                for (int m = 0; m < 4; ++m)
#pragma unroll
                    for (int n = 0; n < 2; ++n) acc[a][b][m][n] = (f32x4){0.f, 0.f, 0.f, 0.f};
        cur = nxt; cA = nA; cB = nB; ++ui;
        if constexpr (ALIGN_EPI) { if (wr == 1) PG8_BAR; }
    }
    PG8_WAIT_V(0);
    if constexpr (!ALIGN_EPI) { if (wr == 0) PG8_BAR; }
    PG8_BAR;
#undef PG8_SA
#undef PG8_SB
#undef PG8_STAGE
#undef PG8_LDA
#undef PG8_LDB
#undef PG8_MMA
#undef PG8_WAIT_V
#undef PG8_WAIT_L
#undef PG8_BAR
#undef PG8_SCHED
}
}

struct EpiArgs {
    GAS bf16_t* out; const GAS float* ssp; GAS float* gates; GAS float* o0; GAS float* o1; GAS float* o2; GAS float* o3;
    const GAS float* base_p; const GAS float* base_s; GAS float* X; GAS bf16_t* Xb; GAS float* ssp_out;
};
__device__ __forceinline__ float row_rstd(const GAS float* ssp, int row) {
    const GAS f32x4* p = (const GAS f32x4*)(ssp + (size_t)row * 16);
    const f32x4 a = p[0], b = p[1], c = p[2], d = p[3];
    const float s = ((a[0] + a[1]) + (a[2] + a[3])) + ((b[0] + b[1]) + (b[2] + b[3])) + ((c[0] + c[1]) + (c[2] + c[3])) + ((d[0] + d[1]) + (d[2] + d[3]));
    return rsqrtf(s * (1.0f / 1024.0f) + EPS);
}
template <int MODE, bool SMALL>
__device__ __forceinline__ float epi_apply(const EpiArgs& a, int row, int g32, int fq, f32x4 v0, f32x4 v1, float rstd) {
    const int c0 = 32 * g32 + 8 * fq;
    if constexpr (MODE == 0) {
        if (g32 >= ABIN / 32) return 0.f;
        v0 *= rstd; v1 *= rstd;
        u32x4 w; w.x = pk2(v0[0], v0[1]); w.y = pk2(v0[2], v0[3]); w.z = pk2(v1[0], v1[1]); w.w = pk2(v1[2], v1[3]);
        *(GAS u32x4*)(a.out + (size_t)row * ABIN + c0) = w;
        if (g32 == 48 && fq < 2) { GAS float* gp = a.gates + (size_t)row * 32 + 8 * fq; *(GAS f32x4*)gp = v0; *(GAS f32x4*)(gp + 4) = v1; }
        if (g32 == 96 && fq >= 2) { GAS float* gp = a.gates + (size_t)row * 32 + 16 + 8 * (fq - 2); *(GAS f32x4*)gp = v0; *(GAS f32x4*)(gp + 4) = v1; }
        if (c0 < DNQKV) {
            if constexpr (!SMALL) { const int t = row & (SEQ - 1), b = row >> 12; if (t >= SEQ - 3) { GAS float* d = a.o0 + (size_t)(b * 3 + (t - (SEQ - 3))) * DNQKV + c0; *(GAS f32x4*)d = v0; *(GAS f32x4*)(d + 4) = v1; } }
            else { const int r = row - TP, t = r & 15, b = r >> 4; if (t >= SSEQ - 3) { GAS float* d = a.o1 + (size_t)(b * 3 + (t - (SSEQ - 3))) * DNQKV + c0; *(GAS f32x4*)d = v0; *(GAS f32x4*)(d + 4) = v1; } }
        }
        return 0.f;
    } else if constexpr (MODE == 1) {
        v0 *= rstd; v1 *= rstd;
        u32x4 w; w.x = pk2(v0[0], v0[1]); w.y = pk2(v0[2], v0[3]); w.z = pk2(v1[0], v1[1]); w.w = pk2(v1[2], v1[3]);
        *(GAS u32x4*)(a.out + (size_t)row * NQKV + c0) = w;
        if (c0 >= 1024) {
            const int isv = c0 >= 2048, cc = c0 - 1024 - 1024 * isv;
            if constexpr (!SMALL) { const int t = row & (SEQ - 1), b = row >> 12; if (t >= SEQ - 512) { GAS float* d = a.o0 + (size_t)isv * (O_CVP - O_CKP) + (size_t)(b * 512 + (t - (SEQ - 512))) * 1024 + cc; *(GAS f32x4*)d = v0; *(GAS f32x4*)(d + 4) = v1; } }
            else { const int r = row - TP; GAS float* d = a.o2 + (size_t)isv * (O_CVS - O_CKS) + (size_t)r * 1024 + cc; *(GAS f32x4*)d = v0; *(GAS f32x4*)(d + 4) = v1; }
        }
        return 0.f;
    } else if constexpr (MODE == 2) {
        const GAS float* bp = SMALL ? a.base_s + (size_t)(row - TP) * DM + c0 : a.base_p + (size_t)row * DM + c0;
        const f32x4 x0 = *(const GAS f32x4*)bp + v0, x1 = *(const GAS f32x4*)(bp + 4) + v1;
        GAS float* xp = a.X + (size_t)row * DM + c0; *(GAS f32x4*)xp = x0; *(GAS f32x4*)(xp + 4) = x1;
        u32x4 w; w.x = pk2(x0[0], x0[1]); w.y = pk2(x0[2], x0[3]); w.z = pk2(x1[0], x1[1]); w.w = pk2(x1[2], x1[3]);
        *(GAS u32x4*)(a.Xb + (size_t)row * DM + c0) = w;
        return ((x0[0] * x0[0] + x0[1] * x0[1]) + (x0[2] * x0[2] + x0[3] * x0[3])) + ((x1[0] * x1[0] + x1[1] * x1[1]) + (x1[2] * x1[2] + x1[3] * x1[3]));
    } else {
        v0 *= rstd; v1 *= rstd;
        float h[4];
#pragma unroll
        for (int j = 0; j < 4; ++j) h[j] = silu_f(v0[j]) * v1[j];
        u32x2 w; w.x = pk2(h[0], h[1]); w.y = pk2(h[2], h[3]);
        *(GAS u32x2*)(a.out + (size_t)row * DFF + 16 * g32 + 4 * fq) = w;
        return 0.f;
    }
}
constexpr int EA_OFF = 131072 + 512;
__device__ __forceinline__ EpiArgs load_ea(const LAS unsigned long long* ap) {
    EpiArgs a;
    a.out = (GAS bf16_t*)ap[0]; a.ssp = (const GAS float*)ap[1]; a.gates = (GAS float*)ap[2]; a.o0 = (GAS float*)ap[3]; a.o1 = (GAS float*)ap[4]; a.o2 = (GAS float*)ap[5]; a.o3 = (GAS float*)ap[6];
    a.base_p = (const GAS float*)ap[7]; a.base_s = (const GAS float*)ap[8]; a.X = (GAS float*)ap[9]; a.Xb = (GAS bf16_t*)ap[10]; a.ssp_out = (GAS float*)ap[11];
    return a;
}
template <int MODE> struct Epi {
    const LAS unsigned long long* ap;
    __device__ __forceinline__ void operator()(const f32x4 (&acc)[2][2][4][2], const pg8::Unit& u, int wr, int wc, int fr, int fq) const {
        const EpiArgs a = load_ea(ap);
#pragma unroll
        for (int ai = 0; ai < 2; ++ai)
#pragma unroll
            for (int m = 0; m < 4; ++m) {
                const int row = u.pm * 256 + ai * 128 + wr * 64 + m * 16 + fr;
                float rstd = 1.f; if constexpr (MODE != 2) rstd = row_rstd(a.ssp, row);
                float ss = 0.f;
#pragma unroll
                for (int bj = 0; bj < 2; ++bj) { const int g32 = (u.pn * 256 + bj * 128 + wc * 32) >> 5; ss += epi_apply<MODE, false>(a, row, g32, fq, acc[ai][bj][m][0], acc[ai][bj][m][1], rstd); }
                if constexpr (MODE == 2) { ss += __shfl_xor(ss, 16); ss += __shfl_xor(ss, 32); if (fq == 0) a.ssp_out[(size_t)row * 16 + u.pn * 4 + wc] = ss; }
            }
    }
};

template <int MODE>
__device__ __forceinline__ void small_gemm(const bf16_t* A, const bf16_t* Bt, int Npos, int K, const LAS unsigned long long* eap, int gw, int ngw, int lane) {
    const int fr = lane & 15, fq = lane >> 4, ncg = Npos / 64, nunits = (TS / 16) * ncg;
    for (int u = gw; u < nunits; u += ngw) {
        const int rb = u % (TS / 16), cgp = u / (TS / 16), r0 = TP + rb * 16, p0 = cgp * 64;
        f32x4 acc[4];
#pragma unroll
        for (int f = 0; f < 4; ++f) acc[f] = (f32x4){0.f, 0.f, 0.f, 0.f};
        const bf16_t* ap = A + (size_t)(r0 + fr) * K + 8 * fq;
        const bf16_t* bp = Bt + (size_t)(p0 + fr) * K + 8 * fq;
#pragma unroll 4
        for (int k0 = 0; k0 < K; k0 += 32) {
            const bf16x8 av = *(const bf16x8*)(ap + k0);
#pragma unroll
            for (int f = 0; f < 4; ++f) { const bf16x8 wv = *(const bf16x8*)(bp + (size_t)(16 * f) * K + k0); acc[f] = __builtin_amdgcn_mfma_f32_16x16x32_bf16(wv, av, acc[f], 0, 0, 0); }
        }
        const int row = r0 + fr;
        const EpiArgs a = load_ea(eap);
        float rstd = 1.f; if constexpr (MODE != 2) rstd = row_rstd(a.ssp, row);
        float ss = 0.f;
#pragma unroll
        for (int gq = 0; gq < 2; ++gq) ss += epi_apply<MODE, true>(a, row, (p0 >> 5) + gq, fq, acc[2 * gq], acc[2 * gq + 1], rstd);
        if constexpr (MODE == 2) { ss += __shfl_xor(ss, 16); ss += __shfl_xor(ss, 32); if (fq == 0) a.ssp_out[(size_t)row * 16 + cgp] = ss; }
    }
}

__device__ __forceinline__ void transpose_item(const float* W, int K, int Nsrc, int gu, const float* gamma, bf16_t* WT, LAS float* scr, int item, int npb, int lane) {
    const int kb = item / npb, nb = item % npb, k0 = 64 * kb, p0 = 32 * nb;
    const int cl = p0 + pg8::perm32(lane & 31);
    int src = cl; if (gu) src = ((cl >> 2) & 1) * DFF + 4 * (cl >> 3) + (cl & 3);
    const bool valid = src < Nsrc;
#pragma unroll 8
    for (int i = 0; i < 32; ++i) { const int kk = 2 * i + (lane >> 5); float v = 0.f; if (valid) { v = W[(size_t)(k0 + kk) * Nsrc + src]; if (gamma) v *= gamma[k0 + kk]; } scr[kk * 33 + (lane & 31)] = v; }
    asm volatile("s_waitcnt lgkmcnt(0)" ::: "memory");
    const int c = lane & 7;
#pragma unroll
    for (int j = 0; j < 4; ++j) { const int n = (lane >> 3) + 8 * j; const LAS float* s = scr + (8 * c) * 33 + n;
        u32x4 o; o.x = pk2(s[0 * 33], s[1 * 33]); o.y = pk2(s[2 * 33], s[3 * 33]); o.z = pk2(s[4 * 33], s[5 * 33]); o.w = pk2(s[6 * 33], s[7 * 33]);
        *(u32x4*)(WT + (size_t)(p0 + n) * K + k0 + 8 * c) = o; }
    asm volatile("s_waitcnt lgkmcnt(0)" ::: "memory");
}
__device__ __forceinline__ void convert_matrix(const float* W, int K, int Nsrc, int Npos, int gu, const float* gamma, bf16_t* WT, LAS float* scr, int gw, int ngw, int lane) {
    const int npb = Npos / 32, nitems = (K / 64) * npb;
    for (int it = gw; it < nitems; it += ngw) transpose_item(W, K, Nsrc, gu, gamma, WT, scr, it, npb, lane);
}
__device__ __forceinline__ void phase_prologue(const Params& P, LAS unsigned char* lds, int gw, int ngw, int wid, int lane) {
    LAS float* scr = (LAS float*)(lds + wid * 8704);
    unsigned char* ws = P.ws;
    for (int i = 0; i < 2; ++i) {
        convert_matrix(P.in[8] + (size_t)i * 1024 * ABIN, 1024, ABIN, ABPAD, 0, P.in[7] + i * 1024, (bf16_t*)(ws + WS_WIN + i * SZ_WIN), scr, gw, ngw, lane);
        convert_matrix(P.in[16] + (size_t)i * 1024 * 1024, 1024, 1024, 1024, 0, nullptr, (bf16_t*)(ws + WS_WOUT + i * SZ_W1K), scr, gw, ngw, lane);
        convert_matrix(P.in[18] + (size_t)i * 1024 * NQKV, 1024, NQKV, NQKV, 0, P.in[17] + i * 1024, (bf16_t*)(ws + WS_WQKV + i * SZ_WQKV), scr, gw, ngw, lane);
        convert_matrix(P.in[20] + (size_t)i * 1024 * 1024, 1024, 1024, 1024, 0, nullptr, (bf16_t*)(ws + WS_WCOUT + i * SZ_W1K), scr, gw, ngw, lane);
    }
    for (int l = 0; l < 4; ++l) {
        convert_matrix(P.in[22] + (size_t)l * 1024 * NGU, 1024, NGU, NGU, 1, P.in[21] + l * 1024, (bf16_t*)(ws + WS_WGU + l * SZ_WGU), scr, gw, ngw, lane);
        convert_matrix(P.in[23] + (size_t)l * DFF * 1024, DFF, 1024, 1024, 0, nullptr, (bf16_t*)(ws + WS_WDN + l * SZ_WDN), scr, gw, ngw, lane);
    }
    bf16_t* Xb = (bf16_t*)(ws + WS_XB); float* ssp = (float*)(ws + WS_SSP);
    for (int row = gw; row < TR; row += ngw) {
        const float* xr = (row < TP) ? P.in[0] + (size_t)row * DM : P.in[1] + (size_t)(row - TP) * DM;
        f32x4 v[4]; float s = 0.f;
#pragma unroll
        for (int j = 0; j < 4; ++j) { v[j] = ((const f32x4*)xr)[lane + 64 * j]; s += (v[j][0] * v[j][0] + v[j][1] * v[j][1]) + (v[j][2] * v[j][2] + v[j][3] * v[j][3]); }
        s = wave_sum(s);
#pragma unroll
        for (int j = 0; j < 4; ++j) { u32x2 w; w.x = pk2(v[j][0], v[j][1]); w.y = pk2(v[j][2], v[j][3]); ((u32x2*)(Xb + (size_t)row * DM))[lane + 64 * j] = w; }
        if (lane < 16) ssp[(size_t)row * 16 + lane] = (lane == 0) ? s : 0.f;
    }
}
__device__ __forceinline__ void phase_final(const Params& P, int gw, int ngw, int lane) {
    const GAS float* ssp = (const GAS float*)(P.ws + WS_SSP); const float* g = P.in[24];
    f32x4 gv[4];
#pragma unroll
    for (int j = 0; j < 4; ++j) gv[j] = ((const f32x4*)g)[lane + 64 * j];
    for (int row = gw; row < TR; row += ngw) {
        const float rstd = row_rstd(ssp, row);
        f32x4* xr = (f32x4*)(P.out + (size_t)row * DM);
#pragma unroll
        for (int j = 0; j < 4; ++j) { f32x4 v = xr[lane + 64 * j]; xr[lane + 64 * j] = v * rstd * gv[j]; }
    }
}

constexpr int MX_CH = 32;
__device__ __forceinline__ void delta_unit(const Params& P, LAS unsigned char* lds, int li, bool sample, int b, int h, const int tid) {
    const int lane = tid & 63, wid = __builtin_amdgcn_readfirstlane(tid >> 6);
    const int L = sample ? SSEQ : SEQ, rowbase = sample ? TP + b * SSEQ : b * SEQ;
    const bf16_t* PROJ = (const bf16_t*)(P.ws + WS_R1); const float* GATES = (const float*)(P.ws + WS_GATES); bf16_t* MIX = (bf16_t*)(P.ws + WS_MIX);
    const int NC = (L + MX_CH - 1) / MX_CH;
    constexpr int SET = 4 * 8192 + 256;
    const int e = (wid & 3) * 16 + (lane >> 2), dq = lane & 3;
    f32x2 S[8];
    float* sout = P.out + (sample ? O_DNS : O_DNP) + (size_t)((li * 8 + b) * 8 + h) * 4096;
    if (wid < 4) {
        if (sample) { const float* s0 = P.in[3] + (size_t)((li * 8 + b) * 8 + h) * 4096;
#pragma unroll
            for (int j = 0; j < 8; ++j) { S[j][0] = s0[(16 * dq + 2 * j) * 64 + e]; S[j][1] = s0[(16 * dq + 2 * j + 1) * 64 + e]; } }
        else {
#pragma unroll
            for (int j = 0; j < 8; ++j) S[j] = (f32x2){0.f, 0.f}; }
    }
    const int pw = wid - 4, c = lane;
    float cwq[4], cwk[4], cwv[4], onorm = 0.f, alog = 0.f, dtb = 0.f;
    if (wid >= 4) {
        const float* cw = P.in[9] + (size_t)li * 4 * DNQKV;
#pragma unroll
        for (int t = 0; t < 4; ++t) { cwq[t] = cw[t * DNQKV + h * 64 + c]; cwk[t] = cw[t * DNQKV + 512 + h * 64 + c]; cwv[t] = cw[t * DNQKV + 1024 + h * 64 + c]; }
        onorm = P.in[12][li * 64 + c]; alog = P.in[10][li * 8 + h]; dtb = P.in[11][li * 8 + h];
    }
    for (int j = 0; j < NC + 2; ++j) {
        if (wid >= 4) {
            if (j < NC) {
                LAS float* qs = (LAS float*)(lds + (j & 1) * SET); LAS float* ks = qs + 2048; LAS float* vs = qs + 4096; LAS float* sc = qs + 8192;
                const int t0 = j * MX_CH + pw * 8;
                if (t0 < L) {
                    float rq[11], rk[11], rv[11];
#pragma unroll
                    for (int r = 0; r < 11; ++r) {
                        const int t = t0 - 3 + r;
                        if (t >= 0) { const bf16_t* pr = PROJ + (size_t)(rowbase + t) * ABIN + h * 64 + c; rq[r] = bf2f(pr[0]); rk[r] = bf2f(pr[512]); rv[r] = bf2f(pr[1024]); }
                        else if (sample) { const float* cb = P.in[2] + (size_t)((li * 8 + b) * 3 + (3 + t)) * DNQKV + h * 64 + c; rq[r] = cb[0]; rk[r] = cb[512]; rv[r] = cb[1024]; }
                        else { rq[r] = 0.f; rk[r] = 0.f; rv[r] = 0.f; }
                    }
                    float ga = 0.f, gb = 0.f;
                    if (lane < 8) { const float* gp = GATES + (size_t)(rowbase + t0 + lane) * 32; ga = gp[h]; gb = gp[8 + h]; }
#pragma unroll
                    for (int i = 0; i < 8; ++i) {
                        float q = cwq[0] * rq[i] + cwq[1] * rq[i + 1] + cwq[2] * rq[i + 2] + cwq[3] * rq[i + 3];
                        float k = cwk[0] * rk[i] + cwk[1] * rk[i + 1] + cwk[2] * rk[i + 2] + cwk[3] * rk[i + 3];
                        float v = cwv[0] * rv[i] + cwv[1] * rv[i + 1] + cwv[2] * rv[i + 2] + cwv[3] * rv[i + 3];
                        q = silu_f(q); k = silu_f(k); v = silu_f(v);
                        const float sq = wave_sum(q * q), sk = wave_sum(k * k);
                        const int tok = pw * 8 + i;
                        qs[tok * 64 + c] = q * rsqrtf(sq + EPS) * 0.125f; ks[tok * 64 + c] = k * rsqrtf(sk + EPS); vs[tok * 64 + c] = v;
                    }
                    if (lane < 8) { const float g = -__expf(alog) * softplus_f(ga + dtb); sc[(pw * 8 + lane) * 2] = __expf(g); sc[(pw * 8 + lane) * 2 + 1] = sigmoid_f(gb); }
                }
            }
            if (j >= 2) {
                LAS float* os = (LAS float*)(lds + (j & 1) * SET) + 6144;
                const int t0 = (j - 2) * MX_CH + pw * 8;
                if (t0 < L) {
#pragma unroll
                    for (int i = 0; i < 8; ++i) {
                        const int tok = pw * 8 + i; const size_t row = (size_t)(rowbase + t0 + i);
                        const float o = os[tok * 64 + c]; const float ss = wave_sum(o * o);
                        const float gt = bf2f(PROJ[row * ABIN + 1552 + h * 64 + c]);
                        MIX[row * DM + h * 64 + c] = (bf16_t)f2bf(o * rsqrtf(ss * (1.0f / 64.0f) + EPS) * onorm * silu_f(gt));
                    }
                }
            }
        } else if (j >= 1 && j <= NC) {
            LAS float* qs = (LAS float*)(lds + ((j - 1) & 1) * SET); LAS float* ks = qs + 2048; LAS float* vs = qs + 4096; LAS float* os = qs + 6144; LAS float* sc = qs + 8192;
            const int ntok = min(MX_CH, L - (j - 1) * MX_CH);
            for (int tok = 0; tok < ntok; ++tok) {
                f32x4 kk[4], qq[4];
#pragma unroll
                for (int i = 0; i < 4; ++i) { kk[i] = *(const LAS f32x4*)(ks + tok * 64 + 16 * dq + 4 * i); qq[i] = *(const LAS f32x4*)(qs + tok * 64 + 16 * dq + 4 * i); }
                const float ve = vs[tok * 64 + e]; const f32x2 gb = *(const LAS f32x2*)(sc + tok * 2);
                const float eg = gb[0], beta = gb[1];
                f32x2 wa = (f32x2){0.f, 0.f};
#pragma unroll
                for (int i = 0; i < 4; ++i) { wa += (f32x2){kk[i][0], kk[i][1]} * S[2 * i]; wa += (f32x2){kk[i][2], kk[i][3]} * S[2 * i + 1]; }
                float w = wa[0] + wa[1]; w += __shfl_xor(w, 1); w += __shfl_xor(w, 2);
                const float dl = beta * (ve - eg * w);
                const f32x2 eg2 = (f32x2){eg, eg}, dl2 = (f32x2){dl, dl};
                f32x2 oa = (f32x2){0.f, 0.f};
#pragma unroll
                for (int i = 0; i < 4; ++i) {
                    S[2 * i] = S[2 * i] * eg2 + (f32x2){kk[i][0], kk[i][1]} * dl2; S[2 * i + 1] = S[2 * i + 1] * eg2 + (f32x2){kk[i][2], kk[i][3]} * dl2;
                    oa += (f32x2){qq[i][0], qq[i][1]} * S[2 * i]; oa += (f32x2){qq[i][2], qq[i][3]} * S[2 * i + 1];
                }
                float o = oa[0] + oa[1]; o += __shfl_xor(o, 1); o += __shfl_xor(o, 2);
                if (dq == 0) os[tok * 64 + e] = o;
            }
        }
        __syncthreads();
    }
    if (wid < 4) {
#pragma unroll
        for (int j = 0; j < 8; ++j) { sout[(16 * dq + 2 * j) * 64 + e] = S[j][0]; sout[(16 * dq + 2 * j + 1) * 64 + e] = S[j][1]; }
    }
}

__device__ __forceinline__ void gla_unit(const Params& P, LAS unsigned char* lds, int li, bool sample, int b, int h, const int tid) {
    const int lane = tid & 63, wid = __builtin_amdgcn_readfirstlane(tid >> 6);
    const int L = sample ? SSEQ : SEQ, rowbase = sample ? TP + b * SSEQ : b * SEQ;
    const bf16_t* PROJ = (const bf16_t*)(P.ws + WS_R1); const float* GATES = (const float*)(P.ws + WS_GATES); bf16_t* MIX = (bf16_t*)(P.ws + WS_MIX);
    const int NC = (L + MX_CH - 1) / MX_CH;
    constexpr int SET = 3 * 4096 + 2 * 8192;
    const int e = (wid & 3) * 16 + (lane >> 2), dq = lane & 3;
    f32x2 S[4];
    float* sout = P.out + (sample ? O_GLAS : O_GLAP) + (size_t)((li * 8 + b) * 8 + h) * 2048;
    if (wid < 4) {
        if (sample) { const float* s0 = P.in[4] + (size_t)((li * 8 + b) * 8 + h) * 2048;
#pragma unroll
            for (int j = 0; j < 4; ++j) { S[j][0] = s0[(8 * dq + 2 * j) * 64 + e]; S[j][1] = s0[(8 * dq + 2 * j + 1) * 64 + e]; } }
        else {
#pragma unroll
            for (int j = 0; j < 4; ++j) S[j] = (f32x2){0.f, 0.f}; }
    }
    const int pw = wid - 4, c = lane, c32 = lane & 31;
    float w2[16], gkb = 0.f, onorm = 0.f;
    if (wid >= 4) {
#pragma unroll
        for (int r = 0; r < 16; ++r) w2[r] = P.in[13][(size_t)(li * 16 + r) * 256 + h * 32 + c32];
        gkb = P.in[14][li * 256 + h * 32 + c32]; onorm = P.in[15][li * 64 + c];
    }
    for (int j = 0; j < NC + 2; ++j) {
        if (wid >= 4) {
            if (j < NC) {
                LAS float* qs = (LAS float*)(lds + (j & 1) * SET); LAS float* ks = qs + 1024; LAS float* gs = qs + 2048; LAS float* vs = qs + 3072;
                const int t0 = j * MX_CH + pw * 8;
                if (t0 < L) {
#pragma unroll
                    for (int i = 0; i < 8; ++i) {
                        const int tok = pw * 8 + i; const size_t row = (size_t)(rowbase + t0 + i);
                        const bf16_t* pr = PROJ + row * ABIN;
                        vs[tok * 64 + c] = bf2f(pr[2576 + h * 64 + c]);
                        const float* lr = GATES + row * 32 + 16;
                        float z = gkb;
#pragma unroll
                        for (int r = 0; r < 16; ++r) z += lr[r] * w2[r];
                        const float ls = -softplus_f(-z);
                        if (lane < 32) { qs[tok * 32 + c32] = bf2f(pr[2064 + h * 32 + c32]) * 0.17677669529663687f; ks[tok * 32 + c32] = bf2f(pr[2320 + h * 32 + c32]); gs[tok * 32 + c32] = __expf(ls * (1.0f / 16.0f)); }
                    }
                }
            }
            if (j >= 2) {
                LAS float* os = (LAS float*)(lds + (j & 1) * SET) + 3072 + 2048;
                const int t0 = (j - 2) * MX_CH + pw * 8;
                if (t0 < L) {
#pragma unroll
                    for (int i = 0; i < 8; ++i) {
                        const int tok = pw * 8 + i; const size_t row = (size_t)(rowbase + t0 + i);
                        const float o = os[tok * 64 + c]; const float ss = wave_sum(o * o);
                        const float gt = bf2f(PROJ[row * ABIN + 3104 + h * 64 + c]);
                        MIX[row * DM + 512 + h * 64 + c] = (bf16_t)f2bf(o * rsqrtf(ss * (1.0f / 64.0f) + EPS) * onorm * silu_f(gt));
                    }
                }
            }
        } else if (j >= 1 && j <= NC) {
            LAS float* qs = (LAS float*)(lds + ((j - 1) & 1) * SET); LAS float* ks = qs + 1024; LAS float* gs = qs + 2048; LAS float* vs = qs + 3072; LAS float* os = qs + 3072 + 2048;
            const int ntok = min(MX_CH, L - (j - 1) * MX_CH);
            for (int tok = 0; tok < ntok; ++tok) {
                f32x4 kk[2], qq[2], gg[2];
#pragma unroll
                for (int i = 0; i < 2; ++i) { kk[i] = *(const LAS f32x4*)(ks + tok * 32 + 8 * dq + 4 * i); qq[i] = *(const LAS f32x4*)(qs + tok * 32 + 8 * dq + 4 * i); gg[i] = *(const LAS f32x4*)(gs + tok * 32 + 8 * dq + 4 * i); }
                const float ve = vs[tok * 64 + e]; const f32x2 v2 = (f32x2){ve, ve};
                f32x2 oa = (f32x2){0.f, 0.f};
#pragma unroll
                for (int i = 0; i < 2; ++i) {
                    S[2 * i] = S[2 * i] * (f32x2){gg[i][0], gg[i][1]} + (f32x2){kk[i][0], kk[i][1]} * v2; S[2 * i + 1] = S[2 * i + 1] * (f32x2){gg[i][2], gg[i][3]} + (f32x2){kk[i][2], kk[i][3]} * v2;
                    oa += (f32x2){qq[i][0], qq[i][1]} * S[2 * i]; oa += (f32x2){qq[i][2], qq[i][3]} * S[2 * i + 1];
                }
                float o = oa[0] + oa[1]; o += __shfl_xor(o, 1); o += __shfl_xor(o, 2);
                if (dq == 0) os[tok * 64 + e] = o;
            }
        }
        __syncthreads();
    }
    if (wid < 4) {
#pragma unroll
        for (int j = 0; j < 4; ++j) { sout[(8 * dq + 2 * j) * 64 + e] = S[j][0]; sout[(8 * dq + 2 * j + 1) * 64 + e] = S[j][1]; }
    }
}

constexpr int AT_KOFF = 0, AT_VOFF = 2 * 9216, AT_TAB = 4 * 9216;
__device__ __forceinline__ int vpos(int kv) { return 16 * (kv >> 4) + 8 * ((kv >> 2) & 1) + 4 * ((kv >> 3) & 1) + (kv & 3); }
__device__ __forceinline__ void attn_prompt_unit(const Params& P, LAS unsigned char* lds, int li, int b, int h, int g4, const int tid) {
    const int lane = tid & 63, wid = __builtin_amdgcn_readfirstlane(tid >> 6), r32 = lane & 31, hi = lane >> 5;
    const bf16_t* QKV = (const bf16_t*)(P.ws + WS_R1); bf16_t* MIX = (bf16_t*)(P.ws + WS_MIX);
    const int cw = 4 * g4 + (wid >> 1);
    const size_t qrow = (size_t)b * SEQ + 256 * g4 + 32 * wid + r32;
    bf16x8 qr[4];
#pragma unroll
    for (int d0 = 0; d0 < 4; ++d0) qr[d0] = *(const bf16x8*)(QKV + qrow * NQKV + h * 64 + d0 * 16 + hi * 8);
    LAS float* tab = (LAS float*)(lds + AT_TAB);
    if (tid < 257) tab[tid] = P.in[19][(size_t)(li * 16 + h) * 257 + tid] * LOG2E;
    const int kt_lo = max(0, 4 * g4 - 8), kt_hi = 4 * g4 + 3;
    const int srow = tid >> 3, sch = tid & 7;
    const bf16_t* kvsrc = QKV + ((size_t)b * SEQ + srow) * NQKV + 1024 + h * 64 + 8 * sch;
    const int vp = vpos(srow);
    bf16x8 kreg, vreg;
#define AT_LOAD(kt) do { const bf16_t* s_ = kvsrc + (size_t)(kt) * 64 * NQKV; kreg = *(const bf16x8*)s_; vreg = *(const bf16x8*)(s_ + 1024); } while (0)
#define AT_STORE(buf) do { *(LAS bf16x8*)(lds + AT_KOFF + (buf) * 9216 + srow * 144 + sch * 16) = kreg; \
        _Pragma("unroll") for (int j_ = 0; j_ < 8; ++j_) *(LAS short*)(lds + AT_VOFF + (buf) * 9216 + (8 * sch + j_) * 144 + vp * 2) = vreg[j_]; } while (0)
    AT_LOAD(kt_lo); AT_STORE(0);
    __syncthreads();
    float m = -1e30f, l = 0.f; f32x16 o[2];
#pragma unroll
    for (int r = 0; r < 16; ++r) { o[0][r] = 0.f; o[1][r] = 0.f; }
    const float C2 = 0.125f * LOG2E;
    const int qi = 32 * (wid & 1) + r32;
    for (int kt = kt_lo; kt <= kt_hi; ++kt) {
        const int cur = (kt - kt_lo) & 1;
        if (kt < kt_hi) AT_LOAD(kt + 1);
        if (kt >= cw - 8 && kt <= cw) {
            const LAS unsigned char* Kb = lds + AT_KOFF + cur * 9216; const LAS unsigned char* Vb = lds + AT_VOFF + cur * 9216;
            f32x16 p0, p1;
#pragma unroll
            for (int r = 0; r < 16; ++r) { p0[r] = 0.f; p1[r] = 0.f; }
#pragma unroll
            for (int d0 = 0; d0 < 4; ++d0) {
                const bf16x8 a0 = *(const LAS bf16x8*)(Kb + r32 * 144 + d0 * 32 + hi * 16);
                const bf16x8 a1 = *(const LAS bf16x8*)(Kb + (32 + r32) * 144 + d0 * 32 + hi * 16);
                p0 = __builtin_amdgcn_mfma_f32_32x32x16_bf16(a0, qr[d0], p0, 0, 0, 0);
                p1 = __builtin_amdgcn_mfma_f32_32x32x16_bf16(a1, qr[d0], p1, 0, 0, 0);
            }
            const int dist = cw - kt;
            if (dist >= 3) { const float bf = tab[256];
#pragma unroll
                for (int r = 0; r < 16; ++r) { p0[r] = p0[r] * C2 + bf; p1[r] = p1[r] * C2 + bf; } }
            else {
#pragma unroll
                for (int r = 0; r < 16; ++r) { const int kv = (r & 3) + 8 * (r >> 2) + 4 * hi; const int rel = qi - kv + 64 * dist;
                    p0[r] = p0[r] * C2 + tab[min(rel, 128) + 128]; p1[r] = p1[r] * C2 + tab[min(rel - 32, 128) + 128]; } }
            float mx = p0[0];
#pragma unroll
            for (int r = 1; r < 16; ++r) mx = fmaxf(mx, p0[r]);
#pragma unroll
            for (int r = 0; r < 16; ++r) mx = fmaxf(mx, p1[r]);
            mx = fmaxf(mx, __shfl_xor(mx, 32));
            const float mn = fmaxf(m, mx), scl = __builtin_amdgcn_exp2f(m - mn); m = mn;
            float ls = 0.f;
#pragma unroll
            for (int r = 0; r < 16; ++r) { p0[r] = __builtin_amdgcn_exp2f(p0[r] - mn); p1[r] = __builtin_amdgcn_exp2f(p1[r] - mn); ls += p0[r] + p1[r]; }
            l = l * scl + ls;
#pragma unroll
            for (int r = 0; r < 16; ++r) { o[0][r] *= scl; o[1][r] *= scl; }
            u32x4 pw[4];
#pragma unroll
            for (int s = 0; s < 2; ++s) {
                pw[s] = (u32x4){pk2(p0[8 * s], p0[8 * s + 1]), pk2(p0[8 * s + 2], p0[8 * s + 3]), pk2(p0[8 * s + 4], p0[8 * s + 5]), pk2(p0[8 * s + 6], p0[8 * s + 7])};
                pw[2 + s] = (u32x4){pk2(p1[8 * s], p1[8 * s + 1]), pk2(p1[8 * s + 2], p1[8 * s + 3]), pk2(p1[8 * s + 4], p1[8 * s + 5]), pk2(p1[8 * s + 6], p1[8 * s + 7])};
            }
#pragma unroll
            for (int dh = 0; dh < 2; ++dh)
#pragma unroll
                for (int ks = 0; ks < 4; ++ks) {
                    const bf16x8 vf = *(const LAS bf16x8*)(Vb + (32 * dh + r32) * 144 + (16 * ks + 8 * hi) * 2);
                    o[dh] = __builtin_amdgcn_mfma_f32_32x32x16_bf16(vf, __builtin_bit_cast(bf16x8, pw[ks]), o[dh], 0, 0, 0);
                }
        }
        if (kt < kt_hi) AT_STORE(cur ^ 1);
        __syncthreads();
    }
#undef AT_LOAD
#undef AT_STORE
    l += __shfl_xor(l, 32);
    const float rl = 1.0f / l;
    bf16_t* op = MIX + qrow * DM + h * 64;
#pragma unroll
    for (int dh = 0; dh < 2; ++dh)
#pragma unroll
        for (int r4 = 0; r4 < 4; ++r4) {
            u32x2 w; w.x = pk2(o[dh][4 * r4] * rl, o[dh][4 * r4 + 1] * rl); w.y = pk2(o[dh][4 * r4 + 2] * rl, o[dh][4 * r4 + 3] * rl);
            *(u32x2*)(op + 32 * dh + 8 * r4 + 4 * hi) = w;
        }
}
__device__ __forceinline__ void attn_sample_unit(const Params& P, LAS unsigned char* lds, int li, int b, int h, const int tid) {
    const int lane = tid & 63, wid = tid >> 6;
    const bf16_t* QKV = (const bf16_t*)(P.ws + WS_R1); bf16_t* MIX = (bf16_t*)(P.ws + WS_MIX);
    LAS float* qs = (LAS float*)lds;
    LAS float* sc = qs + 1024;
    LAS float* tab = sc + 16 * 528;
    const size_t rb = (size_t)TP + b * SSEQ;
    for (int i = tid; i < 1024; i += 512) qs[i] = bf2f(QKV[(rb + (i >> 6)) * NQKV + h * 64 + (i & 63)]);
    if (tid < 257) tab[tid] = P.in[19][(size_t)(li * 16 + h) * 257 + tid];
    __syncthreads();
    const float* kc = P.in[5] + ((size_t)(li * 8 + b) * 512) * 1024 + h * 64;
    const float* vc = P.in[6] + ((size_t)(li * 8 + b) * 512) * 1024 + h * 64;
    for (int j = tid; j < 528; j += 512) {
        float kr[64];
        if (j < 512) {
#pragma unroll
            for (int d = 0; d < 16; ++d) { const f32x4 t = *(const f32x4*)(kc + (size_t)j * 1024 + 4 * d); kr[4 * d] = t[0]; kr[4 * d + 1] = t[1]; kr[4 * d + 2] = t[2]; kr[4 * d + 3] = t[3]; }
        } else {
#pragma unroll
            for (int d = 0; d < 64; ++d) kr[d] = bf2f(QKV[(rb + (j - 512)) * NQKV + 1024 + h * 64 + d]);
        }
        for (int q = 0; q < 16; ++q) {
            float s = 0.f;
#pragma unroll
            for (int d = 0; d < 64; ++d) s += qs[q * 64 + d] * kr[d];
            const int rel = (j < 512) ? (512 + q - j) : (q - (j - 512));
            sc[q * 528 + j] = s * 0.125f + tab[min(max(rel, -128), 128) + 128];
        }
    }
    __syncthreads();
    for (int q = 2 * wid; q < 2 * wid + 2; ++q) {
        float mx = -1e30f;
        for (int j = lane; j < 528; j += 64) mx = fmaxf(mx, sc[q * 528 + j]);
#pragma unroll
        for (int o = 1; o < 64; o <<= 1) mx = fmaxf(mx, __shfl_xor(mx, o));
        float sm = 0.f;
        for (int j = lane; j < 528; j += 64) { const float p = __expf(sc[q * 528 + j] - mx); sc[q * 528 + j] = p; sm += p; }
        sm = wave_sum(sm);
        const float inv = 1.0f / sm;
        for (int j = lane; j < 528; j += 64) sc[q * 528 + j] *= inv;
    }
    __syncthreads();
    {
        const int q = tid >> 5, d = 2 * (tid & 31);
        float a0 = 0.f, a1 = 0.f;
        for (int j = 0; j < 512; ++j) { const f32x2 v = *(const f32x2*)(vc + (size_t)j * 1024 + d); const float p = sc[q * 528 + j]; a0 += p * v[0]; a1 += p * v[1]; }
        for (int j = 0; j < 16; ++j) { const bf16_t* vp = QKV + (rb + j) * NQKV + 2048 + h * 64 + d; const float p = sc[q * 528 + 512 + j]; a0 += p * bf2f(vp[0]); a1 += p * bf2f(vp[1]); }
        *(unsigned*)(MIX + (rb + q) * DM + h * 64 + d) = pk2(a0, a1);
    }
    __syncthreads();
}

__global__ void __launch_bounds__(512, 2) hybrid_fwd(Params P) {
    extern __shared__ __attribute__((aligned(16))) unsigned char lds_raw[];
    LAS unsigned char* lds = (LAS unsigned char*)lds_raw;
    const int G = gridDim.x;
    for (int ph = P.ph_lo; ph < P.ph_hi; ++ph) {
        int tid = threadIdx.x; asm volatile("" : "+v"(tid));
        int wg = blockIdx.x; asm volatile("" : "+s"(wg));
        const Params& Q = P;
        const int lane = tid & 63, wid = __builtin_amdgcn_readfirstlane(tid >> 6), gw = wg * 8 + wid, ngw = G * 8;
        unsigned char* ws = Q.ws;
        bf16_t* Xb = (bf16_t*)(ws + WS_XB); bf16_t* R1 = (bf16_t*)(ws + WS_R1); bf16_t* MIX = (bf16_t*)(ws + WS_MIX);
        float* GATES = (float*)(ws + WS_GATES); float* SSP = (float*)(ws + WS_SSP);
        if (ph == 0) phase_prologue(Q, lds, gw, ngw, wid, lane);
        else if (ph == NPHASE - 1) phase_final(Q, gw, ngw, lane);
        else {
            const int layer = (ph - 1) / 5, sub = (ph - 1) % 5, li = layer >> 1, odd = layer & 1;
            if (sub == 1) {
                if (!odd) {
                    const int role = wg >> 6, u = wg & 63;
                    if (G == 256) {
                        if (role == 0) delta_unit(Q, lds, li, false, u >> 3, u & 7, tid);
                        else if (role == 1) gla_unit(Q, lds, li, false, u >> 3, u & 7, tid);
                        else if (role == 2) delta_unit(Q, lds, li, true, u >> 3, u & 7, tid);
                        else gla_unit(Q, lds, li, true, u >> 3, u & 7, tid);
                    }
                } else {
                    for (int u = wg * 8; u < wg * 8 + 8; ++u) attn_prompt_unit(Q, lds, li, u >> 8, (u >> 4) & 15, u & 15, tid);
                    if (wg < 128) attn_sample_unit(Q, lds, li, wg >> 4, wg & 15, tid);
                }
            } else {
                pg8::Gemm g; int mode, Npos;
                g.M = TP;
                LAS unsigned long long* eap = (LAS unsigned long long*)(lds + EA_OFF);
#define EA_SET(i, p) eap[i] = (unsigned long long)(p)
                if (sub == 0) {
                    g.A = Xb; g.K = 1024;
                    if (!odd) { mode = 0; Npos = ABPAD; g.Bt = (const bf16_t*)(ws + WS_WIN + li * SZ_WIN);
                        if (tid == 0) { EA_SET(0, R1); EA_SET(1, SSP); EA_SET(2, GATES); EA_SET(3, Q.out + O_CONVP + (size_t)li * 8 * 3 * DNQKV); EA_SET(4, Q.out + O_CONVS + (size_t)li * 8 * 3 * DNQKV); } }
                    else { mode = 1; Npos = NQKV; g.Bt = (const bf16_t*)(ws + WS_WQKV + li * SZ_WQKV);
                        if (tid == 0) { EA_SET(0, R1); EA_SET(1, SSP); EA_SET(3, Q.out + O_CKP + (size_t)li * 8 * 512 * 1024); EA_SET(4, Q.out + O_CVP + (size_t)li * 8 * 512 * 1024); EA_SET(5, Q.out + O_CKS + (size_t)li * 8 * 16 * 1024); EA_SET(6, Q.out + O_CVS + (size_t)li * 8 * 16 * 1024); } }
                } else if (sub == 2) {
                    mode = 2; Npos = 1024; g.A = MIX; g.K = 1024; g.Bt = (const bf16_t*)(ws + (odd ? WS_WCOUT : WS_WOUT) + li * SZ_W1K);
                    if (tid == 0) { EA_SET(7, (layer == 0) ? Q.in[0] : Q.out); EA_SET(8, (layer == 0) ? Q.in[1] : Q.out + (size_t)TP * DM); EA_SET(9, Q.out); EA_SET(10, Xb); EA_SET(11, SSP); }
                } else if (sub == 3) {
                    mode = 3; Npos = NGU; g.A = Xb; g.K = 1024; g.Bt = (const bf16_t*)(ws + WS_WGU + layer * SZ_WGU);
                    if (tid == 0) { EA_SET(0, R1); EA_SET(1, SSP); }
                } else {
                    mode = 2; Npos = 1024; g.A = R1; g.K = DFF; g.Bt = (const bf16_t*)(ws + WS_WDN + layer * SZ_WDN);
                    if (tid == 0) { EA_SET(7, Q.out); EA_SET(8, Q.out + (size_t)TP * DM); EA_SET(9, Q.out); EA_SET(10, Xb); EA_SET(11, SSP); }
                }
#undef EA_SET
                g.N = Npos;
                __syncthreads();
                pg8::StaticOrder S; S.init(TP, Npos, G, wg);
                if (mode == 0) { small_gemm<0>(g.A, g.Bt, Npos, g.K, eap, gw, ngw, lane); Epi<0> E{eap}; pg8::gemm_phase<Epi<0>, true, true>(lds, g, S, E, tid); }
                else if (mode == 1) { small_gemm<1>(g.A, g.Bt, Npos, g.K, eap, gw, ngw, lane); Epi<1> E{eap}; pg8::gemm_phase<Epi<1>, true, true>(lds, g, S, E, tid); }
                else if (mode == 2) { small_gemm<2>(g.A, g.Bt, Npos, g.K, eap, gw, ngw, lane); Epi<2> E{eap}; pg8::gemm_phase<Epi<2>, true, true>(lds, g, S, E, tid); }
                else { small_gemm<3>(g.A, g.Bt, Npos, g.K, eap, gw, ngw, lane); Epi<3> E{eap}; pg8::gemm_phase<Epi<3>, true, true>(lds, g, S, E, tid); }
            }
        }
        if (ph + 1 < P.ph_hi) cg::this_grid().sync();
    }
}

extern "C" void kernel_launch(void* const* d_in, const int* in_sizes, int n_in, void* d_out, int out_size, void* d_ws, size_t ws_size, hipStream_t stream) {
    static int grid = 0;
    if (grid == 0) {
        if (n_in != 25 || (size_t)out_size != O_END || ws_size < WS_END) { fprintf(stderr, "kernel_launch: unexpected sizes n_in %d out %d ws %zu (need %zu)\n", n_in, out_size, ws_size, (size_t)WS_END); grid = -1; return; }
        if (hipFuncSetAttribute((const void*)hybrid_fwd, hipFuncAttributeMaxDynamicSharedMemorySize, LDS_BYTES) != hipSuccess) { fprintf(stderr, "kernel_launch: hipFuncSetAttribute failed\n"); grid = -1; return; }
        int dev = 0, cus = 0, per_cu = 0;
        hipGetDevice(&dev); hipDeviceGetAttribute(&cus, hipDeviceAttributeMultiprocessorCount, dev);
        hipOccupancyMaxActiveBlocksPerMultiprocessor(&per_cu, (const void*)hybrid_fwd, 512, LDS_BYTES);
        (void)hipGetLastError();
        if (cus != 256 || per_cu < 1) fprintf(stderr, "kernel_launch: note: cus %d per_cu %d\n", cus, per_cu);
        grid = 256;
    }
    if (grid < 0) return;
    Params p{};
    for (int i = 0; i < 25; ++i) p.in[i] = (const float*)d_in[i];
    p.out = (float*)d_out; p.ws = (unsigned char*)d_ws;
#if MK_MULTI
    for (int ph = 0; ph < NPHASE; ++ph) { p.ph_lo = ph; p.ph_hi = ph + 1; hipLaunchKernelGGL(hybrid_fwd, dim3(grid), dim3(512), LDS_BYTES, stream, p); }
#else
    p.ph_lo = 0; p.ph_hi = NPHASE;
    void* args[] = {&p};
    hipError_t e = hipLaunchCooperativeKernel((const void*)hybrid_fwd, dim3(grid), dim3(512), args, LDS_BYTES, stream);
    if (e != hipSuccess) fprintf(stderr, "cooperative launch failed: %s\n", hipGetErrorString(e));
#endif
}
```

```cpp
#include <hip/hip_runtime.h>
#include <hip/hip_cooperative_groups.h>
#include <cstdio>
#include <cstdint>
namespace cg = cooperative_groups;

#ifndef MK_MULTI
#define MK_MULTI 0
#endif

#ifndef REP_MIX
#define REP_MIX 1
#endif
#ifndef REP_ATT
#define REP_ATT 1
#endif
#ifndef REP_PRO
#define REP_PRO 1
#endif
#ifndef REP_PROJ
#define REP_PROJ 1
#endif
#define LAS __attribute__((address_space(3)))
#define GAS __attribute__((address_space(1)))
typedef unsigned short bf16_t;
typedef short bf16x8 __attribute__((ext_vector_type(8)));
typedef float f32x2 __attribute__((ext_vector_type(2)));
typedef float f32x4 __attribute__((ext_vector_type(4)));
typedef float f32x16 __attribute__((ext_vector_type(16)));
typedef unsigned u32x2 __attribute__((ext_vector_type(2)));
typedef unsigned u32x4 __attribute__((ext_vector_type(4)));

constexpr int DM = 1024, NB = 8, SEQ = 4096, SB = 8, SSEQ = 16, PAST = 2048;
constexpr int TP = NB * SEQ;
constexpr int TS = SB * SSEQ;
constexpr int TR = TP + TS;
constexpr int ABIN = 3616, ABPAD = 3840, DFF = 2816, NGU = 5632, NQKV = 3072, DNQKV = 1536;
constexpr float EPS = 1e-6f;
constexpr float LOG2E = 1.4426950408889634f;

constexpr size_t O_Y = 0;
constexpr size_t O_CONVP = (size_t)TR * DM;
constexpr size_t O_CONVS = O_CONVP + 2 * 8 * 3 * 1536;
constexpr size_t O_DNP = O_CONVS + 2 * 8 * 3 * 1536;
constexpr size_t O_DNS = O_DNP + 2 * 8 * 8 * 64 * 64;
constexpr size_t O_GLAP = O_DNS + 2 * 8 * 8 * 64 * 64;
constexpr size_t O_GLAS = O_GLAP + 2 * 8 * 8 * 32 * 64;
constexpr size_t O_CKP = O_GLAS + 2 * 8 * 8 * 32 * 64;
constexpr size_t O_CKS = O_CKP + (size_t)2 * 8 * 512 * 1024;
constexpr size_t O_CVP = O_CKS + 2 * 8 * 16 * 1024;
constexpr size_t O_CVS = O_CVP + (size_t)2 * 8 * 512 * 1024;
constexpr size_t O_END = O_CVS + 2 * 8 * 16 * 1024;

constexpr size_t SZ_WIN = (size_t)ABPAD * 1024 * 2, SZ_W1K = (size_t)1024 * 1024 * 2, SZ_WQKV = (size_t)NQKV * 1024 * 2, SZ_WGU = (size_t)NGU * 1024 * 2, SZ_WDN = (size_t)1024 * DFF * 2;
constexpr size_t WS_WIN = 0;
constexpr size_t WS_WOUT = WS_WIN + 2 * SZ_WIN;
constexpr size_t WS_WQKV = WS_WOUT + 2 * SZ_W1K;
constexpr size_t WS_WCOUT = WS_WQKV + 2 * SZ_WQKV;
constexpr size_t WS_WGU = WS_WCOUT + 2 * SZ_W1K;
constexpr size_t WS_WDN = WS_WGU + 4 * SZ_WGU;
constexpr size_t WS_XB = WS_WDN + 4 * SZ_WDN;
constexpr size_t WS_R1 = WS_XB + (size_t)TR * 1024 * 2;
constexpr size_t WS_MIX = WS_R1 + (size_t)TR * ABIN * 2;
constexpr size_t WS_GATES = WS_MIX + (size_t)TR * 1024 * 2;
constexpr size_t WS_SSP = WS_GATES + (size_t)TR * 32 * 4;
constexpr size_t WS_END = WS_SSP + (size_t)TR * 16 * 4;

constexpr int LDS_BYTES = 147456;
constexpr int NPHASE = 24;

struct Params { const float* in[25]; float* out; unsigned char* ws; int ph_lo, ph_hi; };

__device__ __forceinline__ unsigned f2bf(float f) { unsigned u = __builtin_bit_cast(unsigned, f); return (u + 0x7fffu + ((u >> 16) & 1u)) >> 16; }
typedef __bf16 hwbf16x2 __attribute__((ext_vector_type(2)));
__device__ __forceinline__ unsigned pk2(float lo, float hi) { const f32x2 v = {lo, hi}; return __builtin_bit_cast(unsigned, __builtin_convertvector(v, hwbf16x2)); }
__device__ __forceinline__ float bf2f(bf16_t b) { return __builtin_bit_cast(float, ((unsigned)b) << 16); }
template <int CTRL> __device__ __forceinline__ float dppf(float v) { return __builtin_bit_cast(float, __builtin_amdgcn_update_dpp(0, __builtin_bit_cast(int, v), CTRL, 0xF, 0xF, true)); }
__device__ __forceinline__ float quad_sum(float v) { v += dppf<0xB1>(v); v += dppf<0x4E>(v); return v; }
__device__ __forceinline__ float oct_sum(float v) { v = quad_sum(v); v += dppf<0x141>(v); return v; }
__device__ __forceinline__ float wave_sum(float v) {
    v = oct_sum(v); v += dppf<0x140>(v);
    const int i = __builtin_bit_cast(int, v);
    return (__builtin_bit_cast(float, __builtin_amdgcn_readlane(i, 0)) + __builtin_bit_cast(float, __builtin_amdgcn_readlane(i, 16))) +
           (__builtin_bit_cast(float, __builtin_amdgcn_readlane(i, 32)) + __builtin_bit_cast(float, __builtin_amdgcn_readlane(i, 48)));
}
__device__ __forceinline__ float fast_rcp(float x) { return __builtin_amdgcn_rcpf(x); }
__device__ __forceinline__ float silu_f(float x) { return x * fast_rcp(1.0f + __expf(-x)); }
__device__ __forceinline__ float sigmoid_f(float x) { return fast_rcp(1.0f + __expf(-x)); }
__device__ __forceinline__ float softplus_f(float x) { return fmaxf(x, 0.f) + __logf(1.0f + __expf(-fabsf(x))); }

namespace pg8 {
constexpr int BM = 256, BK = 64, HALF = 128, HTB = HALF * BK * 2, STAGE_BYTES = 8 * HTB, NXCD = 8, WGM = 8;
__host__ __device__ __forceinline__ int lds_byte(int r, int c) { const int st = (r >> 4) * 2 + (c >> 5), rr = r & 15, cc = c & 31, ob = rr * 64 + cc * 2; return st * 1024 + (ob ^ (((ob >> 9) & 1) << 5)); }
__host__ __device__ __forceinline__ void stage_rc(int b, int& R, int& C) { const int st = b / 1024, sb = b % 1024, swz = sb ^ (((sb >> 9) & 1) << 5); R = (st >> 1) * 16 + swz / 64; C = (st & 1) * 32 + (swz % 64) / 2; }
__host__ __device__ __forceinline__ int perm32(int rho) { const int n = rho >> 4, i = rho & 15; return 8 * (i >> 2) + 4 * n + (i & 3); }
struct Unit { int pm, pn; };
struct Gemm { const bf16_t* A; const bf16_t* Bt; int M, N, K; };
struct StaticOrder {
    int nM, nN, nwg, G, c;
    __host__ __device__ void init(int M, int N, int G_, int c_) { nM = M / BM; nN = N / BM; nwg = nM * nN; G = G_; c = c_; }
    __host__ __device__ bool next(int i, Unit& u) const {
        const long L = (long)i * G + c; if (L >= nwg) return false;
        int wgid = (int)L; { const int q = nwg / NXCD, r = nwg % NXCD, xcd = wgid % NXCD, off = wgid / NXCD; wgid = (xcd < r ? xcd * (q + 1) : r * (q + 1) + (xcd - r) * q) + off; }
        const int nig = WGM * nN, gid = wgid / nig, fm = gid * WGM, gsz = (nM - fm) < WGM ? (nM - fm) : WGM;
        u.pm = fm + ((wgid % nig) % gsz); u.pn = (wgid % nig) / gsz; return true;
    }
};

template <class Epi, bool ALIGN_EPI, bool SP2>
__device__ __forceinline__ void gemm_phase(LAS unsigned char* lds, const Gemm g, const StaticOrder& S, const Epi& E, const int tid) {
    const int wid = __builtin_amdgcn_readfirstlane(tid >> 6), lane = tid & 63, wr = wid >> 2, wc = wid & 3, fr = lane & 15, fq = lane >> 4;
    const int K = g.K, nt = K / BK;
    unsigned voffA[2], voffB[2];
#pragma unroll
    for (int i = 0; i < 2; ++i) { int R, C; stage_rc(tid * 16 + i * 8192, R, C); voffA[i] = (unsigned)(R * K + C) * 2u; voffB[i] = (unsigned)(R * K + C) * 2u; }
    const size_t kstep = (size_t)(BK * 2);
    const size_t hstep = (size_t)HALF * K * 2;
    const size_t tstep = 2 * hstep;
    const unsigned ldsw = (unsigned)wid * 1024u;
    const int aoff = lds_byte(wr * 64 + fr, fq * 8), boff = lds_byte(wc * 32 + fr, fq * 8);
#define PG8_SA(b, h) (((b) * 2 + (h)) * HTB)
#define PG8_SB(b, h) ((4 + (b) * 2 + (h)) * HTB)
#define PG8_STAGE(bufoff, gbase, voff) do { _Pragma("unroll") for (int _i = 0; _i < 2; ++_i) \
        __builtin_amdgcn_global_load_lds((const unsigned*)((const char*)(gbase) + (voff)[_i]), (LAS unsigned*)(lds + (bufoff) + ldsw + _i * 8192), 16, 0, 0); } while (0)
#define PG8_LDA(dst, b, h) do { _Pragma("unroll") for (int m = 0; m < 4; ++m) _Pragma("unroll") for (int k = 0; k < 2; ++k) dst[m][k] = *(const LAS bf16x8*)(lds + PG8_SA(b, h) + aoff + m * 2048 + k * 1024); } while (0)
#define PG8_LDB(dst, b, h) do { _Pragma("unroll") for (int n = 0; n < 2; ++n) _Pragma("unroll") for (int k = 0; k < 2; ++k) dst[n][k] = *(const LAS bf16x8*)(lds + PG8_SB(b, h) + boff + n * 2048 + k * 1024); } while (0)
#define PG8_MMA(ai, bj, At, Bt) do { __builtin_amdgcn_s_setprio(1); _Pragma("unroll") for (int m = 0; m < 4; ++m) _Pragma("unroll") for (int n = 0; n < 2; ++n) _Pragma("unroll") for (int k = 0; k < 2; ++k) \
        acc[ai][bj][m][n] = __builtin_amdgcn_mfma_f32_16x16x32_bf16(Bt[n][k], At[m][k], acc[ai][bj][m][n], 0, 0, 0); __builtin_amdgcn_s_setprio(0); } while (0)
#define PG8_WAIT_V(n) asm volatile("s_waitcnt vmcnt(" #n ")" ::: "memory")
#define PG8_WAIT_L(n) asm volatile("s_waitcnt lgkmcnt(" #n ")" ::: "memory")
#define PG8_BAR __builtin_amdgcn_s_barrier()
#define PG8_SCHED __builtin_amdgcn_sched_barrier(0)
    Unit cur, nxt; int ui = 0;
    if (!S.next(0, cur)) return;
    f32x4 acc[2][2][4][2];
#pragma unroll
    for (int a = 0; a < 2; ++a)
#pragma unroll
        for (int b = 0; b < 2; ++b)
#pragma unroll
            for (int m = 0; m < 4; ++m)
#pragma unroll
                for (int n = 0; n < 2; ++n) acc[a][b][m][n] = (f32x4){0.f, 0.f, 0.f, 0.f};
    bf16x8 At[4][2], B0[2][2], B1[2][2];
    const char* cA = (const char*)g.A + (size_t)cur.pm * tstep; const char* cB = (const char*)g.Bt + (size_t)cur.pn * tstep;
    if constexpr (SP2) {
        PG8_STAGE(PG8_SB(0, 0), cB, voffB); PG8_STAGE(PG8_SB(0, 1), cB + hstep, voffB); PG8_STAGE(PG8_SA(0, 0), cA, voffA); PG8_STAGE(PG8_SA(0, 1), cA + hstep, voffA);
        if (wr == 1) PG8_BAR;
        PG8_WAIT_V(2); PG8_BAR;
        PG8_STAGE(PG8_SB(1, 0), cB + kstep, voffB); PG8_STAGE(PG8_SA(1, 0), cA + kstep, voffA); PG8_STAGE(PG8_SB(1, 1), cB + hstep + kstep, voffB);
        PG8_WAIT_V(6); PG8_BAR;
    } else {
        PG8_STAGE(PG8_SB(0, 0), cB, voffB); PG8_STAGE(PG8_SA(0, 0), cA, voffA); PG8_STAGE(PG8_SB(0, 1), cB + hstep, voffB); PG8_STAGE(PG8_SA(0, 1), cA + hstep, voffA);
        if (wr == 1) PG8_BAR;
        PG8_WAIT_V(4); PG8_BAR;
        PG8_STAGE(PG8_SB(1, 0), cB + kstep, voffB); PG8_STAGE(PG8_SA(1, 0), cA + kstep, voffA); PG8_STAGE(PG8_SB(1, 1), cB + hstep + kstep, voffB);
        PG8_WAIT_V(6); PG8_BAR;
    }
    for (;;) {
        const bool has_next = S.next(ui + 1, nxt);
        const char* nA = has_next ? (const char*)g.A + (size_t)nxt.pm * tstep : cA; const char* nB = has_next ? (const char*)g.Bt + (size_t)nxt.pn * tstep : cB;
        for (int t = 0; t < nt; t += 2) {
            const bool last = (t == nt - 2);
            const char* a1 = cA + (size_t)(t + 1) * kstep;
            const char* a2 = last ? nA : cA + (size_t)(t + 2) * kstep; const char* b2 = last ? nB : cB + (size_t)(t + 2) * kstep;
            const char* a3 = a2 + kstep; const char* b3 = b2 + kstep;
            if constexpr (SP2) {
            PG8_LDB(B0, 0, 0); PG8_LDB(B1, 0, 1); PG8_SCHED; PG8_LDA(At, 0, 0); PG8_STAGE(PG8_SA(1, 1), a1 + hstep, voffA);
            PG8_WAIT_V(8); PG8_WAIT_L(0); PG8_BAR; PG8_MMA(0, 0, At, B0); PG8_MMA(0, 1, At, B1); PG8_BAR; PG8_SCHED;
            PG8_LDA(At, 0, 1); PG8_STAGE(PG8_SB(0, 0), b2, voffB); PG8_STAGE(PG8_SB(0, 1), b2 + hstep, voffB); PG8_STAGE(PG8_SA(0, 0), a2, voffA);
            PG8_WAIT_V(8); PG8_WAIT_L(0); PG8_BAR; PG8_MMA(1, 0, At, B0); PG8_MMA(1, 1, At, B1); PG8_BAR; PG8_SCHED;
            PG8_LDB(B0, 1, 0); PG8_LDB(B1, 1, 1); PG8_SCHED; PG8_LDA(At, 1, 0); PG8_STAGE(PG8_SA(0, 1), a2 + hstep, voffA);
            PG8_WAIT_V(8); PG8_WAIT_L(0); PG8_BAR; PG8_MMA(0, 0, At, B0); PG8_MMA(0, 1, At, B1); PG8_BAR; PG8_SCHED;
            PG8_LDA(At, 1, 1); PG8_STAGE(PG8_SB(1, 0), b3, voffB); PG8_STAGE(PG8_SB(1, 1), b3 + hstep, voffB); PG8_STAGE(PG8_SA(1, 0), a3, voffA);
            PG8_WAIT_V(8); PG8_WAIT_L(0); PG8_BAR; PG8_MMA(1, 0, At, B0); PG8_MMA(1, 1, At, B1); PG8_BAR; PG8_SCHED;
            } else {
            PG8_LDB(B0, 0, 0); PG8_SCHED; PG8_LDA(At, 0, 0); PG8_STAGE(PG8_SA(1, 1), a1 + hstep, voffA);
            PG8_WAIT_L(8); PG8_BAR; PG8_WAIT_L(0); PG8_MMA(0, 0, At, B0); PG8_BAR; PG8_SCHED;
            PG8_LDB(B1, 0, 1); PG8_STAGE(PG8_SB(0, 0), b2, voffB);
            PG8_BAR; PG8_WAIT_L(0); PG8_MMA(0, 1, At, B1); PG8_BAR;
            PG8_LDA(At, 0, 1); PG8_STAGE(PG8_SA(0, 0), a2, voffA);
            PG8_BAR; PG8_WAIT_L(0); PG8_MMA(1, 0, At, B0); PG8_BAR; PG8_SCHED;
            PG8_STAGE(PG8_SB(0, 1), b2 + hstep, voffB);
            PG8_WAIT_V(6); PG8_BAR; PG8_MMA(1, 1, At, B1); PG8_BAR;
            PG8_LDB(B0, 1, 0); PG8_SCHED; PG8_LDA(At, 1, 0); PG8_STAGE(PG8_SA(0, 1), a2 + hstep, voffA);
            PG8_WAIT_L(8); PG8_BAR; PG8_WAIT_L(0); PG8_MMA(0, 0, At, B0); PG8_BAR; PG8_SCHED;
            PG8_LDB(B1, 1, 1); PG8_STAGE(PG8_SB(1, 0), b3, voffB);
            PG8_BAR; PG8_WAIT_L(0); PG8_MMA(0, 1, At, B1); PG8_BAR;
            PG8_LDA(At, 1, 1); PG8_STAGE(PG8_SA(1, 0), a3, voffA);
            PG8_BAR; PG8_WAIT_L(0); PG8_MMA(1, 0, At, B0); PG8_BAR; PG8_SCHED;
            PG8_STAGE(PG8_SB(1, 1), b3 + hstep, voffB);
            PG8_WAIT_V(6); PG8_BAR; PG8_MMA(1, 1, At, B1); PG8_BAR;
            }
        }
        if constexpr (ALIGN_EPI) { if (wr == 0) PG8_BAR; }
        E(acc, cur, wr, wc, fr, fq);
        if (!has_next) break;
#pragma unroll
        for (int a = 0; a < 2; ++a)
#pragma unroll
            for (int b = 0; b < 2; ++b)
#pragma unroll
                for (int m = 0; m < 4; ++m)
#pragma unroll
                    for (int n = 0; n < 2; ++n) acc[a][b][m][n] = (f32x4){0.f, 0.f, 0.f, 0.f};
        cur = nxt; cA = nA; cB = nB; ++ui;
        if constexpr (ALIGN_EPI) { if (wr == 1) PG8_BAR; }
    }
    PG8_WAIT_V(0);
    if constexpr (!ALIGN_EPI) { if (wr == 0) PG8_BAR; }
    PG8_BAR;
#undef PG8_SA
#undef PG8_SB
#undef PG8_STAGE
#undef PG8_LDA
#undef PG8_LDB
#undef PG8_MMA
#undef PG8_WAIT_V
#undef PG8_WAIT_L
#undef PG8_BAR
#undef PG8_SCHED
}
}

struct EpiArgs {
    GAS bf16_t* out; const GAS float* ssp; GAS float* gates; GAS float* o0; GAS float* o1; GAS float* o2; GAS float* o3;
    const GAS float* base_p; const GAS float* base_s; GAS float* X; GAS bf16_t* Xb; GAS float* ssp_out;
};
__device__ __forceinline__ float row_rstd(const GAS float* ssp, int row) {
    const GAS f32x4* p = (const GAS f32x4*)(ssp + (size_t)row * 16);
    const f32x4 a = p[0], b = p[1], c = p[2], d = p[3];
    const float s = ((a[0] + a[1]) + (a[2] + a[3])) + ((b[0] + b[1]) + (b[2] + b[3])) + ((c[0] + c[1]) + (c[2] + c[3])) + ((d[0] + d[1]) + (d[2] + d[3]));
    return rsqrtf(s * (1.0f / 1024.0f) + EPS);
}
template <int MODE, bool SMALL>
__device__ __forceinline__ float epi_apply(const EpiArgs& a, int row, int g32, int fq, f32x4 v0, f32x4 v1, float rstd) {
    const int c0 = 32 * g32 + 8 * fq;
    if constexpr (MODE == 0) {
        if (g32 >= ABIN / 32) return 0.f;
        v0 *= rstd; v1 *= rstd;
        u32x4 w; w.x = pk2(v0[0], v0[1]); w.y = pk2(v0[2], v0[3]); w.z = pk2(v1[0], v1[1]); w.w = pk2(v1[2], v1[3]);
        *(GAS u32x4*)(a.out + (size_t)row * ABIN + c0) = w;
        if (g32 == 48 && fq < 2) { GAS float* gp = a.gates + (size_t)row * 32 + 8 * fq; *(GAS f32x4*)gp = v0; *(GAS f32x4*)(gp + 4) = v1; }
        if (g32 == 96 && fq >= 2) { GAS float* gp = a.gates + (size_t)row * 32 + 16 + 8 * (fq - 2); *(GAS f32x4*)gp = v0; *(GAS f32x4*)(gp + 4) = v1; }
        if (c0 < DNQKV) {
            if constexpr (!SMALL) { const int t = row & (SEQ - 1), b = row >> 12; if (t >= SEQ - 3) { GAS float* d = a.o0 + (size_t)(b * 3 + (t - (SEQ - 3))) * DNQKV + c0; *(GAS f32x4*)d = v0; *(GAS f32x4*)(d + 4) = v1; } }
            else { const int r = row - TP, t = r & 15, b = r >> 4; if (t >= SSEQ - 3) { GAS float* d = a.o1 + (size_t)(b * 3 + (t - (SSEQ - 3))) * DNQKV + c0; *(GAS f32x4*)d = v0; *(GAS f32x4*)(d + 4) = v1; } }
        }
        return 0.f;
    } else if constexpr (MODE == 1) {
        v0 *= rstd; v1 *= rstd;
        u32x4 w; w.x = pk2(v0[0], v0[1]); w.y = pk2(v0[2], v0[3]); w.z = pk2(v1[0], v1[1]); w.w = pk2(v1[2], v1[3]);
        *(GAS u32x4*)(a.out + (size_t)row * NQKV + c0) = w;
        if (c0 >= 1024) {
            const int isv = c0 >= 2048, cc = c0 - 1024 - 1024 * isv;
            if constexpr (!SMALL) { const int t = row & (SEQ - 1), b = row >> 12; if (t >= SEQ - 512) { GAS float* d = a.o0 + (size_t)isv * (O_CVP - O_CKP) + (size_t)(b * 512 + (t - (SEQ - 512))) * 1024 + cc; *(GAS f32x4*)d = v0; *(GAS f32x4*)(d + 4) = v1; } }
            else { const int r = row - TP; GAS float* d = a.o2 + (size_t)isv * (O_CVS - O_CKS) + (size_t)r * 1024 + cc; *(GAS f32x4*)d = v0; *(GAS f32x4*)(d + 4) = v1; }
        }
        return 0.f;
    } else if constexpr (MODE == 2) {
        const GAS float* bp = SMALL ? a.base_s + (size_t)(row - TP) * DM + c0 : a.base_p + (size_t)row * DM + c0;
        const f32x4 x0 = *(const GAS f32x4*)bp + v0, x1 = *(const GAS f32x4*)(bp + 4) + v1;
        GAS float* xp = a.X + (size_t)row * DM + c0; *(GAS f32x4*)xp = x0; *(GAS f32x4*)(xp + 4) = x1;
        u32x4 w; w.x = pk2(x0[0], x0[1]); w.y = pk2(x0[2], x0[3]); w.z = pk2(x1[0], x1[1]); w.w = pk2(x1[2], x1[3]);
        *(GAS u32x4*)(a.Xb + (size_t)row * DM + c0) = w;
        return ((x0[0] * x0[0] + x0[1] * x0[1]) + (x0[2] * x0[2] + x0[3] * x0[3])) + ((x1[0] * x1[0] + x1[1] * x1[1]) + (x1[2] * x1[2] + x1[3] * x1[3]));
    } else {
        v0 *= rstd; v1 *= rstd;
        float h[4];
#pragma unroll
        for (int j = 0; j < 4; ++j) h[j] = silu_f(v0[j]) * v1[j];
        u32x2 w; w.x = pk2(h[0], h[1]); w.y = pk2(h[2], h[3]);
        *(GAS u32x2*)(a.out + (size_t)row * DFF + 16 * g32 + 4 * fq) = w;
        return 0.f;
    }
}
constexpr int EA_OFF = 131072 + 512;
__device__ __forceinline__ EpiArgs load_ea(const LAS unsigned long long* ap) {
    EpiArgs a;
    a.out = (GAS bf16_t*)ap[0]; a.ssp = (const GAS float*)ap[1]; a.gates = (GAS float*)ap[2]; a.o0 = (GAS float*)ap[3]; a.o1 = (GAS float*)ap[4]; a.o2 = (GAS float*)ap[5]; a.o3 = (GAS float*)ap[6];
    a.base_p = (const GAS float*)ap[7]; a.base_s = (const GAS float*)ap[8]; a.X = (GAS float*)ap[9]; a.Xb = (GAS bf16_t*)ap[10]; a.ssp_out = (GAS float*)ap[11];
    return a;
}
template <int MODE> struct Epi {
    const LAS unsigned long long* ap;
    __device__ __forceinline__ void operator()(const f32x4 (&acc)[2][2][4][2], const pg8::Unit& u, int wr, int wc, int fr, int fq) const {
        const EpiArgs a = load_ea(ap);
#pragma unroll
        for (int ai = 0; ai < 2; ++ai)
#pragma unroll
            for (int m = 0; m < 4; ++m) {
                const int row = u.pm * 256 + ai * 128 + wr * 64 + m * 16 + fr;
                float rstd = 1.f; if constexpr (MODE != 2) rstd = row_rstd(a.ssp, row);
                float ss = 0.f;
#pragma unroll
                for (int bj = 0; bj < 2; ++bj) { const int g32 = (u.pn * 256 + bj * 128 + wc * 32) >> 5; ss += epi_apply<MODE, false>(a, row, g32, fq, acc[ai][bj][m][0], acc[ai][bj][m][1], rstd); }
                if constexpr (MODE == 2) { ss += __shfl_xor(ss, 16); ss += __shfl_xor(ss, 32); if (fq == 0) a.ssp_out[(size_t)row * 16 + u.pn * 4 + wc] = ss; }
            }
    }
};

template <int MODE>
__device__ __forceinline__ void small_gemm(const bf16_t* A, const bf16_t* Bt, int Npos, int K, const LAS unsigned long long* eap, LAS unsigned char* lds, int wg, int G, int wid, int lane) {
    const int fr = lane & 15, fq = lane >> 4, ncg = (MODE == 0 ? (ABIN + 63) / 64 : Npos / 64), nunits = (TS / 16) * ncg, KW = K / 8;
    LAS f32x4* part = (LAS f32x4*)lds;
    for (int u = wg; u < nunits; u += G) {
        const int rb = u % (TS / 16), cgp = u / (TS / 16), r0 = TP + rb * 16, p0 = cgp * 64;
        f32x4 acc[4];
#pragma unroll
        for (int f = 0; f < 4; ++f) acc[f] = (f32x4){0.f, 0.f, 0.f, 0.f};
        const bf16_t* ap = A + (size_t)(r0 + fr) * K + wid * KW + 8 * fq;
        const bf16_t* bp = Bt + (size_t)(p0 + fr) * K + wid * KW + 8 * fq;
        for (int k0 = 0; k0 < KW; k0 += 32) {
            const bf16x8 av = *(const bf16x8*)(ap + k0);
            bf16x8 wv[4];
#pragma unroll
            for (int f = 0; f < 4; ++f) wv[f] = *(const bf16x8*)(bp + (size_t)(16 * f) * K + k0);
#pragma unroll
            for (int f = 0; f < 4; ++f) acc[f] = __builtin_amdgcn_mfma_f32_16x16x32_bf16(wv[f], av, acc[f], 0, 0, 0);
        }
#pragma unroll
        for (int f = 0; f < 4; ++f) part[(wid * 4 + f) * 64 + lane] = acc[f];
        __syncthreads();
        if (wid == 0) {
#pragma unroll
            for (int w = 1; w < 8; ++w)
#pragma unroll
                for (int f = 0; f < 4; ++f) acc[f] += part[(w * 4 + f) * 64 + lane];
            const int row = r0 + fr;
            const EpiArgs a = load_ea(eap);
            float rstd = 1.f; if constexpr (MODE != 2) rstd = row_rstd(a.ssp, row);
            float ss = 0.f;
#pragma unroll
            for (int gq = 0; gq < 2; ++gq) ss += epi_apply<MODE, true>(a, row, (p0 >> 5) + gq, fq, acc[2 * gq], acc[2 * gq + 1], rstd);
            if constexpr (MODE == 2) { ss += __shfl_xor(ss, 16); ss += __shfl_xor(ss, 32); if (fq == 0) a.ssp_out[(size_t)row * 16 + cgp] = ss; }
        }
        __syncthreads();
    }
}

__device__ __forceinline__ void transpose_item(const float* W, int K, int Nsrc, int gu, const float* gamma, bf16_t* WT, LAS float* scr, int item, int npb, int lane) {
    const int kb = item / npb, nb = item % npb, k0 = 64 * kb, p0 = 32 * nb;
    const int cl = p0 + pg8::perm32(lane & 31);
    int src = cl; if (gu) src = ((cl >> 2) & 1) * DFF + 4 * (cl >> 3) + (cl & 3);
    const bool valid = src < Nsrc;
#pragma unroll 8
    for (int i = 0; i < 32; ++i) { const int kk = 2 * i + (lane >> 5); float v = 0.f; if (valid) { v = W[(size_t)(k0 + kk) * Nsrc + src]; if (gamma) v *= gamma[k0 + kk]; } scr[kk * 33 + (lane & 31)] = v; }
    asm volatile("s_waitcnt lgkmcnt(0)" ::: "memory");
    const int c = lane & 7;
#pragma unroll
    for (int j = 0; j < 4; ++j) { const int n = (lane >> 3) + 8 * j; const LAS float* s = scr + (8 * c) * 33 + n;
        u32x4 o; o.x = pk2(s[0 * 33], s[1 * 33]); o.y = pk2(s[2 * 33], s[3 * 33]); o.z = pk2(s[4 * 33], s[5 * 33]); o.w = pk2(s[6 * 33], s[7 * 33]);
        *(u32x4*)(WT + (size_t)(p0 + n) * K + k0 + 8 * c) = o; }
    asm volatile("s_waitcnt lgkmcnt(0)" ::: "memory");
}
__device__ __forceinline__ void convert_matrix(const float* W, int K, int Nsrc, int Npos, int gu, const float* gamma, bf16_t* WT, LAS float* scr, int gw, int ngw, int lane) {
    const int npb = Npos / 32, nitems = (K / 64) * npb;
    for (int it = gw; it < nitems; it += ngw) transpose_item(W, K, Nsrc, gu, gamma, WT, scr, it, npb, lane);
}
__device__ __forceinline__ void phase_prologue(const Params& P, LAS unsigned char* lds, int gw, int ngw, int wid, int lane) {
    LAS float* scr = (LAS float*)(lds + wid * 8704);
    unsigned char* ws = P.ws;
    for (int i = 0; i < 2; ++i) {
        convert_matrix(P.in[8] + (size_t)i * 1024 * ABIN, 1024, ABIN, ABPAD, 0, P.in[7] + i * 1024, (bf16_t*)(ws + WS_WIN + i * SZ_WIN), scr, gw, ngw, lane);
        convert_matrix(P.in[16] + (size_t)i * 1024 * 1024, 1024, 1024, 1024, 0, nullptr, (bf16_t*)(ws + WS_WOUT + i * SZ_W1K), scr, gw, ngw, lane);
        convert_matrix(P.in[18] + (size_t)i * 1024 * NQKV, 1024, NQKV, NQKV, 0, P.in[17] + i * 1024, (bf16_t*)(ws + WS_WQKV + i * SZ_WQKV), scr, gw, ngw, lane);
        convert_matrix(P.in[20] + (size_t)i * 1024 * 1024, 1024, 1024, 1024, 0, nullptr, (bf16_t*)(ws + WS_WCOUT + i * SZ_W1K), scr, gw, ngw, lane);
    }
    for (int l = 0; l < 4; ++l) {
        convert_matrix(P.in[22] + (size_t)l * 1024 * NGU, 1024, NGU, NGU, 1, P.in[21] + l * 1024, (bf16_t*)(ws + WS_WGU + l * SZ_WGU), scr, gw, ngw, lane);
        convert_matrix(P.in[23] + (size_t)l * DFF * 1024, DFF, 1024, 1024, 0, nullptr, (bf16_t*)(ws + WS_WDN + l * SZ_WDN), scr, gw, ngw, lane);
    }
    bf16_t* Xb = (bf16_t*)(ws + WS_XB); float* ssp = (float*)(ws + WS_SSP);
    for (int row = gw; row < TR; row += ngw) {
        const float* xr = (row < TP) ? P.in[0] + (size_t)row * DM : P.in[1] + (size_t)(row - TP) * DM;
        f32x4 v[4]; float s = 0.f;
#pragma unroll
        for (int j = 0; j < 4; ++j) { v[j] = ((const f32x4*)xr)[lane + 64 * j]; s += (v[j][0] * v[j][0] + v[j][1] * v[j][1]) + (v[j][2] * v[j][2] + v[j][3] * v[j][3]); }
        s = wave_sum(s);
#pragma unroll
        for (int j = 0; j < 4; ++j) { u32x2 w; w.x = pk2(v[j][0], v[j][1]); w.y = pk2(v[j][2], v[j][3]); ((u32x2*)(Xb + (size_t)row * DM))[lane + 64 * j] = w; }
        if (lane < 16) ssp[(size_t)row * 16 + lane] = (lane == 0) ? s : 0.f;
    }
}
__device__ __forceinline__ void phase_final(const Params& P, int gw, int ngw, int lane) {
    const GAS float* ssp = (const GAS float*)(P.ws + WS_SSP); const float* g = P.in[24];
    f32x4 gv[4];
#pragma unroll
    for (int j = 0; j < 4; ++j) gv[j] = ((const f32x4*)g)[lane + 64 * j];
    for (int row = gw; row < TR; row += ngw) {
        const float rstd = row_rstd(ssp, row);
        f32x4* xr = (f32x4*)(P.out + (size_t)row * DM);
#pragma unroll
        for (int j = 0; j < 4; ++j) { f32x4 v = xr[lane + 64 * j]; xr[lane + 64 * j] = v * rstd * gv[j]; }
    }
}

constexpr int MX_CH = 32;
__device__ __forceinline__ void delta_unit(const Params& P, LAS unsigned char* lds, int li, bool sample, int b, int h, const int tid) {
    const int lane = tid & 63, wid = __builtin_amdgcn_readfirstlane(tid >> 6);
    const int L = sample ? SSEQ : SEQ, rowbase = sample ? TP + b * SSEQ : b * SEQ;
    const bf16_t* PROJ = (const bf16_t*)(P.ws + WS_R1); const float* GATES = (const float*)(P.ws + WS_GATES); bf16_t* MIX = (bf16_t*)(P.ws + WS_MIX);
    const int NC = (L + MX_CH - 1) / MX_CH;
    constexpr int SET = 4 * 8192 + 256;
    if (wid < 4) __builtin_amdgcn_s_setprio(2);
    const int e = (wid & 3) * 16 + (lane >> 2), dq = lane & 3;
    f32x2 S[8];
    float* sout = P.out + (sample ? O_DNS : O_DNP) + (size_t)((li * 8 + b) * 8 + h) * 4096;
    if (wid < 4) {
        if (sample) { const float* s0 = P.in[3] + (size_t)((li * 8 + b) * 8 + h) * 4096;
#pragma unroll
            for (int j = 0; j < 8; ++j) { S[j][0] = s0[(16 * dq + 2 * j) * 64 + e]; S[j][1] = s0[(16 * dq + 2 * j + 1) * 64 + e]; } }
        else {
#pragma unroll
            for (int j = 0; j < 8; ++j) S[j] = (f32x2){0.f, 0.f}; }
    }
    const int pw = wid - 4, c = lane;
    float cwq[4], cwk[4], cwv[4], onorm = 0.f, alog = 0.f, dtb = 0.f;
    if (wid >= 4) {
        const float* cw = P.in[9] + (size_t)li * 4 * DNQKV;
#pragma unroll
        for (int t = 0; t < 4; ++t) { cwq[t] = cw[t * DNQKV + h * 64 + c]; cwk[t] = cw[t * DNQKV + 512 + h * 64 + c]; cwv[t] = cw[t * DNQKV + 1024 + h * 64 + c]; }
        onorm = P.in[12][li * 64 + c]; alog = P.in[10][li * 8 + h]; dtb = P.in[11][li * 8 + h];
    }
    for (int j = 0; j < NC + 2; ++j) {
        if (wid >= 4) {
            if (j < NC) {
                LAS float* qs = (LAS float*)(lds + (j & 1) * SET); LAS float* ks = qs + 2048; LAS float* vs = qs + 4096; LAS float* sc = qs + 8192;
                const int t0 = j * MX_CH + pw * 8;
                if (t0 < L) {
                    float rq[11], rk[11], rv[11];
#pragma unroll
                    for (int r = 0; r < 11; ++r) {
                        const int t = t0 - 3 + r, tc = max(t, 0);
                        const bf16_t* pr = PROJ + (size_t)(rowbase + tc) * ABIN + h * 64 + c;
                        const float m = (t >= 0) ? 1.f : 0.f;
                        rq[r] = bf2f(pr[0]) * m; rk[r] = bf2f(pr[512]) * m; rv[r] = bf2f(pr[1024]) * m;
                    }
                    if (sample && t0 == 0) {
#pragma unroll
                        for (int r = 0; r < 3; ++r) { const float* cb = P.in[2] + (size_t)((li * 8 + b) * 3 + r) * DNQKV + h * 64 + c; rq[r] = cb[0]; rk[r] = cb[512]; rv[r] = cb[1024]; }
                    }
                    float ga = 0.f, gb = 0.f;
                    if (lane < 8) { const float* gp = GATES + (size_t)(rowbase + t0 + lane) * 32; ga = gp[h]; gb = gp[8 + h]; }
#pragma unroll
                    for (int i = 0; i < 8; ++i) {
                        float q = cwq[0] * rq[i] + cwq[1] * rq[i + 1] + cwq[2] * rq[i + 2] + cwq[3] * rq[i + 3];
                        float k = cwk[0] * rk[i] + cwk[1] * rk[i + 1] + cwk[2] * rk[i + 2] + cwk[3] * rk[i + 3];
                        float v = cwv[0] * rv[i] + cwv[1] * rv[i + 1] + cwv[2] * rv[i + 2] + cwv[3] * rv[i + 3];
                        q = silu_f(q); k = silu_f(k); v = silu_f(v);
                        const float sq = wave_sum(q * q), sk = wave_sum(k * k);
                        const int tok = pw * 8 + i;
                        qs[tok * 64 + c] = q * rsqrtf(sq + EPS) * 0.125f; ks[tok * 64 + c] = k * rsqrtf(sk + EPS); vs[tok * 64 + c] = v;
                    }
                    if (lane < 8) { const float g = -__expf(alog) * softplus_f(ga + dtb); sc[(pw * 8 + lane) * 2] = __expf(g); sc[(pw * 8 + lane) * 2 + 1] = sigmoid_f(gb); }
                }
            }
            if (j >= 2) {
                LAS float* os = (LAS float*)(lds + (j & 1) * SET) + 6144;
                const int t0 = (j - 2) * MX_CH + pw * 8;
                if (t0 < L) {
#pragma unroll
                    for (int i = 0; i < 8; ++i) {
                        const int tok = pw * 8 + i; const size_t row = (size_t)(rowbase + t0 + i);
                        MIX[row * DM + h * 64 + c] = (bf16_t)f2bf(os[tok * 64 + c]);
                    }
                }
            }
        } else if (j >= 1 && j <= NC) {
            LAS float* qs = (LAS float*)(lds + ((j - 1) & 1) * SET); LAS float* ks = qs + 2048; LAS float* vs = qs + 4096; LAS float* os = qs + 6144; LAS float* sc = qs + 8192;
            const int ntok = min(MX_CH, L - (j - 1) * MX_CH);
            f32x4 kk[4], qq[4]; float ve; f32x2 gb;
#pragma unroll
            for (int i = 0; i < 4; ++i) { kk[i] = *(const LAS f32x4*)(ks + 16 * dq + 4 * i); qq[i] = *(const LAS f32x4*)(qs + 16 * dq + 4 * i); }
            ve = vs[e]; gb = *(const LAS f32x2*)(sc);
            for (int tok = 0; tok < ntok; ++tok) {
                const int tn = min(tok + 1, ntok - 1);
                f32x4 kn[4], qn[4];
#pragma unroll
                for (int i = 0; i < 4; ++i) { kn[i] = *(const LAS f32x4*)(ks + tn * 64 + 16 * dq + 4 * i); qn[i] = *(const LAS f32x4*)(qs + tn * 64 + 16 * dq + 4 * i); }
                const float vn = vs[tn * 64 + e]; const f32x2 gn = *(const LAS f32x2*)(sc + tn * 2);
                const float eg = gb[0], beta = gb[1];
                f32x2 wa[4];
#pragma unroll
                for (int i = 0; i < 4; ++i) wa[i] = (f32x2){kk[i][0], kk[i][1]} * S[2 * i] + (f32x2){kk[i][2], kk[i][3]} * S[2 * i + 1];
                const f32x2 ws2 = (wa[0] + wa[1]) + (wa[2] + wa[3]);
                const float w = quad_sum(ws2[0] + ws2[1]);
                const float dl = beta * (ve - eg * w);
                const f32x2 eg2 = (f32x2){eg, eg}, dl2 = (f32x2){dl, dl};
                f32x2 oa[4];
#pragma unroll
                for (int i = 0; i < 4; ++i) {
                    S[2 * i] = S[2 * i] * eg2 + (f32x2){kk[i][0], kk[i][1]} * dl2; S[2 * i + 1] = S[2 * i + 1] * eg2 + (f32x2){kk[i][2], kk[i][3]} * dl2;
                    oa[i] = (f32x2){qq[i][0], qq[i][1]} * S[2 * i] + (f32x2){qq[i][2], qq[i][3]} * S[2 * i + 1];
                }
                const f32x2 os2 = (oa[0] + oa[1]) + (oa[2] + oa[3]);
                const float o = quad_sum(os2[0] + os2[1]);
                if (dq == 0) os[tok * 64 + e] = o;
#pragma unroll
                for (int i = 0; i < 4; ++i) { kk[i] = kn[i]; qq[i] = qn[i]; }
                ve = vn; gb = gn;
            }
        }
        __syncthreads();
    }
    if (wid < 4) {
#pragma unroll
        for (int j = 0; j < 8; ++j) { sout[(16 * dq + 2 * j) * 64 + e] = S[j][0]; sout[(16 * dq + 2 * j + 1) * 64 + e] = S[j][1]; }
    }
    __builtin_amdgcn_s_setprio(0);
}

__device__ __forceinline__ void gla_unit(const Params& P, LAS unsigned char* lds, int li, bool sample, int b, int h, const int tid) {
    const int lane = tid & 63, wid = __builtin_amdgcn_readfirstlane(tid >> 6);
    const int L = sample ? SSEQ : SEQ, rowbase = sample ? TP + b * SSEQ : b * SEQ;
    const bf16_t* PROJ = (const bf16_t*)(P.ws + WS_R1); const float* GATES = (const float*)(P.ws + WS_GATES); bf16_t* MIX = (bf16_t*)(P.ws + WS_MIX);
    const int NC = (L + MX_CH - 1) / MX_CH;
    constexpr int SET = 3 * 4096 + 2 * 8192;
    if (wid < 4) __builtin_amdgcn_s_setprio(2);
    const int e = (wid & 3) * 16 + (lane >> 2), dq = lane & 3;
    f32x2 S[4];
    float* sout = P.out + (sample ? O_GLAS : O_GLAP) + (size_t)((li * 8 + b) * 8 + h) * 2048;
    if (wid < 4) {
        if (sample) { const float* s0 = P.in[4] + (size_t)((li * 8 + b) * 8 + h) * 2048;
#pragma unroll
            for (int j = 0; j < 4; ++j) { S[j][0] = s0[(8 * dq + 2 * j) * 64 + e]; S[j][1] = s0[(8 * dq + 2 * j + 1) * 64 + e]; } }
        else {
#pragma unroll
            for (int j = 0; j < 4; ++j) S[j] = (f32x2){0.f, 0.f}; }
    }
    const int pw = wid - 4, c = lane, c32 = lane & 31;
    float w2[16], gkb = 0.f, onorm = 0.f;
    if (wid >= 4) {
#pragma unroll
        for (int r = 0; r < 16; ++r) w2[r] = P.in[13][(size_t)(li * 16 + r) * 256 + h * 32 + c32];
        gkb = P.in[14][li * 256 + h * 32 + c32]; onorm = P.in[15][li * 64 + c];
    }
    for (int j = 0; j < NC + 2; ++j) {
        if (wid >= 4) {
            if (j < NC) {
                LAS float* qs = (LAS float*)(lds + (j & 1) * SET); LAS float* ks = qs + 1024; LAS float* gs = qs + 2048; LAS float* vs = qs + 3072;
                const int t0 = j * MX_CH + pw * 8;
                if (t0 < L) {
#pragma unroll
                    for (int i = 0; i < 8; ++i) {
                        const int tok = pw * 8 + i; const size_t row = (size_t)(rowbase + t0 + i);
                        const bf16_t* pr = PROJ + row * ABIN;
                        vs[tok * 64 + c] = bf2f(pr[2576 + h * 64 + c]);
                        const float* lr = GATES + row * 32 + 16;
                        float z = gkb;
#pragma unroll
                        for (int r = 0; r < 16; ++r) z += lr[r] * w2[r];
                        const float ls = -softplus_f(-z);
                        if (lane < 32) { qs[tok * 32 + c32] = bf2f(pr[2064 + h * 32 + c32]) * 0.17677669529663687f; ks[tok * 32 + c32] = bf2f(pr[2320 + h * 32 + c32]); gs[tok * 32 + c32] = __expf(ls * (1.0f / 16.0f)); }
                    }
                }
            }
            if (j >= 2) {
                LAS float* os = (LAS float*)(lds + (j & 1) * SET) + 3072 + 2048;
                const int t0 = (j - 2) * MX_CH + pw * 8;
                if (t0 < L) {
#pragma unroll
                    for (int i = 0; i < 8; ++i) {
                        const int tok = pw * 8 + i; const size_t row = (size_t)(rowbase + t0 + i);
                        MIX[row * DM + 512 + h * 64 + c] = (bf16_t)f2bf(os[tok * 64 + c]);
                    }
                }
            }
        } else if (j >= 1 && j <= NC) {
            LAS float* qs = (LAS float*)(lds + ((j - 1) & 1) * SET); LAS float* ks = qs + 1024; LAS float* gs = qs + 2048; LAS float* vs = qs + 3072; LAS float* os = qs + 3072 + 2048;
            const int ntok = min(MX_CH, L - (j - 1) * MX_CH);
            f32x4 kk[2], qq[2], gg[2]; float ve;
#pragma unroll
            for (int i = 0; i < 2; ++i) { kk[i] = *(const LAS f32x4*)(ks + 8 * dq + 4 * i); qq[i] = *(const LAS f32x4*)(qs + 8 * dq + 4 * i); gg[i] = *(const LAS f32x4*)(gs + 8 * dq + 4 * i); }
            ve = vs[e];
            for (int tok = 0; tok < ntok; ++tok) {
                const int tn = min(tok + 1, ntok - 1);
                f32x4 kn[2], qn[2], gn[2];
#pragma unroll
                for (int i = 0; i < 2; ++i) { kn[i] = *(const LAS f32x4*)(ks + tn * 32 + 8 * dq + 4 * i); qn[i] = *(const LAS f32x4*)(qs + tn * 32 + 8 * dq + 4 * i); gn[i] = *(const LAS f32x4*)(gs + tn * 32 + 8 * dq + 4 * i); }
                const float vn = vs[tn * 64 + e];
                const f32x2 v2 = (f32x2){ve, ve};
                f32x2 oa[2];
#pragma unroll
                for (int i = 0; i < 2; ++i) {
                    S[2 * i] = S[2 * i] * (f32x2){gg[i][0], gg[i][1]} + (f32x2){kk[i][0], kk[i][1]} * v2; S[2 * i + 1] = S[2 * i + 1] * (f32x2){gg[i][2], gg[i][3]} + (f32x2){kk[i][2], kk[i][3]} * v2;
                    oa[i] = (f32x2){qq[i][0], qq[i][1]} * S[2 * i] + (f32x2){qq[i][2], qq[i][3]} * S[2 * i + 1];
                }
                const f32x2 os2 = oa[0] + oa[1];
                const float o = quad_sum(os2[0] + os2[1]);
                if (dq == 0) os[tok * 64 + e] = o;
#pragma unroll
                for (int i = 0; i < 2; ++i) { kk[i] = kn[i]; qq[i] = qn[i]; gg[i] = gn[i]; }
                ve = vn;
            }
        }
        __syncthreads();
    }
    if (wid < 4) {
#pragma unroll
        for (int j = 0; j < 4; ++j) { sout[(8 * dq + 2 * j) * 64 + e] = S[j][0]; sout[(8 * dq + 2 * j + 1) * 64 + e] = S[j][1]; }
    }
    __builtin_amdgcn_s_setprio(0);
}

__device__ __forceinline__ void phase_fixup(const Params& P, int li, int gw, int ngw, int lane) {
    bf16_t* MIX = (bf16_t*)(P.ws + WS_MIX); const bf16_t* PROJ = (const bf16_t*)(P.ws + WS_R1);
    const float* on = (lane < 32 ? P.in[12] : P.in[15]) + li * 64 + 16 * (lane & 3);
    float g[16];
#pragma unroll
    for (int j = 0; j < 16; ++j) g[j] = on[j];
    const int gcol = (lane < 32) ? 1552 + 16 * lane : 3104 + 16 * (lane - 32);
    for (int row = gw; row < TR; row += ngw) {
        u32x4* mp = (u32x4*)(MIX + (size_t)row * DM + 16 * lane);
        const u32x4* gp = (const u32x4*)(PROJ + (size_t)row * ABIN + gcol);
        const u32x4 m0 = mp[0], m1 = mp[1], g0 = gp[0], g1 = gp[1];
        float o[16], gt[16];
#pragma unroll
        for (int j = 0; j < 4; ++j) { o[2 * j] = __builtin_bit_cast(float, m0[j] << 16); o[2 * j + 1] = __builtin_bit_cast(float, m0[j] & 0xffff0000u); o[8 + 2 * j] = __builtin_bit_cast(float, m1[j] << 16); o[8 + 2 * j + 1] = __builtin_bit_cast(float, m1[j] & 0xffff0000u);
            gt[2 * j] = __builtin_bit_cast(float, g0[j] << 16); gt[2 * j + 1] = __builtin_bit_cast(float, g0[j] & 0xffff0000u); gt[8 + 2 * j] = __builtin_bit_cast(float, g1[j] << 16); gt[8 + 2 * j + 1] = __builtin_bit_cast(float, g1[j] & 0xffff0000u); }
        float ss = 0.f;
#pragma unroll
        for (int j = 0; j < 16; ++j) ss += o[j] * o[j];
        ss = quad_sum(ss);
        const float rstd = rsqrtf(ss * (1.0f / 64.0f) + EPS);
        float r[16];
#pragma unroll
        for (int j = 0; j < 16; ++j) r[j] = o[j] * rstd * g[j] * silu_f(gt[j]);
        u32x4 w0, w1;
#pragma unroll
        for (int j = 0; j < 4; ++j) { w0[j] = pk2(r[2 * j], r[2 * j + 1]); w1[j] = pk2(r[8 + 2 * j], r[8 + 2 * j + 1]); }
        mp[0] = w0; mp[1] = w1;
    }
}

constexpr int AT_KOFF = 0, AT_VOFF = 2 * 9216, AT_TAB = 4 * 9216;
__device__ __forceinline__ int vpos(int kv) { return 16 * (kv >> 4) + 8 * ((kv >> 2) & 1) + 4 * ((kv >> 3) & 1) + (kv & 3); }
__device__ __forceinline__ void attn_prompt_unit(const Params& P, LAS unsigned char* lds, int li, int b, int h, int g4, const int tid) {
    const int lane = tid & 63, wid = __builtin_amdgcn_readfirstlane(tid >> 6), r32 = lane & 31, hi = lane >> 5;
    const bf16_t* QKV = (const bf16_t*)(P.ws + WS_R1); bf16_t* MIX = (bf16_t*)(P.ws + WS_MIX);
    const int cw = 4 * g4 + (wid >> 1);
    const size_t qrow = (size_t)b * SEQ + 256 * g4 + 32 * wid + r32;
    bf16x8 qr[4];
#pragma unroll
    for (int d0 = 0; d0 < 4; ++d0) qr[d0] = *(const bf16x8*)(QKV + qrow * NQKV + h * 64 + d0 * 16 + hi * 8);
    LAS float* tab = (LAS float*)(lds + AT_TAB);
    if (tid < 257) tab[tid] = P.in[19][(size_t)(li * 16 + h) * 257 + tid] * LOG2E;
    const int kt_lo = max(0, 4 * g4 - 8), kt_hi = 4 * g4 + 3;
    const int srow = tid >> 3, sch = tid & 7;
    const bf16_t* kvsrc = QKV + ((size_t)b * SEQ + srow) * NQKV + 1024 + h * 64 + 8 * sch;
    const int vp = vpos(srow);
    bf16x8 kreg, vreg;
#define AT_LOAD(kt) do { const bf16_t* s_ = kvsrc + (size_t)(kt) * 64 * NQKV; kreg = *(const bf16x8*)s_; vreg = *(const bf16x8*)(s_ + 1024); } while (0)
#define AT_STORE(buf) do { *(LAS bf16x8*)(lds + AT_KOFF + (buf) * 9216 + srow * 144 + sch * 16) = kreg; \
        _Pragma("unroll") for (int j_ = 0; j_ < 8; ++j_) *(LAS short*)(lds + AT_VOFF + (buf) * 9216 + (8 * sch + j_) * 144 + vp * 2) = vreg[j_]; } while (0)
    AT_LOAD(kt_lo); AT_STORE(0);
    __syncthreads();
    float m = -1e30f, l = 0.f; f32x16 o[2];
#pragma unroll
    for (int r = 0; r < 16; ++r) { o[0][r] = 0.f; o[1][r] = 0.f; }
    const float C2 = 0.125f * LOG2E;
    const int qi = 32 * (wid & 1) + r32;
    for (int kt = kt_lo; kt <= kt_hi; ++kt) {
        const int cur = (kt - kt_lo) & 1;
        if (kt < kt_hi) AT_LOAD(kt + 1);
        if (kt >= cw - 8 && kt <= cw) {
            const LAS unsigned char* Kb = lds + AT_KOFF + cur * 9216; const LAS unsigned char* Vb = lds + AT_VOFF + cur * 9216;
            f32x16 p0, p1;
#pragma unroll
            for (int r = 0; r < 16; ++r) { p0[r] = 0.f; p1[r] = 0.f; }
#pragma unroll
            for (int d0 = 0; d0 < 4; ++d0) {
                const bf16x8 a0 = *(const LAS bf16x8*)(Kb + r32 * 144 + d0 * 32 + hi * 16);
                const bf16x8 a1 = *(const LAS bf16x8*)(Kb + (32 + r32) * 144 + d0 * 32 + hi * 16);
                p0 = __builtin_amdgcn_mfma_f32_32x32x16_bf16(a0, qr[d0], p0, 0, 0, 0);
                p1 = __builtin_amdgcn_mfma_f32_32x32x16_bf16(a1, qr[d0], p1, 0, 0, 0);
            }
            const int dist = cw - kt;
            if (dist >= 3) { const float bf = tab[256];
#pragma unroll
                for (int r = 0; r < 16; ++r) { p0[r] = p0[r] * C2 + bf; p1[r] = p1[r] * C2 + bf; } }
            else {
#pragma unroll
                for (int r = 0; r < 16; ++r) { const int kv = (r & 3) + 8 * (r >> 2) + 4 * hi; const int rel = qi - kv + 64 * dist;
                    p0[r] = p0[r] * C2 + tab[min(rel, 128) + 128]; p1[r] = p1[r] * C2 + tab[min(rel - 32, 128) + 128]; } }
            float mx = p0[0];
#pragma unroll
            for (int r = 1; r < 16; ++r) mx = fmaxf(mx, p0[r]);
#pragma unroll
            for (int r = 0; r < 16; ++r) mx = fmaxf(mx, p1[r]);
            mx = fmaxf(mx, __shfl_xor(mx, 32));
            const float mn = fmaxf(m, mx), scl = __builtin_amdgcn_exp2f(m - mn); m = mn;
            float ls = 0.f;
#pragma unroll
            for (int r = 0; r < 16; ++r) { p0[r] = __builtin_amdgcn_exp2f(p0[r] - mn); p1[r] = __builtin_amdgcn_exp2f(p1[r] - mn); ls += p0[r] + p1[r]; }
            l = l * scl + ls;
#pragma unroll
            for (int r = 0; r < 16; ++r) { o[0][r] *= scl; o[1][r] *= scl; }
            u32x4 pw[4];
#pragma unroll
            for (int s = 0; s < 2; ++s) {
                pw[s] = (u32x4){pk2(p0[8 * s], p0[8 * s + 1]), pk2(p0[8 * s + 2], p0[8 * s + 3]), pk2(p0[8 * s + 4], p0[8 * s + 5]), pk2(p0[8 * s + 6], p0[8 * s + 7])};
                pw[2 + s] = (u32x4){pk2(p1[8 * s], p1[8 * s + 1]), pk2(p1[8 * s + 2], p1[8 * s + 3]), pk2(p1[8 * s + 4], p1[8 * s + 5]), pk2(p1[8 * s + 6], p1[8 * s + 7])};
            }
#pragma unroll
            for (int dh = 0; dh < 2; ++dh)
#pragma unroll
                for (int ks = 0; ks < 4; ++ks) {
                    const bf16x8 vf = *(const LAS bf16x8*)(Vb + (32 * dh + r32) * 144 + (16 * ks + 8 * hi) * 2);
                    o[dh] = __builtin_amdgcn_mfma_f32_32x32x16_bf16(vf, __builtin_bit_cast(bf16x8, pw[ks]), o[dh], 0, 0, 0);
                }
        }
        if (kt < kt_hi) AT_STORE(cur ^ 1);
        __syncthreads();
    }
#undef AT_LOAD
#undef AT_STORE
    l += __shfl_xor(l, 32);
    const float rl = 1.0f / l;
    bf16_t* op = MIX + qrow * DM + h * 64;
#pragma unroll
    for (int dh = 0; dh < 2; ++dh)
#pragma unroll
        for (int r4 = 0; r4 < 4; ++r4) {
            u32x2 w; w.x = pk2(o[dh][4 * r4] * rl, o[dh][4 * r4 + 1] * rl); w.y = pk2(o[dh][4 * r4 + 2] * rl, o[dh][4 * r4 + 3] * rl);
            *(u32x2*)(op + 32 * dh + 8 * r4 + 4 * hi) = w;
        }
}
__device__ __forceinline__ void attn_sample_unit(const Params& P, LAS unsigned char* lds, int li, int b, int h, const int tid) {
    const int lane = tid & 63, wid = tid >> 6;
    const bf16_t* QKV = (const bf16_t*)(P.ws + WS_R1); bf16_t* MIX = (bf16_t*)(P.ws + WS_MIX);
    LAS float* qs = (LAS float*)lds;
    LAS float* sc = qs + 1024;
    LAS float* tab = sc + 16 * 528;
    const size_t rb = (size_t)TP + b * SSEQ;
    for (int i = tid; i < 1024; i += 512) qs[i] = bf2f(QKV[(rb + (i >> 6)) * NQKV + h * 64 + (i & 63)]);
    if (tid < 257) tab[tid] = P.in[19][(size_t)(li * 16 + h) * 257 + tid];
    __syncthreads();
    const float* kc = P.in[5] + ((size_t)(li * 8 + b) * 512) * 1024 + h * 64;
    const float* vc = P.in[6] + ((size_t)(li * 8 + b) * 512) * 1024 + h * 64;
    for (int j = tid; j < 528; j += 512) {
        float kr[64];
        if (j < 512) {
#pragma unroll
            for (int d = 0; d < 16; ++d) { const f32x4 t = *(const f32x4*)(kc + (size_t)j * 1024 + 4 * d); kr[4 * d] = t[0]; kr[4 * d + 1] = t[1]; kr[4 * d + 2] = t[2]; kr[4 * d + 3] = t[3]; }
        } else {
#pragma unroll
            for (int d = 0; d < 64; ++d) kr[d] = bf2f(QKV[(rb + (j - 512)) * NQKV + 1024 + h * 64 + d]);
        }
        for (int q = 0; q < 16; ++q) {
            float s = 0.f;
#pragma unroll
            for (int d = 0; d < 64; ++d) s += qs[q * 64 + d] * kr[d];
            const int rel = (j < 512) ? (512 + q - j) : (q - (j - 512));
            sc[q * 528 + j] = s * 0.125f + tab[min(max(rel, -128), 128) + 128];
        }
    }
    __syncthreads();
    for (int q = 2 * wid; q < 2 * wid + 2; ++q) {
        float mx = -1e30f;
        for (int j = lane; j < 528; j += 64) mx = fmaxf(mx, sc[q * 528 + j]);
#pragma unroll
        for (int o = 1; o < 64; o <<= 1) mx = fmaxf(mx, __shfl_xor(mx, o));
        float sm = 0.f;
        for (int j = lane; j < 528; j += 64) { const float p = __expf(sc[q * 528 + j] - mx); sc[q * 528 + j] = p; sm += p; }
        sm = wave_sum(sm);
        const float inv = 1.0f / sm;
        for (int j = lane; j < 528; j += 64) sc[q * 528 + j] *= inv;
    }
    __syncthreads();
    {
        const int q = tid >> 5, d = 2 * (tid & 31);
        float a0 = 0.f, a1 = 0.f;
        for (int j = 0; j < 512; ++j) { const f32x2 v = *(const f32x2*)(vc + (size_t)j * 1024 + d); const float p = sc[q * 528 + j]; a0 += p * v[0]; a1 += p * v[1]; }
        for (int j = 0; j < 16; ++j) { const bf16_t* vp = QKV + (rb + j) * NQKV + 2048 + h * 64 + d; const float p = sc[q * 528 + 512 + j]; a0 += p * bf2f(vp[0]); a1 += p * bf2f(vp[1]); }
        *(unsigned*)(MIX + (rb + q) * DM + h * 64 + d) = pk2(a0, a1);
    }
    __syncthreads();
}

__global__ void __launch_bounds__(512, 2) hybrid_fwd(Params P) {
    extern __shared__ __attribute__((aligned(16))) unsigned char lds_raw[];
    LAS unsigned char* lds = (LAS unsigned char*)lds_raw;
    const int G = gridDim.x;
    int ph = P.ph_lo, rep = 0;
    while (ph < P.ph_hi) {
        int tid = threadIdx.x; asm volatile("" : "+v"(tid));
        int wg = blockIdx.x; asm volatile("" : "+s"(wg));
        const Params& Q = P;
        const int lane = tid & 63, wid = __builtin_amdgcn_readfirstlane(tid >> 6), gw = wg * 8 + wid, ngw = G * 8;
        unsigned char* ws = Q.ws;
        bf16_t* Xb = (bf16_t*)(ws + WS_XB); bf16_t* R1 = (bf16_t*)(ws + WS_R1); bf16_t* MIX = (bf16_t*)(ws + WS_MIX);
        float* GATES = (float*)(ws + WS_GATES); float* SSP = (float*)(ws + WS_SSP);
        int nrep = 1;
        if (ph == 0) nrep = REP_PRO; else if (ph != NPHASE - 1) { const int q_ = (ph - 1) % 11; if (q_ == 1) nrep = REP_MIX; else if (q_ == 7) nrep = REP_ATT; else if (q_ == 0 || q_ == 4 || q_ == 6 || q_ == 9) nrep = REP_PROJ; }
        if (ph == 0) phase_prologue(Q, lds, gw, ngw, wid, lane);
        else if (ph == NPHASE - 1) phase_final(Q, gw, ngw, lane);
        else {
            int layer, sub;
            { const int r_ = ph - 1, pair_ = r_ / 11, q_ = r_ % 11; if (q_ < 6) { layer = 2 * pair_; sub = (q_ < 2) ? q_ : (q_ == 2 ? 5 : q_ - 1); } else { layer = 2 * pair_ + 1; sub = q_ - 6; } }
            const int li = layer >> 1, odd = layer & 1;
            if (sub == 5) phase_fixup(Q, li, gw, ngw, lane);
            else if (sub == 1) {
                if (!odd) {
                    const int role = wg >> 6, u = wg & 63;
                    if (G == 256) {
                        if (role == 0) delta_unit(Q, lds, li, false, u >> 3, u & 7, tid);
                        else if (role == 1) gla_unit(Q, lds, li, false, u >> 3, u & 7, tid);
                        else if (role == 2) delta_unit(Q, lds, li, true, u >> 3, u & 7, tid);
                        else gla_unit(Q, lds, li, true, u >> 3, u & 7, tid);
                    }
                } else {
                    for (int u = wg * 8; u < wg * 8 + 8; ++u) attn_prompt_unit(Q, lds, li, u >> 8, (u >> 4) & 15, u & 15, tid);
                    if (wg < 128) attn_sample_unit(Q, lds, li, wg >> 4, wg & 15, tid);
                }
            } else {
                pg8::Gemm g; int mode, Npos;
                g.M = TP;
                LAS unsigned long long* eap = (LAS unsigned long long*)(lds + EA_OFF);
#define EA_SET(i, p) eap[i] = (unsigned long long)(p)
                if (sub == 0) {
                    g.A = Xb; g.K = 1024;
                    if (!odd) { mode = 0; Npos = ABPAD; g.Bt = (const bf16_t*)(ws + WS_WIN + li * SZ_WIN);
                        if (tid == 0) { EA_SET(0, R1); EA_SET(1, SSP); EA_SET(2, GATES); EA_SET(3, Q.out + O_CONVP + (size_t)li * 8 * 3 * DNQKV); EA_SET(4, Q.out + O_CONVS + (size_t)li * 8 * 3 * DNQKV); } }
                    else { mode = 1; Npos = NQKV; g.Bt = (const bf16_t*)(ws + WS_WQKV + li * SZ_WQKV);
                        if (tid == 0) { EA_SET(0, R1); EA_SET(1, SSP); EA_SET(3, Q.out + O_CKP + (size_t)li * 8 * 512 * 1024); EA_SET(4, Q.out + O_CVP + (size_t)li * 8 * 512 * 1024); EA_SET(5, Q.out + O_CKS + (size_t)li * 8 * 16 * 1024); EA_SET(6, Q.out + O_CVS + (size_t)li * 8 * 16 * 1024); } }
                } else if (sub == 2) {
                    mode = 2; Npos = 1024; g.A = MIX; g.K = 1024; g.Bt = (const bf16_t*)(ws + (odd ? WS_WCOUT : WS_WOUT) + li * SZ_W1K);
                    if (tid == 0) { EA_SET(7, (layer == 0) ? Q.in[0] : Q.out); EA_SET(8, (layer == 0) ? Q.in[1] : Q.out + (size_t)TP * DM); EA_SET(9, Q.out); EA_SET(10, Xb); EA_SET(11, SSP); }
                } else if (sub == 3) {
                    mode = 3; Npos = NGU; g.A = Xb; g.K = 1024; g.Bt = (const bf16_t*)(ws + WS_WGU + layer * SZ_WGU);
                    if (tid == 0) { EA_SET(0, R1); EA_SET(1, SSP); }
                } else {
                    mode = 2; Npos = 1024; g.A = R1; g.K = DFF; g.Bt = (const bf16_t*)(ws + WS_WDN + layer * SZ_WDN);
                    if (tid == 0) { EA_SET(7, Q.out); EA_SET(8, Q.out + (size_t)TP * DM); EA_SET(9, Q.out); EA_SET(10, Xb); EA_SET(11, SSP); }
                }
#undef EA_SET
                g.N = Npos;
                __syncthreads();
                pg8::StaticOrder S; S.init(TP, Npos, G, wg);
                if (mode == 0) { small_gemm<0>(g.A, g.Bt, Npos, g.K, eap, lds, wg, G, wid, lane); Epi<0> E{eap}; pg8::gemm_phase<Epi<0>, true, true>(lds, g, S, E, tid); }
                else if (mode == 1) { small_gemm<1>(g.A, g.Bt, Npos, g.K, eap, lds, wg, G, wid, lane); Epi<1> E{eap}; pg8::gemm_phase<Epi<1>, true, true>(lds, g, S, E, tid); }
                else if (mode == 2) { small_gemm<2>(g.A, g.Bt, Npos, g.K, eap, lds, wg, G, wid, lane); Epi<2> E{eap}; pg8::gemm_phase<Epi<2>, true, true>(lds, g, S, E, tid); }
                else { small_gemm<3>(g.A, g.Bt, Npos, g.K, eap, lds, wg, G, wid, lane); Epi<3> E{eap}; pg8::gemm_phase<Epi<3>, true, true>(lds, g, S, E, tid); }
            }
        }
        if (++rep >= nrep) { rep = 0; ++ph; }
        if (ph < P.ph_hi) cg::this_grid().sync();
    }
}

extern "C" void kernel_launch(void* const* d_in, const int* in_sizes, int n_in, void* d_out, int out_size, void* d_ws, size_t ws_size, hipStream_t stream) {
    static int grid = 0;
    if (grid == 0) {
        if (n_in != 25 || (size_t)out_size != O_END || ws_size < WS_END) { fprintf(stderr, "kernel_launch: unexpected sizes n_in %d out %d ws %zu (need %zu)\n", n_in, out_size, ws_size, (size_t)WS_END); grid = -1; return; }
        if (hipFuncSetAttribute((const void*)hybrid_fwd, hipFuncAttributeMaxDynamicSharedMemorySize, LDS_BYTES) != hipSuccess) { fprintf(stderr, "kernel_launch: hipFuncSetAttribute failed\n"); grid = -1; return; }
        int dev = 0, cus = 0, per_cu = 0;
        hipGetDevice(&dev); hipDeviceGetAttribute(&cus, hipDeviceAttributeMultiprocessorCount, dev);
        hipOccupancyMaxActiveBlocksPerMultiprocessor(&per_cu, (const void*)hybrid_fwd, 512, LDS_BYTES);
        (void)hipGetLastError();
        if (cus != 256 || per_cu < 1) fprintf(stderr, "kernel_launch: note: cus %d per_cu %d\n", cus, per_cu);
        grid = 256;
    }
    if (grid < 0) return;
    Params p{};
    for (int i = 0; i < 25; ++i) p.in[i] = (const float*)d_in[i];
    p.out = (float*)d_out; p.ws = (unsigned char*)d_ws;
#if MK_MULTI
    for (int ph = 0; ph < NPHASE; ++ph) { p.ph_lo = ph; p.ph_hi = ph + 1; hipLaunchKernelGGL(hybrid_fwd, dim3(grid), dim3(512), LDS_BYTES, stream, p); }
#else
    p.ph_lo = 0; p.ph_hi = NPHASE;
    void* args[] = {&p};
    hipError_t e = hipLaunchCooperativeKernel((const void*)hybrid_fwd, dim3(grid), dim3(512), args, LDS_BYTES, stream);
    if (e != hipSuccess) fprintf(stderr, "cooperative launch failed: %s\n", hipGetErrorString(e));
#endif
}
```

```cpp
#include <hip/hip_runtime.h>
#include <hip/hip_cooperative_groups.h>
#include <cstdio>
#include <cstdint>
namespace cg = cooperative_groups;

#ifndef MK_MULTI
#define MK_MULTI 0
#endif

#ifndef REP_MIX
#define REP_MIX 1
#endif
#ifndef REP_ATT
#define REP_ATT 1
#endif
#ifndef REP_PRO
#define REP_PRO 1
#endif
#ifndef REP_PROJ
#define REP_PROJ 1
#endif
#define LAS __attribute__((address_space(3)))
#define GAS __attribute__((address_space(1)))
typedef unsigned short bf16_t;
typedef short bf16x8 __attribute__((ext_vector_type(8)));
typedef float f32x2 __attribute__((ext_vector_type(2)));
typedef float f32x4 __attribute__((ext_vector_type(4)));
typedef float f32x16 __attribute__((ext_vector_type(16)));
typedef unsigned u32x2 __attribute__((ext_vector_type(2)));
typedef unsigned u32x4 __attribute__((ext_vector_type(4)));

constexpr int DM = 1024, NB = 8, SEQ = 4096, SB = 8, SSEQ = 16, PAST = 2048;
constexpr int TP = NB * SEQ;
constexpr int TS = SB * SSEQ;
constexpr int TR = TP + TS;
constexpr int ABIN = 3616, ABPAD = 3840, DFF = 2816, NGU = 5632, NQKV = 3072, DNQKV = 1536;
constexpr float EPS = 1e-6f;
constexpr float LOG2E = 1.4426950408889634f;

constexpr size_t O_Y = 0;
constexpr size_t O_CONVP = (size_t)TR * DM;
constexpr size_t O_CONVS = O_CONVP + 2 * 8 * 3 * 1536;
constexpr size_t O_DNP = O_CONVS + 2 * 8 * 3 * 1536;
constexpr size_t O_DNS = O_DNP + 2 * 8 * 8 * 64 * 64;
constexpr size_t O_GLAP = O_DNS + 2 * 8 * 8 * 64 * 64;
constexpr size_t O_GLAS = O_GLAP + 2 * 8 * 8 * 32 * 64;
constexpr size_t O_CKP = O_GLAS + 2 * 8 * 8 * 32 * 64;
constexpr size_t O_CKS = O_CKP + (size_t)2 * 8 * 512 * 1024;
constexpr size_t O_CVP = O_CKS + 2 * 8 * 16 * 1024;
constexpr size_t O_CVS = O_CVP + (size_t)2 * 8 * 512 * 1024;
constexpr size_t O_END = O_CVS + 2 * 8 * 16 * 1024;

constexpr size_t SZ_WIN = (size_t)ABPAD * 1024 * 2, SZ_W1K = (size_t)1024 * 1024 * 2, SZ_WQKV = (size_t)NQKV * 1024 * 2, SZ_WGU = (size_t)NGU * 1024 * 2, SZ_WDN = (size_t)1024 * DFF * 2;
constexpr size_t WS_WIN = 0;
constexpr size_t WS_WOUT = WS_WIN + 2 * SZ_WIN;
constexpr size_t WS_WQKV = WS_WOUT + 2 * SZ_W1K;
constexpr size_t WS_WCOUT = WS_WQKV + 2 * SZ_WQKV;
constexpr size_t WS_WGU = WS_WCOUT + 2 * SZ_W1K;
constexpr size_t WS_WDN = WS_WGU + 4 * SZ_WGU;
constexpr size_t WS_XB = WS_WDN + 4 * SZ_WDN;
constexpr size_t WS_R1 = WS_XB + (size_t)TR * 1024 * 2;
constexpr size_t WS_MIX = WS_R1 + (size_t)TR * ABIN * 2;
constexpr size_t WS_GATES = WS_MIX + (size_t)TR * 1024 * 2;
constexpr size_t WS_SSP = WS_GATES + (size_t)TR * 32 * 4;
constexpr size_t WS_CTL = WS_SSP + (size_t)TR * 16 * 4;
constexpr size_t CTL_BYTES = 16384;
constexpr size_t WS_END = WS_CTL + CTL_BYTES;

constexpr int LDS_BYTES = 147456;
constexpr int NPHASE = 24;

struct Params { const float* in[25]; float* out; unsigned char* ws; int ph_lo, ph_hi; };

__device__ __forceinline__ unsigned f2bf(float f) { unsigned u = __builtin_bit_cast(unsigned, f); return (u + 0x7fffu + ((u >> 16) & 1u)) >> 16; }
typedef __bf16 hwbf16x2 __attribute__((ext_vector_type(2)));
__device__ __forceinline__ unsigned pk2(float lo, float hi) { const f32x2 v = {lo, hi}; return __builtin_bit_cast(unsigned, __builtin_convertvector(v, hwbf16x2)); }
__device__ __forceinline__ float bf2f(bf16_t b) { return __builtin_bit_cast(float, ((unsigned)b) << 16); }
template <int CTRL> __device__ __forceinline__ float dppf(float v) { return __builtin_bit_cast(float, __builtin_amdgcn_update_dpp(0, __builtin_bit_cast(int, v), CTRL, 0xF, 0xF, true)); }
__device__ __forceinline__ float quad_sum(float v) { v += dppf<0xB1>(v); v += dppf<0x4E>(v); return v; }
__device__ __forceinline__ float oct_sum(float v) { v = quad_sum(v); v += dppf<0x141>(v); return v; }
__device__ __forceinline__ float wave_sum(float v) {
    v = oct_sum(v); v += dppf<0x140>(v);
    const int i = __builtin_bit_cast(int, v);
    return (__builtin_bit_cast(float, __builtin_amdgcn_readlane(i, 0)) + __builtin_bit_cast(float, __builtin_amdgcn_readlane(i, 16))) +
           (__builtin_bit_cast(float, __builtin_amdgcn_readlane(i, 32)) + __builtin_bit_cast(float, __builtin_amdgcn_readlane(i, 48)));
}
__device__ __forceinline__ float fast_rcp(float x) { return __builtin_amdgcn_rcpf(x); }
__device__ __forceinline__ float silu_f(float x) { return x * fast_rcp(1.0f + __expf(-x)); }
__device__ __forceinline__ float sigmoid_f(float x) { return fast_rcp(1.0f + __expf(-x)); }
__device__ __forceinline__ float softplus_f(float x) { return fmaxf(x, 0.f) + __logf(1.0f + __expf(-fabsf(x))); }

namespace pg8 {
constexpr int BM = 256, BK = 64, HALF = 128, HTB = HALF * BK * 2, STAGE_BYTES = 8 * HTB, NXCD = 8, WGM = 8;
__host__ __device__ __forceinline__ int lds_byte(int r, int c) { const int st = (r >> 4) * 2 + (c >> 5), rr = r & 15, cc = c & 31, ob = rr * 64 + cc * 2; return st * 1024 + (ob ^ (((ob >> 9) & 1) << 5)); }
__host__ __device__ __forceinline__ void stage_rc(int b, int& R, int& C) { const int st = b / 1024, sb = b % 1024, swz = sb ^ (((sb >> 9) & 1) << 5); R = (st >> 1) * 16 + swz / 64; C = (st & 1) * 32 + (swz % 64) / 2; }
__host__ __device__ __forceinline__ int perm32(int rho) { const int n = rho >> 4, i = rho & 15; return 8 * (i >> 2) + 4 * n + (i & 3); }
struct Unit { int pm, pn; };
struct Gemm { const bf16_t* A; const bf16_t* Bt; int M, N, K; };
struct StaticOrder {
    int nM, nN, nwg, G, c;
    __host__ __device__ void init(int M, int N, int G_, int c_) { nM = M / BM; nN = N / BM; nwg = nM * nN; G = G_; c = c_; }
    __host__ __device__ bool next(int i, Unit& u) const {
        const long L = (long)i * G + c; if (L >= nwg) return false;
        int wgid = (int)L; { const int q = nwg / NXCD, r = nwg % NXCD, xcd = wgid % NXCD, off = wgid / NXCD; wgid = (xcd < r ? xcd * (q + 1) : r * (q + 1) + (xcd - r) * q) + off; }
        const int nig = WGM * nN, gid = wgid / nig, fm = gid * WGM, gsz = (nM - fm) < WGM ? (nM - fm) : WGM;
        u.pm = fm + ((wgid % nig) % gsz); u.pn = (wgid % nig) / gsz; return true;
    }
};

template <class Epi, bool ALIGN_EPI, bool SP2>
__device__ __forceinline__ void gemm_phase(LAS unsigned char* lds, const Gemm g, const StaticOrder& S, const Epi& E, const int tid) {
    const int wid = __builtin_amdgcn_readfirstlane(tid >> 6), lane = tid & 63, wr = wid >> 2, wc = wid & 3, fr = lane & 15, fq = lane >> 4;
    const int K = g.K, nt = K / BK;
    unsigned voffA[2], voffB[2];
#pragma unroll
    for (int i = 0; i < 2; ++i) { int R, C; stage_rc(tid * 16 + i * 8192, R, C); voffA[i] = (unsigned)(R * K + C) * 2u; voffB[i] = (unsigned)(R * K + C) * 2u; }
    const size_t kstep = (size_t)(BK * 2);
    const size_t hstep = (size_t)HALF * K * 2;
    const size_t tstep = 2 * hstep;
    const unsigned ldsw = (unsigned)wid * 1024u;
    const int aoff = lds_byte(wr * 64 + fr, fq * 8), boff = lds_byte(wc * 32 + fr, fq * 8);
#define PG8_SA(b, h) (((b) * 2 + (h)) * HTB)
#define PG8_SB(b, h) ((4 + (b) * 2 + (h)) * HTB)
#define PG8_STAGE(bufoff, gbase, voff) do { _Pragma("unroll") for (int _i = 0; _i < 2; ++_i) \
        __builtin_amdgcn_global_load_lds((const unsigned*)((const char*)(gbase) + (voff)[_i]), (LAS unsigned*)(lds + (bufoff) + ldsw + _i * 8192), 16, 0, 0); } while (0)
#define PG8_LDA(dst, b, h) do { _Pragma("unroll") for (int m = 0; m < 4; ++m) _Pragma("unroll") for (int k = 0; k < 2; ++k) dst[m][k] = *(const LAS bf16x8*)(lds + PG8_SA(b, h) + aoff + m * 2048 + k * 1024); } while (0)
#define PG8_LDB(dst, b, h) do { _Pragma("unroll") for (int n = 0; n < 2; ++n) _Pragma("unroll") for (int k = 0; k < 2; ++k) dst[n][k] = *(const LAS bf16x8*)(lds + PG8_SB(b, h) + boff + n * 2048 + k * 1024); } while (0)
#define PG8_MMA(ai, bj, At, Bt) do { __builtin_amdgcn_s_setprio(1); _Pragma("unroll") for (int m = 0; m < 4; ++m) _Pragma("unroll") for (int n = 0; n < 2; ++n) _Pragma("unroll") for (int k = 0; k < 2; ++k) \
        acc[ai][bj][m][n] = __builtin_amdgcn_mfma_f32_16x16x32_bf16(Bt[n][k], At[m][k], acc[ai][bj][m][n], 0, 0, 0); __builtin_amdgcn_s_setprio(0); } while (0)
#define PG8_WAIT_V(n) asm volatile("s_waitcnt vmcnt(" #n ")" ::: "memory")
#define PG8_WAIT_L(n) asm volatile("s_waitcnt lgkmcnt(" #n ")" ::: "memory")
#define PG8_BAR __builtin_amdgcn_s_barrier()
#define PG8_SCHED __builtin_amdgcn_sched_barrier(0)
    Unit cur, nxt; int ui = 0;
    if (!S.next(0, cur)) return;
    f32x4 acc[2][2][4][2];
#pragma unroll
    for (int a = 0; a < 2; ++a)
#pragma unroll
        for (int b = 0; b < 2; ++b)
#pragma unroll
            for (int m = 0; m < 4; ++m)
#pragma unroll
                for (int n = 0; n < 2; ++n) acc[a][b][m][n] = (f32x4){0.f, 0.f, 0.f, 0.f};
    bf16x8 At[4][2], B0[2][2], B1[2][2];
    const char* cA = (const char*)g.A + (size_t)cur.pm * tstep; const char* cB = (const char*)g.Bt + (size_t)cur.pn * tstep;
    if constexpr (SP2) {
        PG8_STAGE(PG8_SB(0, 0), cB, voffB); PG8_STAGE(PG8_SB(0, 1), cB + hstep, voffB); PG8_STAGE(PG8_SA(0, 0), cA, voffA); PG8_STAGE(PG8_SA(0, 1), cA + hstep, voffA);
        if (wr == 1) PG8_BAR;
        PG8_WAIT_V(2); PG8_BAR;
        PG8_STAGE(PG8_SB(1, 0), cB + kstep, voffB); PG8_STAGE(PG8_SA(1, 0), cA + kstep, voffA); PG8_STAGE(PG8_SB(1, 1), cB + hstep + kstep, voffB);
        PG8_WAIT_V(6); PG8_BAR;
    } else {
        PG8_STAGE(PG8_SB(0, 0), cB, voffB); PG8_STAGE(PG8_SA(0, 0), cA, voffA); PG8_STAGE(PG8_SB(0, 1), cB + hstep, voffB); PG8_STAGE(PG8_SA(0, 1), cA + hstep, voffA);
        if (wr == 1) PG8_BAR;
        PG8_WAIT_V(4); PG8_BAR;
        PG8_STAGE(PG8_SB(1, 0), cB + kstep, voffB); PG8_STAGE(PG8_SA(1, 0), cA + kstep, voffA); PG8_STAGE(PG8_SB(1, 1), cB + hstep + kstep, voffB);
        PG8_WAIT_V(6); PG8_BAR;
    }
    for (;;) {
        const bool has_next = S.next(ui + 1, nxt);
        const char* nA = has_next ? (const char*)g.A + (size_t)nxt.pm * tstep : cA; const char* nB = has_next ? (const char*)g.Bt + (size_t)nxt.pn * tstep : cB;
        for (int t = 0; t < nt; t += 2) {
            const bool last = (t == nt - 2);
            const char* a1 = cA + (size_t)(t + 1) * kstep;
            const char* a2 = last ? nA : cA + (size_t)(t + 2) * kstep; const char* b2 = last ? nB : cB + (size_t)(t + 2) * kstep;
            const char* a3 = a2 + kstep; const char* b3 = b2 + kstep;
            if constexpr (SP2) {
            PG8_LDB(B0, 0, 0); PG8_LDB(B1, 0, 1); PG8_SCHED; PG8_LDA(At, 0, 0); PG8_STAGE(PG8_SA(1, 1), a1 + hstep, voffA);
            PG8_WAIT_V(8); PG8_WAIT_L(0); PG8_BAR; PG8_MMA(0, 0, At, B0); PG8_MMA(0, 1, At, B1); PG8_BAR; PG8_SCHED;
            PG8_LDA(At, 0, 1); PG8_STAGE(PG8_SB(0, 0), b2, voffB); PG8_STAGE(PG8_SB(0, 1), b2 + hstep, voffB); PG8_STAGE(PG8_SA(0, 0), a2, voffA);
            PG8_WAIT_V(8); PG8_WAIT_L(0); PG8_BAR; PG8_MMA(1, 0, At, B0); PG8_MMA(1, 1, At, B1); PG8_BAR; PG8_SCHED;
            PG8_LDB(B0, 1, 0); PG8_LDB(B1, 1, 1); PG8_SCHED; PG8_LDA(At, 1, 0); PG8_STAGE(PG8_SA(0, 1), a2 + hstep, voffA);
            PG8_WAIT_V(8); PG8_WAIT_L(0); PG8_BAR; PG8_MMA(0, 0, At, B0); PG8_MMA(0, 1, At, B1); PG8_BAR; PG8_SCHED;
            PG8_LDA(At, 1, 1); PG8_STAGE(PG8_SB(1, 0), b3, voffB); PG8_STAGE(PG8_SB(1, 1), b3 + hstep, voffB); PG8_STAGE(PG8_SA(1, 0), a3, voffA);
            PG8_WAIT_V(8); PG8_WAIT_L(0); PG8_BAR; PG8_MMA(1, 0, At, B0); PG8_MMA(1, 1, At, B1); PG8_BAR; PG8_SCHED;
            } else {
            PG8_LDB(B0, 0, 0); PG8_SCHED; PG8_LDA(At, 0, 0); PG8_STAGE(PG8_SA(1, 1), a1 + hstep, voffA);
            PG8_WAIT_L(8); PG8_BAR; PG8_WAIT_L(0); PG8_MMA(0, 0, At, B0); PG8_BAR; PG8_SCHED;
            PG8_LDB(B1, 0, 1); PG8_STAGE(PG8_SB(0, 0), b2, voffB);
            PG8_BAR; PG8_WAIT_L(0); PG8_MMA(0, 1, At, B1); PG8_BAR;
            PG8_LDA(At, 0, 1); PG8_STAGE(PG8_SA(0, 0), a2, voffA);
            PG8_BAR; PG8_WAIT_L(0); PG8_MMA(1, 0, At, B0); PG8_BAR; PG8_SCHED;
            PG8_STAGE(PG8_SB(0, 1), b2 + hstep, voffB);
            PG8_WAIT_V(6); PG8_BAR; PG8_MMA(1, 1, At, B1); PG8_BAR;
            PG8_LDB(B0, 1, 0); PG8_SCHED; PG8_LDA(At, 1, 0); PG8_STAGE(PG8_SA(0, 1), a2 + hstep, voffA);
            PG8_WAIT_L(8); PG8_BAR; PG8_WAIT_L(0); PG8_MMA(0, 0, At, B0); PG8_BAR; PG8_SCHED;
            PG8_LDB(B1, 1, 1); PG8_STAGE(PG8_SB(1, 0), b3, voffB);
            PG8_BAR; PG8_WAIT_L(0); PG8_MMA(0, 1, At, B1); PG8_BAR;
            PG8_LDA(At, 1, 1); PG8_STAGE(PG8_SA(1, 0), a3, voffA);
            PG8_BAR; PG8_WAIT_L(0); PG8_MMA(1, 0, At, B0); PG8_BAR; PG8_SCHED;
            PG8_STAGE(PG8_SB(1, 1), b3 + hstep, voffB);
            PG8_WAIT_V(6); PG8_BAR; PG8_MMA(1, 1, At, B1); PG8_BAR;
            }
        }
        if constexpr (ALIGN_EPI) { if (wr == 0) PG8_BAR; }
        E(acc, cur, wr, wc, fr, fq);
        if (!has_next) break;
#pragma unroll
        for (int a = 0; a < 2; ++a)
#pragma unroll
            for (int b = 0; b < 2; ++b)
#pragma unroll
                for (int m = 0; m < 4; ++m)
#pragma unroll
                    for (int n = 0; n < 2; ++n) acc[a][b][m][n] = (f32x4){0.f, 0.f, 0.f, 0.f};
        cur = nxt; cA = nA; cB = nB; ++ui;
        if constexpr (ALIGN_EPI) { if (wr == 1) PG8_BAR; }
    }
    PG8_WAIT_V(0);
    if constexpr (!ALIGN_EPI) { if (wr == 0) PG8_BAR; }
    PG8_BAR;
#undef PG8_SA
#undef PG8_SB
#undef PG8_STAGE
#undef PG8_LDA
#undef PG8_LDB
#undef PG8_MMA
#undef PG8_WAIT_V
#undef PG8_WAIT_L
#undef PG8_BAR
#undef PG8_SCHED
}
}

struct EpiArgs {
    GAS bf16_t* out; const GAS float* ssp; GAS float* gates; GAS float* o0; GAS float* o1; GAS float* o2; GAS float* o3;
    const GAS float* base_p; const GAS float* base_s; GAS float* X; GAS bf16_t* Xb; GAS float* ssp_out;
};
__device__ __forceinline__ float row_rstd(const GAS float* ssp, int row) {
    const GAS f32x4* p = (const GAS f32x4*)(ssp + (size_t)row * 16);
    const f32x4 a = p[0], b = p[1], c = p[2], d = p[3];
    const float s = ((a[0] + a[1]) + (a[2] + a[3])) + ((b[0] + b[1]) + (b[2] + b[3])) + ((c[0] + c[1]) + (c[2] + c[3])) + ((d[0] + d[1]) + (d[2] + d[3]));
    return rsqrtf(s * (1.0f / 1024.0f) + EPS);
}
template <int MODE, bool SMALL>
__device__ __forceinline__ float epi_apply(const EpiArgs& a, int row, int g32, int fq, f32x4 v0, f32x4 v1, float rstd) {
    const int c0 = 32 * g32 + 8 * fq;
    if constexpr (MODE == 0) {
        if (g32 >= ABIN / 32) return 0.f;
        v0 *= rstd; v1 *= rstd;
        u32x4 w; w.x = pk2(v0[0], v0[1]); w.y = pk2(v0[2], v0[3]); w.z = pk2(v1[0], v1[1]); w.w = pk2(v1[2], v1[3]);
        *(GAS u32x4*)(a.out + (size_t)row * ABIN + c0) = w;
        if (g32 == 48 && fq < 2) { GAS float* gp = a.gates + (size_t)row * 32 + 8 * fq; *(GAS f32x4*)gp = v0; *(GAS f32x4*)(gp + 4) = v1; }
        if (g32 == 96 && fq >= 2) { GAS float* gp = a.gates + (size_t)row * 32 + 16 + 8 * (fq - 2); *(GAS f32x4*)gp = v0; *(GAS f32x4*)(gp + 4) = v1; }
        if (c0 < DNQKV) {
            if constexpr (!SMALL) { const int t = row & (SEQ - 1), b = row >> 12; if (t >= SEQ - 3) { GAS float* d = a.o0 + (size_t)(b * 3 + (t - (SEQ - 3))) * DNQKV + c0; *(GAS f32x4*)d = v0; *(GAS f32x4*)(d + 4) = v1; } }
            else { const int r = row - TP, t = r & 15, b = r >> 4; if (t >= SSEQ - 3) { GAS float* d = a.o1 + (size_t)(b * 3 + (t - (SSEQ - 3))) * DNQKV + c0; *(GAS f32x4*)d = v0; *(GAS f32x4*)(d + 4) = v1; } }
        }
        return 0.f;
    } else if constexpr (MODE == 1) {
        v0 *= rstd; v1 *= rstd;
        u32x4 w; w.x = pk2(v0[0], v0[1]); w.y = pk2(v0[2], v0[3]); w.z = pk2(v1[0], v1[1]); w.w = pk2(v1[2], v1[3]);
        *(GAS u32x4*)(a.out + (size_t)row * NQKV + c0) = w;
        if (c0 >= 1024) {
            const int isv = c0 >= 2048, cc = c0 - 1024 - 1024 * isv;
            if constexpr (!SMALL) { const int t = row & (SEQ - 1), b = row >> 12; if (t >= SEQ - 512) { GAS float* d = a.o0 + (size_t)isv * (O_CVP - O_CKP) + (size_t)(b * 512 + (t - (SEQ - 512))) * 1024 + cc; *(GAS f32x4*)d = v0; *(GAS f32x4*)(d + 4) = v1; } }
            else { const int r = row - TP; GAS float* d = a.o2 + (size_t)isv * (O_CVS - O_CKS) + (size_t)r * 1024 + cc; *(GAS f32x4*)d = v0; *(GAS f32x4*)(d + 4) = v1; }
        }
        return 0.f;
    } else if constexpr (MODE == 2) {
        const GAS float* bp = SMALL ? a.base_s + (size_t)(row - TP) * DM + c0 : a.base_p + (size_t)row * DM + c0;
        const f32x4 x0 = *(const GAS f32x4*)bp + v0, x1 = *(const GAS f32x4*)(bp + 4) + v1;
        GAS float* xp = a.X + (size_t)row * DM + c0; *(GAS f32x4*)xp = x0; *(GAS f32x4*)(xp + 4) = x1;
        u32x4 w; w.x = pk2(x0[0], x0[1]); w.y = pk2(x0[2], x0[3]); w.z = pk2(x1[0], x1[1]); w.w = pk2(x1[2], x1[3]);
        *(GAS u32x4*)(a.Xb + (size_t)row * DM + c0) = w;
        return ((x0[0] * x0[0] + x0[1] * x0[1]) + (x0[2] * x0[2] + x0[3] * x0[3])) + ((x1[0] * x1[0] + x1[1] * x1[1]) + (x1[2] * x1[2] + x1[3] * x1[3]));
    } else {
        v0 *= rstd; v1 *= rstd;
        float h[4];
#pragma unroll
        for (int j = 0; j < 4; ++j) h[j] = silu_f(v0[j]) * v1[j];
        u32x2 w; w.x = pk2(h[0], h[1]); w.y = pk2(h[2], h[3]);
        *(GAS u32x2*)(a.out + (size_t)row * DFF + 16 * g32 + 4 * fq) = w;
        return 0.f;
    }
}
constexpr int EA_OFF = 131072 + 512;
__device__ __forceinline__ EpiArgs load_ea(const LAS unsigned long long* ap) {
    EpiArgs a;
    a.out = (GAS bf16_t*)ap[0]; a.ssp = (const GAS float*)ap[1]; a.gates = (GAS float*)ap[2]; a.o0 = (GAS float*)ap[3]; a.o1 = (GAS float*)ap[4]; a.o2 = (GAS float*)ap[5]; a.o3 = (GAS float*)ap[6];
    a.base_p = (const GAS float*)ap[7]; a.base_s = (const GAS float*)ap[8]; a.X = (GAS float*)ap[9]; a.Xb = (GAS bf16_t*)ap[10]; a.ssp_out = (GAS float*)ap[11];
    return a;
}
template <int MODE> struct Epi {
    const LAS unsigned long long* ap;
    __device__ __forceinline__ void operator()(const f32x4 (&acc)[2][2][4][2], const pg8::Unit& u, int wr, int wc, int fr, int fq) const {
        const EpiArgs a = load_ea(ap);
#pragma unroll
        for (int ai = 0; ai < 2; ++ai)
#pragma unroll
            for (int m = 0; m < 4; ++m) {
                const int row = u.pm * 256 + ai * 128 + wr * 64 + m * 16 + fr;
                float rstd = 1.f; if constexpr (MODE != 2) rstd = row_rstd(a.ssp, row);
                float ss = 0.f;
#pragma unroll
                for (int bj = 0; bj < 2; ++bj) { const int g32 = (u.pn * 256 + bj * 128 + wc * 32) >> 5; ss += epi_apply<MODE, false>(a, row, g32, fq, acc[ai][bj][m][0], acc[ai][bj][m][1], rstd); }
                if constexpr (MODE == 2) { ss += __shfl_xor(ss, 16); ss += __shfl_xor(ss, 32); if (fq == 0) a.ssp_out[(size_t)row * 16 + u.pn * 4 + wc] = ss; }
            }
    }
};

template <int MODE>
__device__ __forceinline__ void small_gemm(const bf16_t* A, const bf16_t* Bt, int Npos, int K, const LAS unsigned long long* eap, LAS unsigned char* lds, int wg, int G, int wid, int lane) {
    const int fr = lane & 15, fq = lane >> 4, ncg = (MODE == 0 ? (ABIN + 63) / 64 : Npos / 64), nunits = (TS / 16) * ncg, KW = K / 8;
    LAS f32x4* part = (LAS f32x4*)lds;
    for (int u = wg; u < nunits; u += G) {
        const int rb = u % (TS / 16), cgp = u / (TS / 16), r0 = TP + rb * 16, p0 = cgp * 64;
        f32x4 acc[4];
#pragma unroll
        for (int f = 0; f < 4; ++f) acc[f] = (f32x4){0.f, 0.f, 0.f, 0.f};
        const bf16_t* ap = A + (size_t)(r0 + fr) * K + wid * KW + 8 * fq;
        const bf16_t* bp = Bt + (size_t)(p0 + fr) * K + wid * KW + 8 * fq;
        for (int k0 = 0; k0 < KW; k0 += 32) {
            const bf16x8 av = *(const bf16x8*)(ap + k0);
            bf16x8 wv[4];
#pragma unroll
            for (int f = 0; f < 4; ++f) wv[f] = *(const bf16x8*)(bp + (size_t)(16 * f) * K + k0);
#pragma unroll
            for (int f = 0; f < 4; ++f) acc[f] = __builtin_amdgcn_mfma_f32_16x16x32_bf16(wv[f], av, acc[f], 0, 0, 0);
        }
#pragma unroll
        for (int f = 0; f < 4; ++f) part[(wid * 4 + f) * 64 + lane] = acc[f];
        __syncthreads();
        if (wid == 0) {
#pragma unroll
            for (int w = 1; w < 8; ++w)
#pragma unroll
                for (int f = 0; f < 4; ++f) acc[f] += part[(w * 4 + f) * 64 + lane];
            const int row = r0 + fr;
            const EpiArgs a = load_ea(eap);
            float rstd = 1.f; if constexpr (MODE != 2) rstd = row_rstd(a.ssp, row);
            float ss = 0.f;
#pragma unroll
            for (int gq = 0; gq < 2; ++gq) ss += epi_apply<MODE, true>(a, row, (p0 >> 5) + gq, fq, acc[2 * gq], acc[2 * gq + 1], rstd);
            if constexpr (MODE == 2) { ss += __shfl_xor(ss, 16); ss += __shfl_xor(ss, 32); if (fq == 0) a.ssp_out[(size_t)row * 16 + cgp] = ss; }
        }
        __syncthreads();
    }
}

__device__ __forceinline__ void transpose_item(const float* W, int K, int Nsrc, int gu, const float* gamma, bf16_t* WT, LAS float* scr, int item, int npb, int lane) {
    const int kb = item / npb, nb = item % npb, k0 = 64 * kb, p0 = 32 * nb;
    const int cl = p0 + pg8::perm32(lane & 31);
    int src = cl; if (gu) src = ((cl >> 2) & 1) * DFF + 4 * (cl >> 3) + (cl & 3);
    const bool valid = src < Nsrc;
#pragma unroll 8
    for (int i = 0; i < 32; ++i) { const int kk = 2 * i + (lane >> 5); float v = 0.f; if (valid) { v = W[(size_t)(k0 + kk) * Nsrc + src]; if (gamma) v *= gamma[k0 + kk]; } scr[kk * 33 + (lane & 31)] = v; }
    asm volatile("s_waitcnt lgkmcnt(0)" ::: "memory");
    const int c = lane & 7;
#pragma unroll
    for (int j = 0; j < 4; ++j) { const int n = (lane >> 3) + 8 * j; const LAS float* s = scr + (8 * c) * 33 + n;
        u32x4 o; o.x = pk2(s[0 * 33], s[1 * 33]); o.y = pk2(s[2 * 33], s[3 * 33]); o.z = pk2(s[4 * 33], s[5 * 33]); o.w = pk2(s[6 * 33], s[7 * 33]);
        *(u32x4*)(WT + (size_t)(p0 + n) * K + k0 + 8 * c) = o; }
    asm volatile("s_waitcnt lgkmcnt(0)" ::: "memory");
}
__device__ __forceinline__ void convert_matrix(const float* W, int K, int Nsrc, int Npos, int gu, const float* gamma, bf16_t* WT, LAS float* scr, int gw, int ngw, int lane) {
    const int npb = Npos / 32, nitems = (K / 64) * npb;
    for (int it = gw; it < nitems; it += ngw) transpose_item(W, K, Nsrc, gu, gamma, WT, scr, it, npb, lane);
}
__device__ __forceinline__ void phase_prologue(const Params& P, LAS unsigned char* lds, int gw, int ngw, int wid, int lane) {
    LAS float* scr = (LAS float*)(lds + wid * 8704);
    unsigned char* ws = P.ws;
    for (int i = 0; i < 2; ++i) {
        convert_matrix(P.in[8] + (size_t)i * 1024 * ABIN, 1024, ABIN, ABPAD, 0, P.in[7] + i * 1024, (bf16_t*)(ws + WS_WIN + i * SZ_WIN), scr, gw, ngw, lane);
        convert_matrix(P.in[16] + (size_t)i * 1024 * 1024, 1024, 1024, 1024, 0, nullptr, (bf16_t*)(ws + WS_WOUT + i * SZ_W1K), scr, gw, ngw, lane);
        convert_matrix(P.in[18] + (size_t)i * 1024 * NQKV, 1024, NQKV, NQKV, 0, P.in[17] + i * 1024, (bf16_t*)(ws + WS_WQKV + i * SZ_WQKV), scr, gw, ngw, lane);
        convert_matrix(P.in[20] + (size_t)i * 1024 * 1024, 1024, 1024, 1024, 0, nullptr, (bf16_t*)(ws + WS_WCOUT + i * SZ_W1K), scr, gw, ngw, lane);
    }
    for (int l = 0; l < 4; ++l) {
        convert_matrix(P.in[22] + (size_t)l * 1024 * NGU, 1024, NGU, NGU, 1, P.in[21] + l * 1024, (bf16_t*)(ws + WS_WGU + l * SZ_WGU), scr, gw, ngw, lane);
        convert_matrix(P.in[23] + (size_t)l * DFF * 1024, DFF, 1024, 1024, 0, nullptr, (bf16_t*)(ws + WS_WDN + l * SZ_WDN), scr, gw, ngw, lane);
    }
    bf16_t* Xb = (bf16_t*)(ws + WS_XB); float* ssp = (float*)(ws + WS_SSP);
    for (int row = gw; row < TR; row += ngw) {
        const float* xr = (row < TP) ? P.in[0] + (size_t)row * DM : P.in[1] + (size_t)(row - TP) * DM;
        f32x4 v[4]; float s = 0.f;
#pragma unroll
        for (int j = 0; j < 4; ++j) { v[j] = ((const f32x4*)xr)[lane + 64 * j]; s += (v[j][0] * v[j][0] + v[j][1] * v[j][1]) + (v[j][2] * v[j][2] + v[j][3] * v[j][3]); }
        s = wave_sum(s);
#pragma unroll
        for (int j = 0; j < 4; ++j) { u32x2 w; w.x = pk2(v[j][0], v[j][1]); w.y = pk2(v[j][2], v[j][3]); ((u32x2*)(Xb + (size_t)row * DM))[lane + 64 * j] = w; }
        if (lane < 16) ssp[(size_t)row * 16 + lane] = (lane == 0) ? s : 0.f;
    }
}
__device__ __forceinline__ void phase_final(const Params& P, int gw, int ngw, int lane) {
    const GAS float* ssp = (const GAS float*)(P.ws + WS_SSP); const float* g = P.in[24];
    f32x4 gv[4];
#pragma unroll
    for (int j = 0; j < 4; ++j) gv[j] = ((const f32x4*)g)[lane + 64 * j];
    for (int row = gw; row < TR; row += ngw) {
        const float rstd = row_rstd(ssp, row);
        f32x4* xr = (f32x4*)(P.out + (size_t)row * DM);
#pragma unroll
        for (int j = 0; j < 4; ++j) { f32x4 v = xr[lane + 64 * j]; xr[lane + 64 * j] = v * rstd * gv[j]; }
    }
}

constexpr int MX_CH = 32;
#define LDS_BARRIER() asm volatile("s_waitcnt lgkmcnt(0)\n\ts_barrier" ::: "memory")
__device__ __forceinline__ void delta_unit(const Params& P, LAS unsigned char* lds, int li, bool sample, int b, int h, int half, const int tid) {
    const int lane = tid & 63, wid = __builtin_amdgcn_readfirstlane(tid >> 6);
    const int L = sample ? SSEQ : SEQ, rowbase = sample ? TP + b * SSEQ : b * SEQ;
    const bf16_t* PROJ = (const bf16_t*)(P.ws + WS_R1); const float* GATES = (const float*)(P.ws + WS_GATES); bf16_t* MIX = (bf16_t*)(P.ws + WS_MIX);
    const int NC = (L + MX_CH - 1) / MX_CH;
    constexpr int SET = 4 * 8192 + 256;
    if (wid < 4) __builtin_amdgcn_s_setprio(2);
    const int e = 32 * half + (wid & 3) * 8 + (lane >> 3), dq = lane & 7;
    f32x2 S[4];
    float* sout = P.out + (sample ? O_DNS : O_DNP) + (size_t)((li * 8 + b) * 8 + h) * 4096;
    if (wid < 4) {
        if (sample) { const float* s0 = P.in[3] + (size_t)((li * 8 + b) * 8 + h) * 4096;
#pragma unroll
            for (int j = 0; j < 4; ++j) { S[j][0] = s0[(8 * dq + 2 * j) * 64 + e]; S[j][1] = s0[(8 * dq + 2 * j + 1) * 64 + e]; } }
        else {
#pragma unroll
            for (int j = 0; j < 4; ++j) S[j] = (f32x2){0.f, 0.f}; }
    }
    const int pw = wid - 4, c = lane;
    float cwq[4], cwk[4], cwv[4], alog = 0.f, dtb = 0.f;
    float rq[11], rk[11], rv[11], ga = 0.f, gb_ = 0.f;
    if (wid >= 4) {
        const float* cw = P.in[9] + (size_t)li * 4 * DNQKV;
#pragma unroll
        for (int t = 0; t < 4; ++t) { cwq[t] = cw[t * DNQKV + h * 64 + c]; cwk[t] = cw[t * DNQKV + 512 + h * 64 + c]; cwv[t] = cw[t * DNQKV + 1024 + h * 64 + c]; }
        alog = P.in[10][li * 8 + h]; dtb = P.in[11][li * 8 + h];
    }
#define DN_LOADS(jn) do { const int t0n_ = (jn) * MX_CH + pw * 8; if ((jn) < NC && t0n_ < L) { \
        _Pragma("unroll") for (int r = 0; r < 11; ++r) { const int t = t0n_ - 3 + r, tc = max(t, 0); const bf16_t* pr = PROJ + (size_t)(rowbase + tc) * ABIN + h * 64 + c; \
            const float m = (t >= 0) ? 1.f : 0.f; rq[r] = bf2f(pr[0]) * m; rk[r] = bf2f(pr[512]) * m; rv[r] = bf2f(pr[1024]) * m; } \
        { const float* gp = GATES + (size_t)(rowbase + t0n_ + (lane & 7)) * 32; ga = gp[h]; gb_ = gp[8 + h]; } \
        if (sample && t0n_ == 0) { _Pragma("unroll") for (int r = 0; r < 3; ++r) { const float* cb = P.in[2] + (size_t)((li * 8 + b) * 3 + r) * DNQKV + h * 64 + c; rq[r] = cb[0]; rk[r] = cb[512]; rv[r] = cb[1024]; } } } } while (0)
    if (wid >= 4) DN_LOADS(0);
    for (int j = 0; j < NC + 2; ++j) {
        if (wid >= 4) {
            if (j < NC) {
                LAS float* qs = (LAS float*)(lds + (j & 1) * SET); LAS float* ks = qs + 2048; LAS float* vs = qs + 4096; LAS float* sc = qs + 8192;
                const int t0 = j * MX_CH + pw * 8;
                if (t0 < L) {
#pragma unroll
                    for (int i = 0; i < 8; ++i) {
                        float q = cwq[0] * rq[i] + cwq[1] * rq[i + 1] + cwq[2] * rq[i + 2] + cwq[3] * rq[i + 3];
                        float k = cwk[0] * rk[i] + cwk[1] * rk[i + 1] + cwk[2] * rk[i + 2] + cwk[3] * rk[i + 3];
                        float v = cwv[0] * rv[i] + cwv[1] * rv[i + 1] + cwv[2] * rv[i + 2] + cwv[3] * rv[i + 3];
                        q = silu_f(q); k = silu_f(k); v = silu_f(v);
                        const float sq = wave_sum(q * q), sk = wave_sum(k * k);
                        const int tok = pw * 8 + i;
                        qs[tok * 64 + c] = q * rsqrtf(sq + EPS) * 0.125f; ks[tok * 64 + c] = k * rsqrtf(sk + EPS); vs[tok * 64 + c] = v;
                    }
                    if (lane < 8) { const float g = -__expf(alog) * softplus_f(ga + dtb); sc[(pw * 8 + lane) * 2] = __expf(g); sc[(pw * 8 + lane) * 2 + 1] = sigmoid_f(gb_); }
                }
            }
            DN_LOADS(j + 1);
            if (j >= 2) {
                LAS float* os = (LAS float*)(lds + (j & 1) * SET) + 6144;
                const int t0 = (j - 2) * MX_CH + pw * 8;
                if (t0 < L && (c >> 5) == half) {
#pragma unroll
                    for (int i = 0; i < 8; ++i) {
                        const int tok = pw * 8 + i; const size_t row = (size_t)(rowbase + t0 + i);
                        MIX[row * DM + h * 64 + c] = (bf16_t)f2bf(os[tok * 64 + c]);
                    }
                }
            }
        } else if (j >= 1 && j <= NC) {
            LAS float* qs = (LAS float*)(lds + ((j - 1) & 1) * SET); LAS float* ks = qs + 2048; LAS float* vs = qs + 4096; LAS float* os = qs + 6144; LAS float* sc = qs + 8192;
            const int ntok = min(MX_CH, L - (j - 1) * MX_CH);
            f32x4 kk[2], qq[2]; float ve; f32x2 gb;
#pragma unroll
            for (int i = 0; i < 2; ++i) { kk[i] = *(const LAS f32x4*)(ks + 8 * dq + 4 * i); qq[i] = *(const LAS f32x4*)(qs + 8 * dq + 4 * i); }
            ve = vs[e]; gb = *(const LAS f32x2*)(sc);
#pragma unroll 2
            for (int tok = 0; tok < ntok; ++tok) {
                const int tn = min(tok + 1, ntok - 1);
                f32x4 kn[2], qn[2];
#pragma unroll
                for (int i = 0; i < 2; ++i) { kn[i] = *(const LAS f32x4*)(ks + tn * 64 + 8 * dq + 4 * i); qn[i] = *(const LAS f32x4*)(qs + tn * 64 + 8 * dq + 4 * i); }
                const float vn = vs[tn * 64 + e]; const f32x2 gn = *(const LAS f32x2*)(sc + tn * 2);
                const float eg = gb[0], beta = gb[1];
                const f32x2 wa = (f32x2){kk[0][0], kk[0][1]} * S[0] + (f32x2){kk[0][2], kk[0][3]} * S[1];
                const f32x2 wb = (f32x2){kk[1][0], kk[1][1]} * S[2] + (f32x2){kk[1][2], kk[1][3]} * S[3];
                const f32x2 ws2 = wa + wb;
                const float w = oct_sum(ws2[0] + ws2[1]);
                const float dl = beta * (ve - eg * w);
                const f32x2 eg2 = (f32x2){eg, eg}, dl2 = (f32x2){dl, dl};
#pragma unroll
                for (int i = 0; i < 2; ++i) { S[2 * i] = S[2 * i] * eg2 + (f32x2){kk[i][0], kk[i][1]} * dl2; S[2 * i + 1] = S[2 * i + 1] * eg2 + (f32x2){kk[i][2], kk[i][3]} * dl2; }
                const f32x2 oa = (f32x2){qq[0][0], qq[0][1]} * S[0] + (f32x2){qq[0][2], qq[0][3]} * S[1];
                const f32x2 ob = (f32x2){qq[1][0], qq[1][1]} * S[2] + (f32x2){qq[1][2], qq[1][3]} * S[3];
                const f32x2 os2 = oa + ob;
                const float o = oct_sum(os2[0] + os2[1]);
                if (dq == 0) os[tok * 64 + e] = o;
#pragma unroll
                for (int i = 0; i < 2; ++i) { kk[i] = kn[i]; qq[i] = qn[i]; }
                ve = vn; gb = gn;
            }
        }
        LDS_BARRIER();
    }
#undef DN_LOADS
    if (wid < 4) {
#pragma unroll
        for (int j = 0; j < 4; ++j) { sout[(8 * dq + 2 * j) * 64 + e] = S[j][0]; sout[(8 * dq + 2 * j + 1) * 64 + e] = S[j][1]; }
    }
    __builtin_amdgcn_s_setprio(0);
}

__device__ __forceinline__ void gla_unit(const Params& P, LAS unsigned char* lds, int li, bool sample, int b, int h, const int tid) {
    const int lane = tid & 63, wid = __builtin_amdgcn_readfirstlane(tid >> 6);
    const int L = sample ? SSEQ : SEQ, rowbase = sample ? TP + b * SSEQ : b * SEQ;
    const bf16_t* PROJ = (const bf16_t*)(P.ws + WS_R1); const float* GATES = (const float*)(P.ws + WS_GATES); bf16_t* MIX = (bf16_t*)(P.ws + WS_MIX);
    const int NC = (L + MX_CH - 1) / MX_CH;
    constexpr int SET = 3 * 4096 + 2 * 8192;
    if (wid < 4) __builtin_amdgcn_s_setprio(2);
    const int e = (wid & 3) * 16 + (lane >> 2), dq = lane & 3;
    f32x2 S[4];
    float* sout = P.out + (sample ? O_GLAS : O_GLAP) + (size_t)((li * 8 + b) * 8 + h) * 2048;
    if (wid < 4) {
        if (sample) { const float* s0 = P.in[4] + (size_t)((li * 8 + b) * 8 + h) * 2048;
#pragma unroll
            for (int j = 0; j < 4; ++j) { S[j][0] = s0[(8 * dq + 2 * j) * 64 + e]; S[j][1] = s0[(8 * dq + 2 * j + 1) * 64 + e]; } }
        else {
#pragma unroll
            for (int j = 0; j < 4; ++j) S[j] = (f32x2){0.f, 0.f}; }
    }
    const int pw = wid - 4, c = lane, c32 = lane & 31;
    float w2[16], gkb = 0.f, onorm = 0.f;
    if (wid >= 4) {
#pragma unroll
        for (int r = 0; r < 16; ++r) w2[r] = P.in[13][(size_t)(li * 16 + r) * 256 + h * 32 + c32];
        gkb = P.in[14][li * 256 + h * 32 + c32]; onorm = P.in[15][li * 64 + c];
    }
    for (int j = 0; j < NC + 2; ++j) {
        if (wid >= 4) {
            if (j < NC) {
                LAS float* qs = (LAS float*)(lds + (j & 1) * SET); LAS float* ks = qs + 1024; LAS float* gs = qs + 2048; LAS float* vs = qs + 3072;
                const int t0 = j * MX_CH + pw * 8;
                if (t0 < L) {
                    const int g4 = (lane >> 5) * 4;
                    float rv[8], rq[4], rk[4]; f32x4 lrv[4][4];
#pragma unroll
                    for (int i = 0; i < 8; ++i) rv[i] = bf2f(PROJ[(size_t)(rowbase + t0 + i) * ABIN + 2576 + h * 64 + c]);
#pragma unroll
                    for (int i = 0; i < 4; ++i) { const size_t row = (size_t)(rowbase + t0 + g4 + i); const bf16_t* pr = PROJ + row * ABIN;
                        rq[i] = bf2f(pr[2064 + h * 32 + c32]); rk[i] = bf2f(pr[2320 + h * 32 + c32]);
#pragma unroll
                        for (int r = 0; r < 4; ++r) lrv[i][r] = *(const f32x4*)(GATES + row * 32 + 16 + 4 * r); }
#pragma unroll
                    for (int i = 0; i < 8; ++i) vs[(pw * 8 + i) * 64 + c] = rv[i];
#pragma unroll
                    for (int i = 0; i < 4; ++i) {
                        const int tok = pw * 8 + g4 + i;
                        float z = gkb;
#pragma unroll
                        for (int r = 0; r < 4; ++r) z += (lrv[i][r][0] * w2[4 * r] + lrv[i][r][1] * w2[4 * r + 1]) + (lrv[i][r][2] * w2[4 * r + 2] + lrv[i][r][3] * w2[4 * r + 3]);
                        const float ls = -softplus_f(-z);
                        qs[tok * 32 + c32] = rq[i] * 0.17677669529663687f; ks[tok * 32 + c32] = rk[i]; gs[tok * 32 + c32] = __expf(ls * (1.0f / 16.0f));
                    }
                }
            }
            if (j >= 2) {
                LAS float* os = (LAS float*)(lds + (j & 1) * SET) + 3072 + 2048;
                const int t0 = (j - 2) * MX_CH + pw * 8;
                if (t0 < L) {
#pragma unroll
                    for (int i = 0; i < 8; ++i) {
                        const int tok = pw * 8 + i; const size_t row = (size_t)(rowbase + t0 + i);
                        MIX[row * DM + 512 + h * 64 + c] = (bf16_t)f2bf(os[tok * 64 + c]);
                    }
                }
            }
        } else if (j >= 1 && j <= NC) {
            LAS float* qs = (LAS float*)(lds + ((j - 1) & 1) * SET); LAS float* ks = qs + 1024; LAS float* gs = qs + 2048; LAS float* vs = qs + 3072; LAS float* os = qs + 3072 + 2048;
            const int ntok = min(MX_CH, L - (j - 1) * MX_CH);
            f32x4 kk[2], qq[2], gg[2]; float ve;
#pragma unroll
            for (int i = 0; i < 2; ++i) { kk[i] = *(const LAS f32x4*)(ks + 8 * dq + 4 * i); qq[i] = *(const LAS f32x4*)(qs + 8 * dq + 4 * i); gg[i] = *(const LAS f32x4*)(gs + 8 * dq + 4 * i); }
            ve = vs[e];
            for (int tok = 0; tok < ntok; ++tok) {
                const int tn = min(tok + 1, ntok - 1);
                f32x4 kn[2], qn[2], gn[2];
#pragma unroll
                for (int i = 0; i < 2; ++i) { kn[i] = *(const LAS f32x4*)(ks + tn * 32 + 8 * dq + 4 * i); qn[i] = *(const LAS f32x4*)(qs + tn * 32 + 8 * dq + 4 * i); gn[i] = *(const LAS f32x4*)(gs + tn * 32 + 8 * dq + 4 * i); }
                const float vn = vs[tn * 64 + e];
                const f32x2 v2 = (f32x2){ve, ve};
                f32x2 oa[2];
#pragma unroll
                for (int i = 0; i < 2; ++i) {
                    S[2 * i] = S[2 * i] * (f32x2){gg[i][0], gg[i][1]} + (f32x2){kk[i][0], kk[i][1]} * v2; S[2 * i + 1] = S[2 * i + 1] * (f32x2){gg[i][2], gg[i][3]} + (f32x2){kk[i][2], kk[i][3]} * v2;
                    oa[i] = (f32x2){qq[i][0], qq[i][1]} * S[2 * i] + (f32x2){qq[i][2], qq[i][3]} * S[2 * i + 1];
                }
                const f32x2 os2 = oa[0] + oa[1];
                const float o = quad_sum(os2[0] + os2[1]);
                if (dq == 0) os[tok * 64 + e] = o;
#pragma unroll
                for (int i = 0; i < 2; ++i) { kk[i] = kn[i]; qq[i] = qn[i]; gg[i] = gn[i]; }
                ve = vn;
            }
        }
        __syncthreads();
    }
    if (wid < 4) {
#pragma unroll
        for (int j = 0; j < 4; ++j) { sout[(8 * dq + 2 * j) * 64 + e] = S[j][0]; sout[(8 * dq + 2 * j + 1) * 64 + e] = S[j][1]; }
    }
    __builtin_amdgcn_s_setprio(0);
}

__device__ __forceinline__ void phase_fixup(const Params& P, int li, int gw, int ngw, int lane) {
    bf16_t* MIX = (bf16_t*)(P.ws + WS_MIX); const bf16_t* PROJ = (const bf16_t*)(P.ws + WS_R1);
    const float* on = (lane < 32 ? P.in[12] : P.in[15]) + li * 64 + 16 * (lane & 3);
    float g[16];
#pragma unroll
    for (int j = 0; j < 16; ++j) g[j] = on[j];
    const int gcol = (lane < 32) ? 1552 + 16 * lane : 3104 + 16 * (lane - 32);
    for (int row = gw; row < TR; row += ngw) {
        u32x4* mp = (u32x4*)(MIX + (size_t)row * DM + 16 * lane);
        const u32x4* gp = (const u32x4*)(PROJ + (size_t)row * ABIN + gcol);
        const u32x4 m0 = mp[0], m1 = mp[1], g0 = gp[0], g1 = gp[1];
        float o[16], gt[16];
#pragma unroll
        for (int j = 0; j < 4; ++j) { o[2 * j] = __builtin_bit_cast(float, m0[j] << 16); o[2 * j + 1] = __builtin_bit_cast(float, m0[j] & 0xffff0000u); o[8 + 2 * j] = __builtin_bit_cast(float, m1[j] << 16); o[8 + 2 * j + 1] = __builtin_bit_cast(float, m1[j] & 0xffff0000u);
            gt[2 * j] = __builtin_bit_cast(float, g0[j] << 16); gt[2 * j + 1] = __builtin_bit_cast(float, g0[j] & 0xffff0000u); gt[8 + 2 * j] = __builtin_bit_cast(float, g1[j] << 16); gt[8 + 2 * j + 1] = __builtin_bit_cast(float, g1[j] & 0xffff0000u); }
        float ss = 0.f;
#pragma unroll
        for (int j = 0; j < 16; ++j) ss += o[j] * o[j];
        ss = quad_sum(ss);
        const float rstd = rsqrtf(ss * (1.0f / 64.0f) + EPS);
        float r[16];
#pragma unroll
        for (int j = 0; j < 16; ++j) r[j] = o[j] * rstd * g[j] * silu_f(gt[j]);
        u32x4 w0, w1;
#pragma unroll
        for (int j = 0; j < 4; ++j) { w0[j] = pk2(r[2 * j], r[2 * j + 1]); w1[j] = pk2(r[8 + 2 * j], r[8 + 2 * j + 1]); }
        mp[0] = w0; mp[1] = w1;
    }
}

constexpr int AT_KOFF = 0, AT_VOFF = 2 * 9216, AT_TAB = 4 * 9216;
__device__ __forceinline__ int vpos(int kv) { return 16 * (kv >> 4) + 8 * ((kv >> 2) & 1) + 4 * ((kv >> 3) & 1) + (kv & 3); }
__device__ __forceinline__ void attn_prompt_unit(const Params& P, LAS unsigned char* lds, int li, int b, int h, int g4, const int tid) {
    const int lane = tid & 63, wid = __builtin_amdgcn_readfirstlane(tid >> 6), r32 = lane & 31, hi = lane >> 5;
    const bf16_t* QKV = (const bf16_t*)(P.ws + WS_R1); bf16_t* MIX = (bf16_t*)(P.ws + WS_MIX);
    const int cw = 4 * g4 + (wid >> 1);
    const size_t qrow = (size_t)b * SEQ + 256 * g4 + 32 * wid + r32;
    bf16x8 qr[4];
#pragma unroll
    for (int d0 = 0; d0 < 4; ++d0) qr[d0] = *(const bf16x8*)(QKV + qrow * NQKV + h * 64 + d0 * 16 + hi * 8);
    LAS float* tab = (LAS float*)(lds + AT_TAB);
    if (tid < 257) tab[tid] = P.in[19][(size_t)(li * 16 + h) * 257 + tid] * LOG2E;
    const int kt_lo = max(0, 4 * g4 - 8), kt_hi = 4 * g4 + 3;
    const int srow = tid >> 3, sch = tid & 7;
    const bf16_t* kvsrc = QKV + ((size_t)b * SEQ + srow) * NQKV + 1024 + h * 64 + 8 * sch;
    const int vp = vpos(srow);
    bf16x8 kreg, vreg;
#define AT_LOAD(kt) do { const bf16_t* s_ = kvsrc + (size_t)(kt) * 64 * NQKV; kreg = *(const bf16x8*)s_; vreg = *(const bf16x8*)(s_ + 1024); } while (0)
#define AT_STORE(buf) do { *(LAS bf16x8*)(lds + AT_KOFF + (buf) * 9216 + srow * 144 + sch * 16) = kreg; \
        _Pragma("unroll") for (int j_ = 0; j_ < 8; ++j_) *(LAS short*)(lds + AT_VOFF + (buf) * 9216 + (8 * sch + j_) * 144 + vp * 2) = vreg[j_]; } while (0)
    AT_LOAD(kt_lo); AT_STORE(0);
    __syncthreads();
    float m = -1e30f, l = 0.f; f32x16 o[2];
#pragma unroll
    for (int r = 0; r < 16; ++r) { o[0][r] = 0.f; o[1][r] = 0.f; }
    const float C2 = 0.125f * LOG2E;
    const int qi = 32 * (wid & 1) + r32;
    for (int kt = kt_lo; kt <= kt_hi; ++kt) {
        const int cur = (kt - kt_lo) & 1;
        if (kt < kt_hi) AT_LOAD(kt + 1);
        if (kt >= cw - 8 && kt <= cw) {
            const LAS unsigned char* Kb = lds + AT_KOFF + cur * 9216; const LAS unsigned char* Vb = lds + AT_VOFF + cur * 9216;
            f32x16 p0, p1;
#pragma unroll
            for (int r = 0; r < 16; ++r) { p0[r] = 0.f; p1[r] = 0.f; }
#pragma unroll
            for (int d0 = 0; d0 < 4; ++d0) {
                const bf16x8 a0 = *(const LAS bf16x8*)(Kb + r32 * 144 + d0 * 32 + hi * 16);
                const bf16x8 a1 = *(const LAS bf16x8*)(Kb + (32 + r32) * 144 + d0 * 32 + hi * 16);
                p0 = __builtin_amdgcn_mfma_f32_32x32x16_bf16(a0, qr[d0], p0, 0, 0, 0);
                p1 = __builtin_amdgcn_mfma_f32_32x32x16_bf16(a1, qr[d0], p1, 0, 0, 0);
            }
            const int dist = cw - kt;
            if (dist >= 3) { const float bf = tab[256];
#pragma unroll
                for (int r = 0; r < 16; ++r) { p0[r] = p0[r] * C2 + bf; p1[r] = p1[r] * C2 + bf; } }
            else {
#pragma unroll
                for (int r = 0; r < 16; ++r) { const int kv = (r & 3) + 8 * (r >> 2) + 4 * hi; const int rel = qi - kv + 64 * dist;
                    p0[r] = p0[r] * C2 + tab[min(rel, 128) + 128]; p1[r] = p1[r] * C2 + tab[min(rel - 32, 128) + 128]; } }
            float mx = p0[0];
#pragma unroll
            for (int r = 1; r < 16; ++r) mx = fmaxf(mx, p0[r]);
#pragma unroll
            for (int r = 0; r < 16; ++r) mx = fmaxf(mx, p1[r]);
            mx = fmaxf(mx, __shfl_xor(mx, 32));
            const float mn = fmaxf(m, mx), scl = __builtin_amdgcn_exp2f(m - mn); m = mn;
            float ls = 0.f;
#pragma unroll
            for (int r = 0; r < 16; ++r) { p0[r] = __builtin_amdgcn_exp2f(p0[r] - mn); p1[r] = __builtin_amdgcn_exp2f(p1[r] - mn); ls += p0[r] + p1[r]; }
            l = l * scl + ls;
#pragma unroll
            for (int r = 0; r < 16; ++r) { o[0][r] *= scl; o[1][r] *= scl; }
            u32x4 pw[4];
#pragma unroll
            for (int s = 0; s < 2; ++s) {
                pw[s] = (u32x4){pk2(p0[8 * s], p0[8 * s + 1]), pk2(p0[8 * s + 2], p0[8 * s + 3]), pk2(p0[8 * s + 4], p0[8 * s + 5]), pk2(p0[8 * s + 6], p0[8 * s + 7])};
                pw[2 + s] = (u32x4){pk2(p1[8 * s], p1[8 * s + 1]), pk2(p1[8 * s + 2], p1[8 * s + 3]), pk2(p1[8 * s + 4], p1[8 * s + 5]), pk2(p1[8 * s + 6], p1[8 * s + 7])};
            }
#pragma unroll
            for (int dh = 0; dh < 2; ++dh)
#pragma unroll
                for (int ks = 0; ks < 4; ++ks) {
                    const bf16x8 vf = *(const LAS bf16x8*)(Vb + (32 * dh + r32) * 144 + (16 * ks + 8 * hi) * 2);
                    o[dh] = __builtin_amdgcn_mfma_f32_32x32x16_bf16(vf, __builtin_bit_cast(bf16x8, pw[ks]), o[dh], 0, 0, 0);
                }
        }
        if (kt < kt_hi) AT_STORE(cur ^ 1);
        __syncthreads();
    }
#undef AT_LOAD
#undef AT_STORE
    l += __shfl_xor(l, 32);
    const float rl = 1.0f / l;
    bf16_t* op = MIX + qrow * DM + h * 64;
#pragma unroll
    for (int dh = 0; dh < 2; ++dh)
#pragma unroll
        for (int r4 = 0; r4 < 4; ++r4) {
            u32x2 w; w.x = pk2(o[dh][4 * r4] * rl, o[dh][4 * r4 + 1] * rl); w.y = pk2(o[dh][4 * r4 + 2] * rl, o[dh][4 * r4 + 3] * rl);
            *(u32x2*)(op + 32 * dh + 8 * r4 + 4 * hi) = w;
        }
}
__device__ __forceinline__ void attn_sample_unit(const Params& P, LAS unsigned char* lds, int li, int b, int h, const int tid) {
    const int lane = tid & 63, wid = tid >> 6;
    const bf16_t* QKV = (const bf16_t*)(P.ws + WS_R1); bf16_t* MIX = (bf16_t*)(P.ws + WS_MIX);
    LAS float* qs = (LAS float*)lds;
    LAS float* sc = qs + 1024;
    LAS float* tab = sc + 16 * 528;
    const size_t rb = (size_t)TP + b * SSEQ;
    for (int i = tid; i < 1024; i += 512) qs[i] = bf2f(QKV[(rb + (i >> 6)) * NQKV + h * 64 + (i & 63)]);
    if (tid < 257) tab[tid] = P.in[19][(size_t)(li * 16 + h) * 257 + tid];
    __syncthreads();
    const float* kc = P.in[5] + ((size_t)(li * 8 + b) * 512) * 1024 + h * 64;
    const float* vc = P.in[6] + ((size_t)(li * 8 + b) * 512) * 1024 + h * 64;
    for (int j = tid; j < 528; j += 512) {
        float kr[64];
        if (j < 512) {
#pragma unroll
            for (int d = 0; d < 16; ++d) { const f32x4 t = *(const f32x4*)(kc + (size_t)j * 1024 + 4 * d); kr[4 * d] = t[0]; kr[4 * d + 1] = t[1]; kr[4 * d + 2] = t[2]; kr[4 * d + 3] = t[3]; }
        } else {
#pragma unroll
            for (int d = 0; d < 64; ++d) kr[d] = bf2f(QKV[(rb + (j - 512)) * NQKV + 1024 + h * 64 + d]);
        }
        for (int q = 0; q < 16; ++q) {
            float s = 0.f;
#pragma unroll
            for (int d = 0; d < 64; ++d) s += qs[q * 64 + d] * kr[d];
            const int rel = (j < 512) ? (512 + q - j) : (q - (j - 512));
            sc[q * 528 + j] = s * 0.125f + tab[min(max(rel, -128), 128) + 128];
        }
    }
    __syncthreads();
    for (int q = 2 * wid; q < 2 * wid + 2; ++q) {
        float mx = -1e30f;
        for (int j = lane; j < 528; j += 64) mx = fmaxf(mx, sc[q * 528 + j]);
#pragma unroll
        for (int o = 1; o < 64; o <<= 1) mx = fmaxf(mx, __shfl_xor(mx, o));
        float sm = 0.f;
        for (int j = lane; j < 528; j += 64) { const float p = __expf(sc[q * 528 + j] - mx); sc[q * 528 + j] = p; sm += p; }
        sm = wave_sum(sm);
        const float inv = 1.0f / sm;
        for (int j = lane; j < 528; j += 64) sc[q * 528 + j] *= inv;
    }
    __syncthreads();
    {
        const int q = tid >> 5, d = 2 * (tid & 31);
        float a0 = 0.f, a1 = 0.f;
        for (int j = 0; j < 512; ++j) { const f32x2 v = *(const f32x2*)(vc + (size_t)j * 1024 + d); const float p = sc[q * 528 + j]; a0 += p * v[0]; a1 += p * v[1]; }
        for (int j = 0; j < 16; ++j) { const bf16_t* vp = QKV + (rb + j) * NQKV + 2048 + h * 64 + d; const float p = sc[q * 528 + 512 + j]; a0 += p * bf2f(vp[0]); a1 += p * bf2f(vp[1]); }
        *(unsigned*)(MIX + (rb + q) * DM + h * 64 + d) = pk2(a0, a1);
    }
    __syncthreads();
}

#define XB_TMO      128
#define XB_XCNT(j)  (256  + 64 * (j))
#define XB_XSUB(j)  (1280 + 64 * (j))
#define XB_XGEN(j)  (2304 + 64 * (j))
#define XB_TOP      3328
#define XB_TOPGEN   3392
#define XCD_BAR_WORDS 3456
#define XB_SPIN_CAP (1u << 20)
__device__ __forceinline__ unsigned xb_ld(unsigned* p)              { return __hip_atomic_load(p, __ATOMIC_RELAXED, __HIP_MEMORY_SCOPE_AGENT); }
__device__ __forceinline__ unsigned xb_add(unsigned* p, unsigned v) { return __hip_atomic_fetch_add(p, v, __ATOMIC_RELAXED, __HIP_MEMORY_SCOPE_AGENT); }
__device__ __forceinline__ unsigned xb_xcc_id() { return (unsigned)__builtin_amdgcn_s_getreg((3 << 11) | 20) & 0xFu; }
#define XB_SPIN(cond, bar) do { unsigned _sp = 0; while (cond) { __builtin_amdgcn_s_sleep(1); \
    if ((++_sp & 255u) == 0u) { if (xb_ld(&(bar)[XB_TMO])) break; if (_sp > XB_SPIN_CAP) { atomicAdd(&(bar)[XB_TMO], 1u); break; } } } } while (0)
struct XcdBarrier { unsigned* bar; unsigned x; volatile LAS unsigned* st; };
__device__ __forceinline__ XcdBarrier xcd_barrier_post(unsigned* bar, volatile LAS unsigned* st) {
    XcdBarrier b; b.bar = bar; b.x = xb_xcc_id(); b.st = st;
    if (threadIdx.x == 0) (void)xb_add(&bar[XB_XCNT(b.x)], 1u);
    return b;
}
__device__ __forceinline__ void xcd_barrier_complete(unsigned* bar, unsigned x, unsigned& nloc, unsigned& nx) {
    const unsigned G = gridDim.x * gridDim.y * gridDim.z;
    unsigned sum, cnt, mine, sp = 0u;
    for (;;) {
        sum = 0u; cnt = 0u; mine = 0u;
#pragma unroll
        for (unsigned j = 0; j < 16; ++j) { const unsigned c = xb_ld(&bar[XB_XCNT(j)]); sum += c; cnt += (c > 0u) ? 1u : 0u; mine = (j == x) ? c : mine; }
        if (sum == G) break;
        __builtin_amdgcn_s_sleep(1);
        if ((++sp & 255u) == 0u) { if (xb_ld(&bar[XB_TMO])) break; if (sp > XB_SPIN_CAP) { atomicAdd(&bar[XB_TMO], 1u); break; } }
    }
    nloc = mine > 0u ? mine : 1u; nx = cnt > 0u ? cnt : 1u;
}
__device__ __forceinline__ void xcd_barrier(const XcdBarrier& b) {
    asm volatile("s_waitcnt vmcnt(0)" ::: "memory");
    __syncthreads();
    if (threadIdx.x == 0) {
        unsigned* bar = b.bar;
        __builtin_amdgcn_s_waitcnt(0);
        unsigned nloc = b.st[0], nx = b.st[1];
        if (nloc == 0u) { xcd_barrier_complete(bar, b.x, nloc, nx); b.st[0] = nloc; b.st[1] = nx; }
        const unsigned old = xb_add(&bar[XB_XSUB(b.x)], 1u);
        const unsigned gen = old / nloc;
        if (old + 1u == (gen + 1u) * nloc) {
            __builtin_amdgcn_fence(__ATOMIC_RELEASE, "agent");
            asm volatile("s_waitcnt vmcnt(0)" ::: "memory");
            const unsigned og = xb_add(&bar[XB_TOP], 1u);
            const unsigned tg = og / nx;
            if (og + 1u == (tg + 1u) * nx) xb_add(&bar[XB_TOPGEN], 1u);
            else XB_SPIN(xb_ld(&bar[XB_TOPGEN]) == tg, bar);
            __builtin_amdgcn_fence(__ATOMIC_ACQUIRE, "agent");
            xb_add(&bar[XB_XGEN(b.x)], 1u);
            asm volatile("s_waitcnt vmcnt(0)" ::: "memory");
        } else {
            XB_SPIN(xb_ld(&bar[XB_XGEN(b.x)]) == gen, bar);
            __builtin_amdgcn_fence(__ATOMIC_ACQUIRE, "agent");
            asm volatile("s_waitcnt vmcnt(0)" ::: "memory");
        }
    }
    __syncthreads();
}

__global__ void __launch_bounds__(512, 2) hybrid_fwd(Params P) {
    extern __shared__ __attribute__((aligned(16))) unsigned char lds_raw[];
    LAS unsigned char* lds = (LAS unsigned char*)lds_raw;
    const int G = gridDim.x;
    volatile LAS unsigned* xst = (volatile LAS unsigned*)(lds + 131072 + 256);
    if (threadIdx.x < 2) xst[threadIdx.x] = 0u;
    __syncthreads();
    XcdBarrier xbar = xcd_barrier_post((unsigned*)(P.ws + WS_CTL), xst);
    int ph = P.ph_lo, rep = 0;
    while (ph < P.ph_hi) {
        int tid = threadIdx.x; asm volatile("" : "+v"(tid));
        int wg = blockIdx.x; asm volatile("" : "+s"(wg));
        const Params& Q = P;
        const int lane = tid & 63, wid = __builtin_amdgcn_readfirstlane(tid >> 6), gw = wg * 8 + wid, ngw = G * 8;
        unsigned char* ws = Q.ws;
        bf16_t* Xb = (bf16_t*)(ws + WS_XB); bf16_t* R1 = (bf16_t*)(ws + WS_R1); bf16_t* MIX = (bf16_t*)(ws + WS_MIX);
        float* GATES = (float*)(ws + WS_GATES); float* SSP = (float*)(ws + WS_SSP);
        int nrep = 1;
        if (ph == 0) nrep = REP_PRO; else if (ph != NPHASE - 1) { const int q_ = (ph - 1) % 11; if (q_ == 1) nrep = REP_MIX; else if (q_ == 7) nrep = REP_ATT; else if (q_ == 0 || q_ == 4 || q_ == 6 || q_ == 9) nrep = REP_PROJ; }
        if (ph == 0) phase_prologue(Q, lds, gw, ngw, wid, lane);
        else if (ph == NPHASE - 1) phase_final(Q, gw, ngw, lane);
        else {
            int layer, sub;
            { const int r_ = ph - 1, pair_ = r_ / 11, q_ = r_ % 11; if (q_ < 6) { layer = 2 * pair_; sub = (q_ < 2) ? q_ : (q_ == 2 ? 5 : q_ - 1); } else { layer = 2 * pair_ + 1; sub = q_ - 6; } }
            const int li = layer >> 1, odd = layer & 1;
            if (sub == 5) phase_fixup(Q, li, gw, ngw, lane);
            else if (sub == 1) {
                if (!odd) {
                    if (G == 256) {
                        if (wg < 128) delta_unit(Q, lds, li, false, wg >> 4, (wg >> 1) & 7, wg & 1, tid);
                        else if (wg < 192) { const int u = wg - 128; gla_unit(Q, lds, li, false, u >> 3, u & 7, tid); }
                        else { const int u = wg - 192; delta_unit(Q, lds, li, true, u >> 3, u & 7, 0, tid); delta_unit(Q, lds, li, true, u >> 3, u & 7, 1, tid); gla_unit(Q, lds, li, true, u >> 3, u & 7, tid); }
                    }
                } else {
                    for (int u = wg * 8; u < wg * 8 + 8; ++u) attn_prompt_unit(Q, lds, li, u >> 8, (u >> 4) & 15, u & 15, tid);
                    if (wg < 128) attn_sample_unit(Q, lds, li, wg >> 4, wg & 15, tid);
                }
            } else {
                pg8::Gemm g; int mode, Npos;
                g.M = TP;
                LAS unsigned long long* eap = (LAS unsigned long long*)(lds + EA_OFF);
#define EA_SET(i, p) eap[i] = (unsigned long long)(p)
                if (sub == 0) {
                    g.A = Xb; g.K = 1024;
                    if (!odd) { mode = 0; Npos = ABPAD; g.Bt = (const bf16_t*)(ws + WS_WIN + li * SZ_WIN);
                        if (tid == 0) { EA_SET(0, R1); EA_SET(1, SSP); EA_SET(2, GATES); EA_SET(3, Q.out + O_CONVP + (size_t)li * 8 * 3 * DNQKV); EA_SET(4, Q.out + O_CONVS + (size_t)li * 8 * 3 * DNQKV); } }
                    else { mode = 1; Npos = NQKV; g.Bt = (const bf16_t*)(ws + WS_WQKV + li * SZ_WQKV);
                        if (tid == 0) { EA_SET(0, R1); EA_SET(1, SSP); EA_SET(3, Q.out + O_CKP + (size_t)li * 8 * 512 * 1024); EA_SET(4, Q.out + O_CVP + (size_t)li * 8 * 512 * 1024); EA_SET(5, Q.out + O_CKS + (size_t)li * 8 * 16 * 1024); EA_SET(6, Q.out + O_CVS + (size_t)li * 8 * 16 * 1024); } }
                } else if (sub == 2) {
                    mode = 2; Npos = 1024; g.A = MIX; g.K = 1024; g.Bt = (const bf16_t*)(ws + (odd ? WS_WCOUT : WS_WOUT) + li * SZ_W1K);
                    if (tid == 0) { EA_SET(7, (layer == 0) ? Q.in[0] : Q.out); EA_SET(8, (layer == 0) ? Q.in[1] : Q.out + (size_t)TP * DM); EA_SET(9, Q.out); EA_SET(10, Xb); EA_SET(11, SSP); }
                } else if (sub == 3) {
                    mode = 3; Npos = NGU; g.A = Xb; g.K = 1024; g.Bt = (const bf16_t*)(ws + WS_WGU + layer * SZ_WGU);
                    if (tid == 0) { EA_SET(0, R1); EA_SET(1, SSP); }
                } else {
                    mode = 2; Npos = 1024; g.A = R1; g.K = DFF; g.Bt = (const bf16_t*)(ws + WS_WDN + layer * SZ_WDN);
                    if (tid == 0) { EA_SET(7, Q.out); EA_SET(8, Q.out + (size_t)TP * DM); EA_SET(9, Q.out); EA_SET(10, Xb); EA_SET(11, SSP); }
                }
#undef EA_SET
                g.N = Npos;
                __syncthreads();
                pg8::StaticOrder S; S.init(TP, Npos, G, wg);
                if (mode == 0) { small_gemm<0>(g.A, g.Bt, Npos, g.K, eap, lds, wg, G, wid, lane); Epi<0> E{eap}; pg8::gemm_phase<Epi<0>, true, true>(lds, g, S, E, tid); }
                else if (mode == 1) { small_gemm<1>(g.A, g.Bt, Npos, g.K, eap, lds, wg, G, wid, lane); Epi<1> E{eap}; pg8::gemm_phase<Epi<1>, true, true>(lds, g, S, E, tid); }
                else if (mode == 2) { small_gemm<2>(g.A, g.Bt, Npos, g.K, eap, lds, wg, G, wid, lane); Epi<2> E{eap}; pg8::gemm_phase<Epi<2>, true, true>(lds, g, S, E, tid); }
                else { small_gemm<3>(g.A, g.Bt, Npos, g.K, eap, lds, wg, G, wid, lane); Epi<3> E{eap}; pg8::gemm_phase<Epi<3>, true, true>(lds, g, S, E, tid); }
            }
        }
        if (++rep >= nrep) { rep = 0; ++ph; }
        if (ph < P.ph_hi) { if (ph == 1 && rep == 0) cg::this_grid().sync(); else xcd_barrier(xbar); }
    }
}

extern "C" void kernel_launch(void* const* d_in, const int* in_sizes, int n_in, void* d_out, int out_size, void* d_ws, size_t ws_size, hipStream_t stream) {
    static int grid = 0;
    if (grid == 0) {
        if (n_in != 25 || (size_t)out_size != O_END || ws_size < WS_END) { fprintf(stderr, "kernel_launch: unexpected sizes n_in %d out %d ws %zu (need %zu)\n", n_in, out_size, ws_size, (size_t)WS_END); grid = -1; return; }
        if (hipFuncSetAttribute((const void*)hybrid_fwd, hipFuncAttributeMaxDynamicSharedMemorySize, LDS_BYTES) != hipSuccess) { fprintf(stderr, "kernel_launch: hipFuncSetAttribute failed\n"); grid = -1; return; }
        int dev = 0, cus = 0, per_cu = 0;
        hipGetDevice(&dev); hipDeviceGetAttribute(&cus, hipDeviceAttributeMultiprocessorCount, dev);
        hipOccupancyMaxActiveBlocksPerMultiprocessor(&per_cu, (const void*)hybrid_fwd, 512, LDS_BYTES);
        (void)hipGetLastError();
        if (cus != 256 || per_cu < 1) fprintf(stderr, "kernel_launch: note: cus %d per_cu %d\n", cus, per_cu);
        grid = 256;
    }
    if (grid < 0) return;
    Params p{};
    for (int i = 0; i < 25; ++i) p.in[i] = (const float*)d_in[i];
    p.out = (float*)d_out; p.ws = (unsigned char*)d_ws;
#if MK_MULTI
    for (int ph = 0; ph < NPHASE; ++ph) { p.ph_lo = ph; p.ph_hi = ph + 1; hipLaunchKernelGGL(hybrid_fwd, dim3(grid), dim3(512), LDS_BYTES, stream, p); }
#else
    (void)hipMemsetAsync((char*)d_ws + WS_CTL, 0, CTL_BYTES, stream);
    p.ph_lo = 0; p.ph_hi = NPHASE;
    void* args[] = {&p};
    hipError_t e = hipLaunchCooperativeKernel((const void*)hybrid_fwd, dim3(grid), dim3(512), args, LDS_BYTES, stream);
    if (e != hipSuccess) fprintf(stderr, "cooperative launch failed: %s\n", hipGetErrorString(e));
#endif
}
```

```cpp
#include <hip/hip_runtime.h>
#include <hip/hip_cooperative_groups.h>
#include <cstdio>
#include <cstdint>
namespace cg = cooperative_groups;

#ifndef MK_MULTI
#define MK_MULTI 0
#endif

#ifndef REP_MIX
#define REP_MIX 1
#endif
#ifndef REP_ATT
#define REP_ATT 1
#endif
#ifndef REP_PRO
#define REP_PRO 1
#endif
#ifndef REP_PROJ
#define REP_PROJ 1
#endif
#define LAS __attribute__((address_space(3)))
#define GAS __attribute__((address_space(1)))
typedef unsigned short bf16_t;
typedef short bf16x8 __attribute__((ext_vector_type(8)));
typedef float f32x2 __attribute__((ext_vector_type(2)));
typedef float f32x4 __attribute__((ext_vector_type(4)));
typedef float f32x16 __attribute__((ext_vector_type(16)));
typedef unsigned u32x2 __attribute__((ext_vector_type(2)));
typedef unsigned u32x4 __attribute__((ext_vector_type(4)));

constexpr int DM = 1024, NB = 8, SEQ = 4096, SB = 8, SSEQ = 16, PAST = 2048;
constexpr int TP = NB * SEQ;
constexpr int TS = SB * SSEQ;
constexpr int TR = TP + TS;
constexpr int ABIN = 3616, ABPAD = 3840, DFF = 2816, NGU = 5632, NQKV = 3072, DNQKV = 1536;
constexpr float EPS = 1e-6f;
constexpr float LOG2E = 1.4426950408889634f;

constexpr size_t O_Y = 0;
constexpr size_t O_CONVP = (size_t)TR * DM;
constexpr size_t O_CONVS = O_CONVP + 2 * 8 * 3 * 1536;
constexpr size_t O_DNP = O_CONVS + 2 * 8 * 3 * 1536;
constexpr size_t O_DNS = O_DNP + 2 * 8 * 8 * 64 * 64;
constexpr size_t O_GLAP = O_DNS + 2 * 8 * 8 * 64 * 64;
constexpr size_t O_GLAS = O_GLAP + 2 * 8 * 8 * 32 * 64;
constexpr size_t O_CKP = O_GLAS + 2 * 8 * 8 * 32 * 64;
constexpr size_t O_CKS = O_CKP + (size_t)2 * 8 * 512 * 1024;
constexpr size_t O_CVP = O_CKS + 2 * 8 * 16 * 1024;
constexpr size_t O_CVS = O_CVP + (size_t)2 * 8 * 512 * 1024;
constexpr size_t O_END = O_CVS + 2 * 8 * 16 * 1024;

constexpr size_t SZ_WIN = (size_t)ABPAD * 1024 * 2, SZ_W1K = (size_t)1024 * 1024 * 2, SZ_WQKV = (size_t)NQKV * 1024 * 2, SZ_WGU = (size_t)NGU * 1024 * 2, SZ_WDN = (size_t)1024 * DFF * 2;
constexpr size_t WS_WIN = 0;
constexpr size_t WS_WOUT = WS_WIN + 2 * SZ_WIN;
constexpr size_t WS_WQKV = WS_WOUT + 2 * SZ_W1K;
constexpr size_t WS_WCOUT = WS_WQKV + 2 * SZ_WQKV;
constexpr size_t WS_WGU = WS_WCOUT + 2 * SZ_W1K;
constexpr size_t WS_WDN = WS_WGU + 4 * SZ_WGU;
constexpr size_t WS_XB = WS_WDN + 4 * SZ_WDN;
constexpr size_t WS_R1 = WS_XB + (size_t)TR * 1024 * 2;
constexpr size_t WS_MIX = WS_R1 + (size_t)TR * ABIN * 2;
constexpr size_t WS_GATES = WS_MIX + (size_t)TR * 1024 * 2;
constexpr size_t WS_SSP = WS_GATES + (size_t)TR * 32 * 4;
constexpr size_t WS_CTL = WS_SSP + (size_t)TR * 16 * 4;
constexpr size_t CTL_BYTES = 16384;
constexpr size_t WS_END = WS_CTL + CTL_BYTES;

constexpr int LDS_BYTES = 147456;
constexpr int NPHASE = 24;

struct Params { const float* in[25]; float* out; unsigned char* ws; int ph_lo, ph_hi; };

__device__ __forceinline__ unsigned f2bf(float f) { unsigned u = __builtin_bit_cast(unsigned, f); return (u + 0x7fffu + ((u >> 16) & 1u)) >> 16; }
typedef __bf16 hwbf16x2 __attribute__((ext_vector_type(2)));
__device__ __forceinline__ unsigned pk2(float lo, float hi) { const f32x2 v = {lo, hi}; return __builtin_bit_cast(unsigned, __builtin_convertvector(v, hwbf16x2)); }
__device__ __forceinline__ float bf2f(bf16_t b) { return __builtin_bit_cast(float, ((unsigned)b) << 16); }
template <int CTRL> __device__ __forceinline__ float dppf(float v) { return __builtin_bit_cast(float, __builtin_amdgcn_update_dpp(0, __builtin_bit_cast(int, v), CTRL, 0xF, 0xF, true)); }
__device__ __forceinline__ float quad_sum(float v) { v += dppf<0xB1>(v); v += dppf<0x4E>(v); return v; }
__device__ __forceinline__ float oct_sum(float v) { v = quad_sum(v); v += dppf<0x141>(v); return v; }
__device__ __forceinline__ float wave_sum(float v) {
    v = oct_sum(v); v += dppf<0x140>(v);
    const int i = __builtin_bit_cast(int, v);
    return (__builtin_bit_cast(float, __builtin_amdgcn_readlane(i, 0)) + __builtin_bit_cast(float, __builtin_amdgcn_readlane(i, 16))) +
           (__builtin_bit_cast(float, __builtin_amdgcn_readlane(i, 32)) + __builtin_bit_cast(float, __builtin_amdgcn_readlane(i, 48)));
}
__device__ __forceinline__ float fast_rcp(float x) { return __builtin_amdgcn_rcpf(x); }
__device__ __forceinline__ float silu_f(float x) { return x * fast_rcp(1.0f + __expf(-x)); }
__device__ __forceinline__ float sigmoid_f(float x) { return fast_rcp(1.0f + __expf(-x)); }
__device__ __forceinline__ float softplus_f(float x) { return fmaxf(x, 0.f) + __logf(1.0f + __expf(-fabsf(x))); }

namespace pg8 {
constexpr int BM = 256, BK = 64, HALF = 128, HTB = HALF * BK * 2, STAGE_BYTES = 8 * HTB, NXCD = 8, WGM = 8;
__host__ __device__ __forceinline__ int lds_byte(int r, int c) { const int st = (r >> 4) * 2 + (c >> 5), rr = r & 15, cc = c & 31, ob = rr * 64 + cc * 2; return st * 1024 + (ob ^ (((ob >> 9) & 1) << 5)); }
__host__ __device__ __forceinline__ void stage_rc(int b, int& R, int& C) { const int st = b / 1024, sb = b % 1024, swz = sb ^ (((sb >> 9) & 1) << 5); R = (st >> 1) * 16 + swz / 64; C = (st & 1) * 32 + (swz % 64) / 2; }
__host__ __device__ __forceinline__ int perm32(int rho) { const int n = rho >> 4, i = rho & 15; return 8 * (i >> 2) + 4 * n + (i & 3); }
struct Unit { int pm, pn; };
struct Gemm { const bf16_t* A; const bf16_t* Bt; int M, N, K; };
struct StaticOrder {
    int nM, nN, nwg, G, c;
    __host__ __device__ void init(int M, int N, int G_, int c_) { nM = M / BM; nN = N / BM; nwg = nM * nN; G = G_; c = c_; }
    __host__ __device__ bool next(int i, Unit& u) const {
        const long L = (long)i * G + c; if (L >= nwg) return false;
        int wgid = (int)L; { const int q = nwg / NXCD, r = nwg % NXCD, xcd = wgid % NXCD, off = wgid / NXCD; wgid = (xcd < r ? xcd * (q + 1) : r * (q + 1) + (xcd - r) * q) + off; }
        const int nig = WGM * nN, gid = wgid / nig, fm = gid * WGM, gsz = (nM - fm) < WGM ? (nM - fm) : WGM;
        u.pm = fm + ((wgid % nig) % gsz); u.pn = (wgid % nig) / gsz; return true;
    }
};

template <class Epi, bool ALIGN_EPI, bool SP2>
__device__ __forceinline__ void gemm_phase(LAS unsigned char* lds, const Gemm g, const StaticOrder& S, const Epi& E, const int tid) {
    const int wid = __builtin_amdgcn_readfirstlane(tid >> 6), lane = tid & 63, wr = wid >> 2, wc = wid & 3, fr = lane & 15, fq = lane >> 4;
    const int K = g.K, nt = K / BK;
    unsigned voffA[2], voffB[2];
#pragma unroll
    for (int i = 0; i < 2; ++i) { int R, C; stage_rc(tid * 16 + i * 8192, R, C); voffA[i] = (unsigned)(R * K + C) * 2u; voffB[i] = (unsigned)(R * K + C) * 2u; }
    const size_t kstep = (size_t)(BK * 2);
    const size_t hstep = (size_t)HALF * K * 2;
    const size_t tstep = 2 * hstep;
    const unsigned ldsw = (unsigned)wid * 1024u;
    const int aoff = lds_byte(wr * 64 + fr, fq * 8), boff = lds_byte(wc * 32 + fr, fq * 8);
#define PG8_SA(b, h) (((b) * 2 + (h)) * HTB)
#define PG8_SB(b, h) ((4 + (b) * 2 + (h)) * HTB)
#define PG8_STAGE(bufoff, gbase, voff) do { _Pragma("unroll") for (int _i = 0; _i < 2; ++_i) \
        __builtin_amdgcn_global_load_lds((const unsigned*)((const char*)(gbase) + (voff)[_i]), (LAS unsigned*)(lds + (bufoff) + ldsw + _i * 8192), 16, 0, 0); } while (0)
#define PG8_LDA(dst, b, h) do { _Pragma("unroll") for (int m = 0; m < 4; ++m) _Pragma("unroll") for (int k = 0; k < 2; ++k) dst[m][k] = *(const LAS bf16x8*)(lds + PG8_SA(b, h) + aoff + m * 2048 + k * 1024); } while (0)
#define PG8_LDB(dst, b, h) do { _Pragma("unroll") for (int n = 0; n < 2; ++n) _Pragma("unroll") for (int k = 0; k < 2; ++k) dst[n][k] = *(const LAS bf16x8*)(lds + PG8_SB(b, h) + boff + n * 2048 + k * 1024); } while (0)
#define PG8_MMA(ai, bj, At, Bt) do { __builtin_amdgcn_s_setprio(1); _Pragma("unroll") for (int m = 0; m < 4; ++m) _Pragma("unroll") for (int n = 0; n < 2; ++n) _Pragma("unroll") for (int k = 0; k < 2; ++k) \
        acc[ai][bj][m][n] = __builtin_amdgcn_mfma_f32_16x16x32_bf16(Bt[n][k], At[m][k], acc[ai][bj][m][n], 0, 0, 0); __builtin_amdgcn_s_setprio(0); } while (0)
#define PG8_WAIT_V(n) asm volatile("s_waitcnt vmcnt(" #n ")" ::: "memory")
#define PG8_WAIT_L(n) asm volatile("s_waitcnt lgkmcnt(" #n ")" ::: "memory")
#define PG8_BAR __builtin_amdgcn_s_barrier()
#define PG8_SCHED __builtin_amdgcn_sched_barrier(0)
    Unit cur, nxt; int ui = 0;
    if (!S.next(0, cur)) return;
    f32x4 acc[2][2][4][2];
#pragma unroll
    for (int a = 0; a < 2; ++a)
#pragma unroll
        for (int b = 0; b < 2; ++b)
#pragma unroll
            for (int m = 0; m < 4; ++m)
#pragma unroll
                for (int n = 0; n < 2; ++n) acc[a][b][m][n] = (f32x4){0.f, 0.f, 0.f, 0.f};
    bf16x8 At[4][2], B0[2][2], B1[2][2];
    const char* cA = (const char*)g.A + (size_t)cur.pm * tstep; const char* cB = (const char*)g.Bt + (size_t)cur.pn * tstep;
    if constexpr (SP2) {
        PG8_STAGE(PG8_SB(0, 0), cB, voffB); PG8_STAGE(PG8_SB(0, 1), cB + hstep, voffB); PG8_STAGE(PG8_SA(0, 0), cA, voffA); PG8_STAGE(PG8_SA(0, 1), cA + hstep, voffA);
        if (wr == 1) PG8_BAR;
        PG8_WAIT_V(2); PG8_BAR;
        PG8_STAGE(PG8_SB(1, 0), cB + kstep, voffB); PG8_STAGE(PG8_SA(1, 0), cA + kstep, voffA); PG8_STAGE(PG8_SB(1, 1), cB + hstep + kstep, voffB);
        PG8_WAIT_V(6); PG8_BAR;
    } else {
        PG8_STAGE(PG8_SB(0, 0), cB, voffB); PG8_STAGE(PG8_SA(0, 0), cA, voffA); PG8_STAGE(PG8_SB(0, 1), cB + hstep, voffB); PG8_STAGE(PG8_SA(0, 1), cA + hstep, voffA);
        if (wr == 1) PG8_BAR;
        PG8_WAIT_V(4); PG8_BAR;
        PG8_STAGE(PG8_SB(1, 0), cB + kstep, voffB); PG8_STAGE(PG8_SA(1, 0), cA + kstep, voffA); PG8_STAGE(PG8_SB(1, 1), cB + hstep + kstep, voffB);
        PG8_WAIT_V(6); PG8_BAR;
    }
    for (;;) {
        const bool has_next = S.next(ui + 1, nxt);
        const char* nA = has_next ? (const char*)g.A + (size_t)nxt.pm * tstep : cA; const char* nB = has_next ? (const char*)g.Bt + (size_t)nxt.pn * tstep : cB;
        for (int t = 0; t < nt; t += 2) {
            const bool last = (t == nt - 2);
            const char* a1 = cA + (size_t)(t + 1) * kstep;
            const char* a2 = last ? nA : cA + (size_t)(t + 2) * kstep; const char* b2 = last ? nB : cB + (size_t)(t + 2) * kstep;
            const char* a3 = a2 + kstep; const char* b3 = b2 + kstep;
            if constexpr (SP2) {
            PG8_LDB(B0, 0, 0); PG8_LDB(B1, 0, 1); PG8_SCHED; PG8_LDA(At, 0, 0); PG8_STAGE(PG8_SA(1, 1), a1 + hstep, voffA);
            PG8_WAIT_V(8); PG8_WAIT_L(0); PG8_BAR; PG8_MMA(0, 0, At, B0); PG8_MMA(0, 1, At, B1); PG8_BAR; PG8_SCHED;
            PG8_LDA(At, 0, 1); PG8_STAGE(PG8_SB(0, 0), b2, voffB); PG8_STAGE(PG8_SB(0, 1), b2 + hstep, voffB); PG8_STAGE(PG8_SA(0, 0), a2, voffA);
            PG8_WAIT_V(8); PG8_WAIT_L(0); PG8_BAR; PG8_MMA(1, 0, At, B0); PG8_MMA(1, 1, At, B1); PG8_BAR; PG8_SCHED;
            PG8_LDB(B0, 1, 0); PG8_LDB(B1, 1, 1); PG8_SCHED; PG8_LDA(At, 1, 0); PG8_STAGE(PG8_SA(0, 1), a2 + hstep, voffA);
            PG8_WAIT_V(8); PG8_WAIT_L(0); PG8_BAR; PG8_MMA(0, 0, At, B0); PG8_MMA(0, 1, At, B1); PG8_BAR; PG8_SCHED;
            PG8_LDA(At, 1, 1); PG8_STAGE(PG8_SB(1, 0), b3, voffB); PG8_STAGE(PG8_SB(1, 1), b3 + hstep, voffB); PG8_STAGE(PG8_SA(1, 0), a3, voffA);
            PG8_WAIT_V(8); PG8_WAIT_L(0); PG8_BAR; PG8_MMA(1, 0, At, B0); PG8_MMA(1, 1, At, B1); PG8_BAR; PG8_SCHED;
            } else {
            PG8_LDB(B0, 0, 0); PG8_SCHED; PG8_LDA(At, 0, 0); PG8_STAGE(PG8_SA(1, 1), a1 + hstep, voffA);
            PG8_WAIT_L(8); PG8_BAR; PG8_WAIT_L(0); PG8_MMA(0, 0, At, B0); PG8_BAR; PG8_SCHED;
            PG8_LDB(B1, 0, 1); PG8_STAGE(PG8_SB(0, 0), b2, voffB);
            PG8_BAR; PG8_WAIT_L(0); PG8_MMA(0, 1, At, B1); PG8_BAR;
            PG8_LDA(At, 0, 1); PG8_STAGE(PG8_SA(0, 0), a2, voffA);
            PG8_BAR; PG8_WAIT_L(0); PG8_MMA(1, 0, At, B0); PG8_BAR; PG8_SCHED;
            PG8_STAGE(PG8_SB(0, 1), b2 + hstep, voffB);
            PG8_WAIT_V(6); PG8_BAR; PG8_MMA(1, 1, At, B1); PG8_BAR;
            PG8_LDB(B0, 1, 0); PG8_SCHED; PG8_LDA(At, 1, 0); PG8_STAGE(PG8_SA(0, 1), a2 + hstep, voffA);
            PG8_WAIT_L(8); PG8_BAR; PG8_WAIT_L(0); PG8_MMA(0, 0, At, B0); PG8_BAR; PG8_SCHED;
            PG8_LDB(B1, 1, 1); PG8_STAGE(PG8_SB(1, 0), b3, voffB);
            PG8_BAR; PG8_WAIT_L(0); PG8_MMA(0, 1, At, B1); PG8_BAR;
            PG8_LDA(At, 1, 1); PG8_STAGE(PG8_SA(1, 0), a3, voffA);
            PG8_BAR; PG8_WAIT_L(0); PG8_MMA(1, 0, At, B0); PG8_BAR; PG8_SCHED;
            PG8_STAGE(PG8_SB(1, 1), b3 + hstep, voffB);
            PG8_WAIT_V(6); PG8_BAR; PG8_MMA(1, 1, At, B1); PG8_BAR;
            }
        }
        if constexpr (ALIGN_EPI) { if (wr == 0) PG8_BAR; }
        E(acc, cur, wr, wc, fr, fq);
        if (!has_next) break;
#pragma unroll
        for (int a = 0; a < 2; ++a)
#pragma unroll
            for (int b = 0; b < 2; ++b)
#pragma unroll
                for (int m = 0; m < 4; ++m)
#pragma unroll
                    for (int n = 0; n < 2; ++n) acc[a][b][m][n] = (f32x4){0.f, 0.f, 0.f, 0.f};
        cur = nxt; cA = nA; cB = nB; ++ui;
        if constexpr (ALIGN_EPI) { if (wr == 1) PG8_BAR; }
    }
    PG8_WAIT_V(0);
    if constexpr (!ALIGN_EPI) { if (wr == 0) PG8_BAR; }
    PG8_BAR;
#undef PG8_SA
#undef PG8_SB
#undef PG8_STAGE
#undef PG8_LDA
#undef PG8_LDB
#undef PG8_MMA
#undef PG8_WAIT_V
#undef PG8_WAIT_L
#undef PG8_BAR
#undef PG8_SCHED
}
}

struct EpiArgs {
    GAS bf16_t* out; const GAS float* ssp; GAS float* gates; GAS float* o0; GAS float* o1; GAS float* o2; GAS float* o3;
    const GAS float* base_p; const GAS float* base_s; GAS float* X; GAS bf16_t* Xb; GAS float* ssp_out;
};
__device__ __forceinline__ float row_rstd(const GAS float* ssp, int row) {
    const GAS f32x4* p = (const GAS f32x4*)(ssp + (size_t)row * 16);
    const f32x4 a = p[0], b = p[1], c = p[2], d = p[3];
    const float s = ((a[0] + a[1]) + (a[2] + a[3])) + ((b[0] + b[1]) + (b[2] + b[3])) + ((c[0] + c[1]) + (c[2] + c[3])) + ((d[0] + d[1]) + (d[2] + d[3]));
    return rsqrtf(s * (1.0f / 1024.0f) + EPS);
}
template <int MODE, bool SMALL>
__device__ __forceinline__ float epi_apply(const EpiArgs& a, int row, int g32, int fq, f32x4 v0, f32x4 v1, float rstd) {
    const int c0 = 32 * g32 + 8 * fq;
    if constexpr (MODE == 0) {
        if (g32 >= ABIN / 32) return 0.f;
        v0 *= rstd; v1 *= rstd;
        u32x4 w; w.x = pk2(v0[0], v0[1]); w.y = pk2(v0[2], v0[3]); w.z = pk2(v1[0], v1[1]); w.w = pk2(v1[2], v1[3]);
        *(GAS u32x4*)(a.out + (size_t)row * ABIN + c0) = w;
        if (g32 == 48 && fq < 2) { GAS float* gp = a.gates + (size_t)row * 32 + 8 * fq; *(GAS f32x4*)gp = v0; *(GAS f32x4*)(gp + 4) = v1; }
        if (g32 == 96 && fq >= 2) { GAS float* gp = a.gates + (size_t)row * 32 + 16 + 8 * (fq - 2); *(GAS f32x4*)gp = v0; *(GAS f32x4*)(gp + 4) = v1; }
        if (c0 < DNQKV) {
            if constexpr (!SMALL) { const int t = row & (SEQ - 1), b = row >> 12; if (t >= SEQ - 3) { GAS float* d = a.o0 + (size_t)(b * 3 + (t - (SEQ - 3))) * DNQKV + c0; *(GAS f32x4*)d = v0; *(GAS f32x4*)(d + 4) = v1; } }
            else { const int r = row - TP, t = r & 15, b = r >> 4; if (t >= SSEQ - 3) { GAS float* d = a.o1 + (size_t)(b * 3 + (t - (SSEQ - 3))) * DNQKV + c0; *(GAS f32x4*)d = v0; *(GAS f32x4*)(d + 4) = v1; } }
        }
        return 0.f;
    } else if constexpr (MODE == 1) {
        v0 *= rstd; v1 *= rstd;
        u32x4 w; w.x = pk2(v0[0], v0[1]); w.y = pk2(v0[2], v0[3]); w.z = pk2(v1[0], v1[1]); w.w = pk2(v1[2], v1[3]);
        *(GAS u32x4*)(a.out + (size_t)row * NQKV + c0) = w;
        if (c0 >= 1024) {
            const int isv = c0 >= 2048, cc = c0 - 1024 - 1024 * isv;
            if constexpr (!SMALL) { const int t = row & (SEQ - 1), b = row >> 12; if (t >= SEQ - 512) { GAS float* d = a.o0 + (size_t)isv * (O_CVP - O_CKP) + (size_t)(b * 512 + (t - (SEQ - 512))) * 1024 + cc; *(GAS f32x4*)d = v0; *(GAS f32x4*)(d + 4) = v1; } }
            else { const int r = row - TP; GAS float* d = a.o2 + (size_t)isv * (O_CVS - O_CKS) + (size_t)r * 1024 + cc; *(GAS f32x4*)d = v0; *(GAS f32x4*)(d + 4) = v1; }
        }
        return 0.f;
    } else if constexpr (MODE == 2) {
        const GAS float* bp = SMALL ? a.base_s + (size_t)(row - TP) * DM + c0 : a.base_p + (size_t)row * DM + c0;
        const f32x4 x0 = *(const GAS f32x4*)bp + v0, x1 = *(const GAS f32x4*)(bp + 4) + v1;
        GAS float* xp = a.X + (size_t)row * DM + c0; *(GAS f32x4*)xp = x0; *(GAS f32x4*)(xp + 4) = x1;
        u32x4 w; w.x = pk2(x0[0], x0[1]); w.y = pk2(x0[2], x0[3]); w.z = pk2(x1[0], x1[1]); w.w = pk2(x1[2], x1[3]);
        *(GAS u32x4*)(a.Xb + (size_t)row * DM + c0) = w;
        return ((x0[0] * x0[0] + x0[1] * x0[1]) + (x0[2] * x0[2] + x0[3] * x0[3])) + ((x1[0] * x1[0] + x1[1] * x1[1]) + (x1[2] * x1[2] + x1[3] * x1[3]));
    } else {
        v0 *= rstd; v1 *= rstd;
        float h[4];
#pragma unroll
        for (int j = 0; j < 4; ++j) h[j] = silu_f(v0[j]) * v1[j];
        u32x2 w; w.x = pk2(h[0], h[1]); w.y = pk2(h[2], h[3]);
        *(GAS u32x2*)(a.out + (size_t)row * DFF + 16 * g32 + 4 * fq) = w;
        return 0.f;
    }
}
constexpr int EA_OFF = 131072 + 512;
__device__ __forceinline__ EpiArgs load_ea(const LAS unsigned long long* ap) {
    EpiArgs a;
    a.out = (GAS bf16_t*)ap[0]; a.ssp = (const GAS float*)ap[1]; a.gates = (GAS float*)ap[2]; a.o0 = (GAS float*)ap[3]; a.o1 = (GAS float*)ap[4]; a.o2 = (GAS float*)ap[5]; a.o3 = (GAS float*)ap[6];
    a.base_p = (const GAS float*)ap[7]; a.base_s = (const GAS float*)ap[8]; a.X = (GAS float*)ap[9]; a.Xb = (GAS bf16_t*)ap[10]; a.ssp_out = (GAS float*)ap[11];
    return a;
}
template <int MODE> struct Epi {
    const LAS unsigned long long* ap;
    __device__ __forceinline__ void operator()(const f32x4 (&acc)[2][2][4][2], const pg8::Unit& u, int wr, int wc, int fr, int fq) const {
        const EpiArgs a = load_ea(ap);
#pragma unroll
        for (int ai = 0; ai < 2; ++ai)
#pragma unroll
            for (int m = 0; m < 4; ++m) {
                const int row = u.pm * 256 + ai * 128 + wr * 64 + m * 16 + fr;
                float rstd = 1.f; if constexpr (MODE != 2) rstd = row_rstd(a.ssp, row);
                float ss = 0.f;
#pragma unroll
                for (int bj = 0; bj < 2; ++bj) { const int g32 = (u.pn * 256 + bj * 128 + wc * 32) >> 5; ss += epi_apply<MODE, false>(a, row, g32, fq, acc[ai][bj][m][0], acc[ai][bj][m][1], rstd); }
                if constexpr (MODE == 2) { ss += __shfl_xor(ss, 16); ss += __shfl_xor(ss, 32); if (fq == 0) a.ssp_out[(size_t)row * 16 + u.pn * 4 + wc] = ss; }
            }
    }
};

template <int MODE>
__device__ __forceinline__ void small_gemm(const bf16_t* A, const bf16_t* Bt, int Npos, int K, const LAS unsigned long long* eap, LAS unsigned char* lds, int wg, int G, int wid, int lane) {
    const int fr = lane & 15, fq = lane >> 4, ncg = (MODE == 0 ? (ABIN + 63) / 64 : Npos / 64), nunits = (TS / 16) * ncg, KW = K / 8;
    LAS f32x4* part = (LAS f32x4*)lds;
    for (int u = wg; u < nunits; u += G) {
        const int rb = u % (TS / 16), cgp = u / (TS / 16), r0 = TP + rb * 16, p0 = cgp * 64;
        f32x4 acc[4];
#pragma unroll
        for (int f = 0; f < 4; ++f) acc[f] = (f32x4){0.f, 0.f, 0.f, 0.f};
        const bf16_t* ap = A + (size_t)(r0 + fr) * K + wid * KW + 8 * fq;
        const bf16_t* bp = Bt + (size_t)(p0 + fr) * K + wid * KW + 8 * fq;
        for (int k0 = 0; k0 < KW; k0 += 32) {
            const bf16x8 av = *(const bf16x8*)(ap + k0);
            bf16x8 wv[4];
#pragma unroll
            for (int f = 0; f < 4; ++f) wv[f] = *(const bf16x8*)(bp + (size_t)(16 * f) * K + k0);
#pragma unroll
            for (int f = 0; f < 4; ++f) acc[f] = __builtin_amdgcn_mfma_f32_16x16x32_bf16(wv[f], av, acc[f], 0, 0, 0);
        }
#pragma unroll
        for (int f = 0; f < 4; ++f) part[(wid * 4 + f) * 64 + lane] = acc[f];
        __syncthreads();
        if (wid == 0) {
#pragma unroll
            for (int w = 1; w < 8; ++w)
#pragma unroll
                for (int f = 0; f < 4; ++f) acc[f] += part[(w * 4 + f) * 64 + lane];
            const int row = r0 + fr;
            const EpiArgs a = load_ea(eap);
            float rstd = 1.f; if constexpr (MODE != 2) rstd = row_rstd(a.ssp, row);
            float ss = 0.f;
#pragma unroll
            for (int gq = 0; gq < 2; ++gq) ss += epi_apply<MODE, true>(a, row, (p0 >> 5) + gq, fq, acc[2 * gq], acc[2 * gq + 1], rstd);
            if constexpr (MODE == 2) { ss += __shfl_xor(ss, 16); ss += __shfl_xor(ss, 32); if (fq == 0) a.ssp_out[(size_t)row * 16 + cgp] = ss; }
        }
        __syncthreads();
    }
}

__device__ __forceinline__ void transpose_item(const float* W, int K, int Nsrc, int gu, const float* gamma, bf16_t* WT, LAS float* scr, int item, int npb, int lane) {
    const int kb = item / npb, nb = item % npb, k0 = 64 * kb, p0 = 32 * nb;
    const int cl = p0 + pg8::perm32(lane & 31);
    int src = cl; if (gu) src = ((cl >> 2) & 1) * DFF + 4 * (cl >> 3) + (cl & 3);
    const bool valid = src < Nsrc;
#pragma unroll 8
    for (int i = 0; i < 32; ++i) { const int kk = 2 * i + (lane >> 5); float v = 0.f; if (valid) { v = W[(size_t)(k0 + kk) * Nsrc + src]; if (gamma) v *= gamma[k0 + kk]; } scr[kk * 33 + (lane & 31)] = v; }
    asm volatile("s_waitcnt lgkmcnt(0)" ::: "memory");
    const int c = lane & 7;
#pragma unroll
    for (int j = 0; j < 4; ++j) { const int n = (lane >> 3) + 8 * j; const LAS float* s = scr + (8 * c) * 33 + n;
        u32x4 o; o.x = pk2(s[0 * 33], s[1 * 33]); o.y = pk2(s[2 * 33], s[3 * 33]); o.z = pk2(s[4 * 33], s[5 * 33]); o.w = pk2(s[6 * 33], s[7 * 33]);
        *(u32x4*)(WT + (size_t)(p0 + n) * K + k0 + 8 * c) = o; }
    asm volatile("s_waitcnt lgkmcnt(0)" ::: "memory");
}
__device__ __forceinline__ void convert_matrix(const float* W, int K, int Nsrc, int Npos, int gu, const float* gamma, bf16_t* WT, LAS float* scr, int gw, int ngw, int lane) {
    const int npb = Npos / 32, nitems = (K / 64) * npb;
    for (int it = gw; it < nitems; it += ngw) transpose_item(W, K, Nsrc, gu, gamma, WT, scr, it, npb, lane);
}
__device__ __forceinline__ void convert_mats(const Params& P, LAS unsigned char* lds, int m_lo, int m_hi, int gw, int ngw, int wid, int lane) {
    LAS float* scr = (LAS float*)(lds + wid * 8704);
    unsigned char* ws = P.ws;
    for (int mi = m_lo; mi < m_hi; ++mi) {
        int type, idx;
        if (mi < 4) { type = (mi == 0) ? 0 : (mi == 1) ? 1 : (mi == 2) ? 4 : 5; idx = 0; }
        else { const int r = mi - 4, grp = r >> 2, q = r & 3;
            if (q >= 2) { type = q + 2; idx = grp + 1; } else if (grp == 1) { type = q; idx = 1; } else { type = 2 + q; idx = grp >> 1; } }
        const float* W; const float* gamma = nullptr; bf16_t* WT; int K = 1024, Nsrc, Npos, gu = 0;
        if (type == 0) { W = P.in[8] + (size_t)idx * 1024 * ABIN; gamma = P.in[7] + idx * 1024; WT = (bf16_t*)(ws + WS_WIN + idx * SZ_WIN); Nsrc = ABIN; Npos = ABPAD; }
        else if (type == 1) { W = P.in[16] + (size_t)idx * 1024 * 1024; WT = (bf16_t*)(ws + WS_WOUT + idx * SZ_W1K); Nsrc = 1024; Npos = 1024; }
        else if (type == 2) { W = P.in[18] + (size_t)idx * 1024 * NQKV; gamma = P.in[17] + idx * 1024; WT = (bf16_t*)(ws + WS_WQKV + idx * SZ_WQKV); Nsrc = NQKV; Npos = NQKV; }
        else if (type == 3) { W = P.in[20] + (size_t)idx * 1024 * 1024; WT = (bf16_t*)(ws + WS_WCOUT + idx * SZ_W1K); Nsrc = 1024; Npos = 1024; }
        else if (type == 4) { W = P.in[22] + (size_t)idx * 1024 * NGU; gamma = P.in[21] + idx * 1024; WT = (bf16_t*)(ws + WS_WGU + idx * SZ_WGU); Nsrc = NGU; Npos = NGU; gu = 1; }
        else { W = P.in[23] + (size_t)idx * DFF * 1024; WT = (bf16_t*)(ws + WS_WDN + idx * SZ_WDN); K = DFF; Nsrc = 1024; Npos = 1024; }
        convert_matrix(W, K, Nsrc, Npos, gu, gamma, WT, scr, gw, ngw, lane);
    }
}
__device__ __forceinline__ void phase_prologue(const Params& P, LAS unsigned char* lds, int gw, int ngw, int wid, int lane) {
    convert_mats(P, lds, 0, 4, gw, ngw, wid, lane);
    unsigned char* ws = P.ws;
    bf16_t* Xb = (bf16_t*)(ws + WS_XB); float* ssp = (float*)(ws + WS_SSP);
    for (int row = gw; row < TR; row += ngw) {
        const float* xr = (row < TP) ? P.in[0] + (size_t)row * DM : P.in[1] + (size_t)(row - TP) * DM;
        f32x4 v[4]; float s = 0.f;
#pragma unroll
        for (int j = 0; j < 4; ++j) { v[j] = ((const f32x4*)xr)[lane + 64 * j]; s += (v[j][0] * v[j][0] + v[j][1] * v[j][1]) + (v[j][2] * v[j][2] + v[j][3] * v[j][3]); }
        s = wave_sum(s);
#pragma unroll
        for (int j = 0; j < 4; ++j) { u32x2 w; w.x = pk2(v[j][0], v[j][1]); w.y = pk2(v[j][2], v[j][3]); ((u32x2*)(Xb + (size_t)row * DM))[lane + 64 * j] = w; }
        if (lane < 16) ssp[(size_t)row * 16 + lane] = (lane == 0) ? s : 0.f;
    }
}
__device__ __forceinline__ void phase_final(const Params& P, int gw, int ngw, int lane) {
    const GAS float* ssp = (const GAS float*)(P.ws + WS_SSP); const float* g = P.in[24];
    f32x4 gv[4];
#pragma unroll
    for (int j = 0; j < 4; ++j) gv[j] = ((const f32x4*)g)[lane + 64 * j];
    for (int row = gw; row < TR; row += ngw) {
        const float rstd = row_rstd(ssp, row);
        f32x4* xr = (f32x4*)(P.out + (size_t)row * DM);
#pragma unroll
        for (int j = 0; j < 4; ++j) { f32x4 v = xr[lane + 64 * j]; xr[lane + 64 * j] = v * rstd * gv[j]; }
    }
}

constexpr int MX_CH = 32;
#define LDS_BARRIER() asm volatile("s_waitcnt lgkmcnt(0)\n\ts_barrier" ::: "memory")
__device__ __forceinline__ void delta_unit(const Params& P, LAS unsigned char* lds, int li, bool sample, int b, int h, int half, const int tid) {
    const int lane = tid & 63, wid = __builtin_amdgcn_readfirstlane(tid >> 6);
    const int L = sample ? SSEQ : SEQ, rowbase = sample ? TP + b * SSEQ : b * SEQ;
    const bf16_t* PROJ = (const bf16_t*)(P.ws + WS_R1); const float* GATES = (const float*)(P.ws + WS_GATES); bf16_t* MIX = (bf16_t*)(P.ws + WS_MIX);
    const int NC = (L + MX_CH - 1) / MX_CH;
    constexpr int SET = 4 * 8192 + 256;
    if (wid < 4) __builtin_amdgcn_s_setprio(2);
    const int e = 32 * half + (wid & 3) * 8 + (lane >> 3), dq = lane & 7;
    f32x2 S[4];
    float* sout = P.out + (sample ? O_DNS : O_DNP) + (size_t)((li * 8 + b) * 8 + h) * 4096;
    if (wid < 4) {
        if (sample) { const float* s0 = P.in[3] + (size_t)((li * 8 + b) * 8 + h) * 4096;
#pragma unroll
            for (int j = 0; j < 4; ++j) { S[j][0] = s0[(8 * dq + 2 * j) * 64 + e]; S[j][1] = s0[(8 * dq + 2 * j + 1) * 64 + e]; } }
        else {
#pragma unroll
            for (int j = 0; j < 4; ++j) S[j] = (f32x2){0.f, 0.f}; }
    }
    const int pw = wid - 4, c = lane;
    float cwq[4], cwk[4], cwv[4], alog = 0.f, dtb = 0.f;
    float rq[11], rk[11], rv[11], ga = 0.f, gb_ = 0.f;
    if (wid >= 4) {
        const float* cw = P.in[9] + (size_t)li * 4 * DNQKV;
#pragma unroll
        for (int t = 0; t < 4; ++t) { cwq[t] = cw[t * DNQKV + h * 64 + c]; cwk[t] = cw[t * DNQKV + 512 + h * 64 + c]; cwv[t] = cw[t * DNQKV + 1024 + h * 64 + c]; }
        alog = P.in[10][li * 8 + h]; dtb = P.in[11][li * 8 + h];
    }
#define DN_LOADS(jn) do { const int t0n_ = (jn) * MX_CH + pw * 8; if ((jn) < NC && t0n_ < L) { \
        _Pragma("unroll") for (int r = 0; r < 11; ++r) { const int t = t0n_ - 3 + r, tc = max(t, 0); const bf16_t* pr = PROJ + (size_t)(rowbase + tc) * ABIN + h * 64 + c; \
            const float m = (t >= 0) ? 1.f : 0.f; rq[r] = bf2f(pr[0]) * m; rk[r] = bf2f(pr[512]) * m; rv[r] = bf2f(pr[1024]) * m; } \
        { const float* gp = GATES + (size_t)(rowbase + t0n_ + (lane & 7)) * 32; ga = gp[h]; gb_ = gp[8 + h]; } \
        if (sample && t0n_ == 0) { _Pragma("unroll") for (int r = 0; r < 3; ++r) { const float* cb = P.in[2] + (size_t)((li * 8 + b) * 3 + r) * DNQKV + h * 64 + c; rq[r] = cb[0]; rk[r] = cb[512]; rv[r] = cb[1024]; } } } } while (0)
    if (wid >= 4) DN_LOADS(0);
    for (int j = 0; j < NC + 2; ++j) {
        if (wid >= 4) {
            if (j < NC) {
                LAS float* qs = (LAS float*)(lds + (j & 1) * SET); LAS float* ks = qs + 2048; LAS float* vs = qs + 4096; LAS float* sc = qs + 8192;
                const int t0 = j * MX_CH + pw * 8;
                if (t0 < L) {
#pragma unroll
                    for (int i = 0; i < 8; ++i) {
                        float q = cwq[0] * rq[i] + cwq[1] * rq[i + 1] + cwq[2] * rq[i + 2] + cwq[3] * rq[i + 3];
                        float k = cwk[0] * rk[i] + cwk[1] * rk[i + 1] + cwk[2] * rk[i + 2] + cwk[3] * rk[i + 3];
                        float v = cwv[0] * rv[i] + cwv[1] * rv[i + 1] + cwv[2] * rv[i + 2] + cwv[3] * rv[i + 3];
                        q = silu_f(q); k = silu_f(k); v = silu_f(v);
                        const float sq = wave_sum(q * q), sk = wave_sum(k * k);
                        const int tok = pw * 8 + i;
                        qs[tok * 64 + c] = q * rsqrtf(sq + EPS) * 0.125f; ks[tok * 64 + c] = k * rsqrtf(sk + EPS); vs[tok * 64 + c] = v;
                    }
                    if (lane < 8) { const float g = -__expf(alog) * softplus_f(ga + dtb); sc[(pw * 8 + lane) * 2] = __expf(g); sc[(pw * 8 + lane) * 2 + 1] = sigmoid_f(gb_); }
                }
            }
            DN_LOADS(j + 1);
            if (j >= 2) {
                LAS float* os = (LAS float*)(lds + (j & 1) * SET) + 6144;
                const int t0 = (j - 2) * MX_CH + pw * 8;
                if (t0 < L && (c >> 5) == half) {
#pragma unroll
                    for (int i = 0; i < 8; ++i) {
                        const int tok = pw * 8 + i; const size_t row = (size_t)(rowbase + t0 + i);
                        MIX[row * DM + h * 64 + c] = (bf16_t)f2bf(os[tok * 64 + c]);
                    }
                }
            }
        } else if (j >= 1 && j <= NC) {
            LAS float* qs = (LAS float*)(lds + ((j - 1) & 1) * SET); LAS float* ks = qs + 2048; LAS float* vs = qs + 4096; LAS float* os = qs + 6144; LAS float* sc = qs + 8192;
            const int ntok = min(MX_CH, L - (j - 1) * MX_CH);
            f32x4 kk[2], qq[2]; float ve; f32x2 gb;
#pragma unroll
            for (int i = 0; i < 2; ++i) { kk[i] = *(const LAS f32x4*)(ks + 8 * dq + 4 * i); qq[i] = *(const LAS f32x4*)(qs + 8 * dq + 4 * i); }
            ve = vs[e]; gb = *(const LAS f32x2*)(sc);
#pragma unroll 2
            for (int tok = 0; tok < ntok; ++tok) {
                const int tn = min(tok + 1, ntok - 1);
                f32x4 kn[2], qn[2];
#pragma unroll
                for (int i = 0; i < 2; ++i) { kn[i] = *(const LAS f32x4*)(ks + tn * 64 + 8 * dq + 4 * i); qn[i] = *(const LAS f32x4*)(qs + tn * 64 + 8 * dq + 4 * i); }
                const float vn = vs[tn * 64 + e]; const f32x2 gn = *(const LAS f32x2*)(sc + tn * 2);
                const float eg = gb[0], beta = gb[1];
                const f32x2 wa = (f32x2){kk[0][0], kk[0][1]} * S[0] + (f32x2){kk[0][2], kk[0][3]} * S[1];
                const f32x2 wb = (f32x2){kk[1][0], kk[1][1]} * S[2] + (f32x2){kk[1][2], kk[1][3]} * S[3];
                const f32x2 ws2 = wa + wb;
                const float w = oct_sum(ws2[0] + ws2[1]);
                const float dl = beta * (ve - eg * w);
                const f32x2 eg2 = (f32x2){eg, eg}, dl2 = (f32x2){dl, dl};
#pragma unroll
                for (int i = 0; i < 2; ++i) { S[2 * i] = S[2 * i] * eg2 + (f32x2){kk[i][0], kk[i][1]} * dl2; S[2 * i + 1] = S[2 * i + 1] * eg2 + (f32x2){kk[i][2], kk[i][3]} * dl2; }
                const f32x2 oa = (f32x2){qq[0][0], qq[0][1]} * S[0] + (f32x2){qq[0][2], qq[0][3]} * S[1];
                const f32x2 ob = (f32x2){qq[1][0], qq[1][1]} * S[2] + (f32x2){qq[1][2], qq[1][3]} * S[3];
                const f32x2 os2 = oa + ob;
                const float o = oct_sum(os2[0] + os2[1]);
                if (dq == 0) os[tok * 64 + e] = o;
#pragma unroll
                for (int i = 0; i < 2; ++i) { kk[i] = kn[i]; qq[i] = qn[i]; }
                ve = vn; gb = gn;
            }
        }
        LDS_BARRIER();
    }
#undef DN_LOADS
    if (wid < 4) {
#pragma unroll
        for (int j = 0; j < 4; ++j) { sout[(8 * dq + 2 * j) * 64 + e] = S[j][0]; sout[(8 * dq + 2 * j + 1) * 64 + e] = S[j][1]; }
    }
    __builtin_amdgcn_s_setprio(0);
}

__device__ __forceinline__ void gla_unit(const Params& P, LAS unsigned char* lds, int li, bool sample, int b, int h, const int tid) {
    const int lane = tid & 63, wid = __builtin_amdgcn_readfirstlane(tid >> 6);
    const int L = sample ? SSEQ : SEQ, rowbase = sample ? TP + b * SSEQ : b * SEQ;
    const bf16_t* PROJ = (const bf16_t*)(P.ws + WS_R1); const float* GATES = (const float*)(P.ws + WS_GATES); bf16_t* MIX = (bf16_t*)(P.ws + WS_MIX);
    const int NC = (L + MX_CH - 1) / MX_CH;
    constexpr int SET = 3 * 4096 + 2 * 8192;
    if (wid < 4) __builtin_amdgcn_s_setprio(2);
    const int e = (wid & 3) * 16 + (lane >> 2), dq = lane & 3;
    f32x2 S[4];
    float* sout = P.out + (sample ? O_GLAS : O_GLAP) + (size_t)((li * 8 + b) * 8 + h) * 2048;
    if (wid < 4) {
        if (sample) { const float* s0 = P.in[4] + (size_t)((li * 8 + b) * 8 + h) * 2048;
#pragma unroll
            for (int j = 0; j < 4; ++j) { S[j][0] = s0[(8 * dq + 2 * j) * 64 + e]; S[j][1] = s0[(8 * dq + 2 * j + 1) * 64 + e]; } }
        else {
#pragma unroll
            for (int j = 0; j < 4; ++j) S[j] = (f32x2){0.f, 0.f}; }
    }
    const int pw = wid - 4, c = lane, c32 = lane & 31;
    float w2[16], gkb = 0.f, onorm = 0.f;
    if (wid >= 4) {
#pragma unroll
        for (int r = 0; r < 16; ++r) w2[r] = P.in[13][(size_t)(li * 16 + r) * 256 + h * 32 + c32];
        gkb = P.in[14][li * 256 + h * 32 + c32]; onorm = P.in[15][li * 64 + c];
    }
    for (int j = 0; j < NC + 2; ++j) {
        if (wid >= 4) {
            if (j < NC) {
                LAS float* qs = (LAS float*)(lds + (j & 1) * SET); LAS float* ks = qs + 1024; LAS float* gs = qs + 2048; LAS float* vs = qs + 3072;
                const int t0 = j * MX_CH + pw * 8;
                if (t0 < L) {
                    const int g4 = (lane >> 5) * 4;
                    float rv[8], rq[4], rk[4]; f32x4 lrv[4][4];
#pragma unroll
                    for (int i = 0; i < 8; ++i) rv[i] = bf2f(PROJ[(size_t)(rowbase + t0 + i) * ABIN + 2576 + h * 64 + c]);
#pragma unroll
                    for (int i = 0; i < 4; ++i) { const size_t row = (size_t)(rowbase + t0 + g4 + i); const bf16_t* pr = PROJ + row * ABIN;
                        rq[i] = bf2f(pr[2064 + h * 32 + c32]); rk[i] = bf2f(pr[2320 + h * 32 + c32]);
#pragma unroll
                        for (int r = 0; r < 4; ++r) lrv[i][r] = *(const f32x4*)(GATES + row * 32 + 16 + 4 * r); }
#pragma unroll
                    for (int i = 0; i < 8; ++i) vs[(pw * 8 + i) * 64 + c] = rv[i];
#pragma unroll
                    for (int i = 0; i < 4; ++i) {
                        const int tok = pw * 8 + g4 + i;
                        float z = gkb;
#pragma unroll
                        for (int r = 0; r < 4; ++r) z += (lrv[i][r][0] * w2[4 * r] + lrv[i][r][1] * w2[4 * r + 1]) + (lrv[i][r][2] * w2[4 * r + 2] + lrv[i][r][3] * w2[4 * r + 3]);
                        const float ls = -softplus_f(-z);
                        qs[tok * 32 + c32] = rq[i] * 0.17677669529663687f; ks[tok * 32 + c32] = rk[i]; gs[tok * 32 + c32] = __expf(ls * (1.0f / 16.0f));
                    }
                }
            }
            if (j >= 2) {
                LAS float* os = (LAS float*)(lds + (j & 1) * SET) + 3072 + 2048;
                const int t0 = (j - 2) * MX_CH + pw * 8;
                if (t0 < L) {
#pragma unroll
                    for (int i = 0; i < 8; ++i) {
                        const int tok = pw * 8 + i; const size_t row = (size_t)(rowbase + t0 + i);
                        MIX[row * DM + 512 + h * 64 + c] = (bf16_t)f2bf(os[tok * 64 + c]);
                    }
                }
            }
        } else if (j >= 1 && j <= NC) {
            LAS float* qs = (LAS float*)(lds + ((j - 1) & 1) * SET); LAS float* ks = qs + 1024; LAS float* gs = qs + 2048; LAS float* vs = qs + 3072; LAS float* os = qs + 3072 + 2048;
            const int ntok = min(MX_CH, L - (j - 1) * MX_CH);
            f32x4 kk[2], qq[2], gg[2]; float ve;
#pragma unroll
            for (int i = 0; i < 2; ++i) { kk[i] = *(const LAS f32x4*)(ks + 8 * dq + 4 * i); qq[i] = *(const LAS f32x4*)(qs + 8 * dq + 4 * i); gg[i] = *(const LAS f32x4*)(gs + 8 * dq + 4 * i); }
            ve = vs[e];
            for (int tok = 0; tok < ntok; ++tok) {
                const int tn = min(tok + 1, ntok - 1);
                f32x4 kn[2], qn[2], gn[2];
#pragma unroll
                for (int i = 0; i < 2; ++i) { kn[i] = *(const LAS f32x4*)(ks + tn * 32 + 8 * dq + 4 * i); qn[i] = *(const LAS f32x4*)(qs + tn * 32 + 8 * dq + 4 * i); gn[i] = *(const LAS f32x4*)(gs + tn * 32 + 8 * dq + 4 * i); }
                const float vn = vs[tn * 64 + e];
                const f32x2 v2 = (f32x2){ve, ve};
                f32x2 oa[2];
#pragma unroll
                for (int i = 0; i < 2; ++i) {
                    S[2 * i] = S[2 * i] * (f32x2){gg[i][0], gg[i][1]} + (f32x2){kk[i][0], kk[i][1]} * v2; S[2 * i + 1] = S[2 * i + 1] * (f32x2){gg[i][2], gg[i][3]} + (f32x2){kk[i][2], kk[i][3]} * v2;
                    oa[i] = (f32x2){qq[i][0], qq[i][1]} * S[2 * i] + (f32x2){qq[i][2], qq[i][3]} * S[2 * i + 1];
                }
                const f32x2 os2 = oa[0] + oa[1];
                const float o = quad_sum(os2[0] + os2[1]);
                if (dq == 0) os[tok * 64 + e] = o;
#pragma unroll
                for (int i = 0; i < 2; ++i) { kk[i] = kn[i]; qq[i] = qn[i]; gg[i] = gn[i]; }
                ve = vn;
            }
        }
        __syncthreads();
    }
    if (wid < 4) {
#pragma unroll
        for (int j = 0; j < 4; ++j) { sout[(8 * dq + 2 * j) * 64 + e] = S[j][0]; sout[(8 * dq + 2 * j + 1) * 64 + e] = S[j][1]; }
    }
    __builtin_amdgcn_s_setprio(0);
}

__device__ __forceinline__ void phase_fixup(const Params& P, int li, int gw, int ngw, int lane) {
    bf16_t* MIX = (bf16_t*)(P.ws + WS_MIX); const bf16_t* PROJ = (const bf16_t*)(P.ws + WS_R1);
    const float* on = (lane < 32 ? P.in[12] : P.in[15]) + li * 64 + 16 * (lane & 3);
    float g[16];
#pragma unroll
    for (int j = 0; j < 16; ++j) g[j] = on[j];
    const int gcol = (lane < 32) ? 1552 + 16 * lane : 3104 + 16 * (lane - 32);
    for (int row = gw; row < TR; row += ngw) {
        u32x4* mp = (u32x4*)(MIX + (size_t)row * DM + 16 * lane);
        const u32x4* gp = (const u32x4*)(PROJ + (size_t)row * ABIN + gcol);
        const u32x4 m0 = mp[0], m1 = mp[1], g0 = gp[0], g1 = gp[1];
        float o[16], gt[16];
#pragma unroll
        for (int j = 0; j < 4; ++j) { o[2 * j] = __builtin_bit_cast(float, m0[j] << 16); o[2 * j + 1] = __builtin_bit_cast(float, m0[j] & 0xffff0000u); o[8 + 2 * j] = __builtin_bit_cast(float, m1[j] << 16); o[8 + 2 * j + 1] = __builtin_bit_cast(float, m1[j] & 0xffff0000u);
            gt[2 * j] = __builtin_bit_cast(float, g0[j] << 16); gt[2 * j + 1] = __builtin_bit_cast(float, g0[j] & 0xffff0000u); gt[8 + 2 * j] = __builtin_bit_cast(float, g1[j] << 16); gt[8 + 2 * j + 1] = __builtin_bit_cast(float, g1[j] & 0xffff0000u); }
        float ss = 0.f;
#pragma unroll
        for (int j = 0; j < 16; ++j) ss += o[j] * o[j];
        ss = quad_sum(ss);
        const float rstd = rsqrtf(ss * (1.0f / 64.0f) + EPS);
        float r[16];
#pragma unroll
        for (int j = 0; j < 16; ++j) r[j] = o[j] * rstd * g[j] * silu_f(gt[j]);
        u32x4 w0, w1;
#pragma unroll
        for (int j = 0; j < 4; ++j) { w0[j] = pk2(r[2 * j], r[2 * j + 1]); w1[j] = pk2(r[8 + 2 * j], r[8 + 2 * j + 1]); }
        mp[0] = w0; mp[1] = w1;
    }
}

constexpr int AT_KOFF = 0, AT_VOFF = 2 * 9216, AT_TAB = 4 * 9216;
__device__ __forceinline__ int vpos(int kv) { return 16 * (kv >> 4) + 8 * ((kv >> 2) & 1) + 4 * ((kv >> 3) & 1) + (kv & 3); }
__device__ __forceinline__ void attn_prompt_unit(const Params& P, LAS unsigned char* lds, int li, int b, int h, int g4, const int tid) {
    const int lane = tid & 63, wid = __builtin_amdgcn_readfirstlane(tid >> 6), r32 = lane & 31, hi = lane >> 5;
    const bf16_t* QKV = (const bf16_t*)(P.ws + WS_R1); bf16_t* MIX = (bf16_t*)(P.ws + WS_MIX);
    const int cw = 4 * g4 + (wid >> 1);
    const size_t qrow = (size_t)b * SEQ + 256 * g4 + 32 * wid + r32;
    bf16x8 qr[4];
#pragma unroll
    for (int d0 = 0; d0 < 4; ++d0) qr[d0] = *(const bf16x8*)(QKV + qrow * NQKV + h * 64 + d0 * 16 + hi * 8);
    LAS float* tab = (LAS float*)(lds + AT_TAB);
    if (tid < 257) tab[tid] = P.in[19][(size_t)(li * 16 + h) * 257 + tid] * LOG2E;
    const int kt_lo = max(0, 4 * g4 - 8), kt_hi = 4 * g4 + 3;
    const int srow = tid & 63, sch = tid >> 6;
    const bf16_t* kvsrc = QKV + ((size_t)b * SEQ + srow) * NQKV + 1024 + h * 64 + 8 * sch;
    const int vp = vpos(srow);
    bf16x8 kreg, vreg;
#define AT_LOAD(kt) do { const bf16_t* s_ = kvsrc + (size_t)(kt) * 64 * NQKV; kreg = *(const bf16x8*)s_; vreg = *(const bf16x8*)(s_ + 1024); } while (0)
#define AT_STORE(buf) do { *(LAS bf16x8*)(lds + AT_KOFF + (buf) * 9216 + srow * 144 + sch * 16) = kreg; \
        _Pragma("unroll") for (int j_ = 0; j_ < 8; ++j_) *(LAS short*)(lds + AT_VOFF + (buf) * 9216 + (8 * sch + j_) * 144 + vp * 2) = vreg[j_]; } while (0)
    AT_LOAD(kt_lo); AT_STORE(0);
    __syncthreads();
    float m = -1e30f, l = 0.f; f32x16 o[2];
#pragma unroll
    for (int r = 0; r < 16; ++r) { o[0][r] = 0.f; o[1][r] = 0.f; }
    const float C2 = 0.125f * LOG2E;
    const int qi = 32 * (wid & 1) + r32;
    for (int kt = kt_lo; kt <= kt_hi; ++kt) {
        const int cur = (kt - kt_lo) & 1;
        if (kt < kt_hi) AT_LOAD(kt + 1);
        if (kt >= cw - 8 && kt <= cw) {
            const LAS unsigned char* Kb = lds + AT_KOFF + cur * 9216; const LAS unsigned char* Vb = lds + AT_VOFF + cur * 9216;
            f32x16 p0, p1;
#pragma unroll
            for (int r = 0; r < 16; ++r) { p0[r] = 0.f; p1[r] = 0.f; }
#pragma unroll
            for (int d0 = 0; d0 < 4; ++d0) {
                const bf16x8 a0 = *(const LAS bf16x8*)(Kb + r32 * 144 + d0 * 32 + hi * 16);
                const bf16x8 a1 = *(const LAS bf16x8*)(Kb + (32 + r32) * 144 + d0 * 32 + hi * 16);
                p0 = __builtin_amdgcn_mfma_f32_32x32x16_bf16(a0, qr[d0], p0, 0, 0, 0);
                p1 = __builtin_amdgcn_mfma_f32_32x32x16_bf16(a1, qr[d0], p1, 0, 0, 0);
            }
            const int dist = cw - kt;
            if (dist >= 3) { const float bf = tab[256];
#pragma unroll
                for (int r = 0; r < 16; ++r) { p0[r] = p0[r] * C2 + bf; p1[r] = p1[r] * C2 + bf; } }
            else {
#pragma unroll
                for (int r = 0; r < 16; ++r) { const int kv = (r & 3) + 8 * (r >> 2) + 4 * hi; const int rel = qi - kv + 64 * dist;
                    p0[r] = p0[r] * C2 + tab[min(rel, 128) + 128]; p1[r] = p1[r] * C2 + tab[min(rel - 32, 128) + 128]; } }
            float mx = p0[0];
#pragma unroll
            for (int r = 1; r < 16; ++r) mx = fmaxf(mx, p0[r]);
#pragma unroll
            for (int r = 0; r < 16; ++r) mx = fmaxf(mx, p1[r]);
            mx = fmaxf(mx, __shfl_xor(mx, 32));
            const float mn = fmaxf(m, mx), scl = __builtin_amdgcn_exp2f(m - mn); m = mn;
            float ls = 0.f;
#pragma unroll
            for (int r = 0; r < 16; ++r) { p0[r] = __builtin_amdgcn_exp2f(p0[r] - mn); p1[r] = __builtin_amdgcn_exp2f(p1[r] - mn); ls += p0[r] + p1[r]; }
            l = l * scl + ls;
#pragma unroll
            for (int r = 0; r < 16; ++r) { o[0][r] *= scl; o[1][r] *= scl; }
            u32x4 pw[4];
#pragma unroll
            for (int s = 0; s < 2; ++s) {
                pw[s] = (u32x4){pk2(p0[8 * s], p0[8 * s + 1]), pk2(p0[8 * s + 2], p0[8 * s + 3]), pk2(p0[8 * s + 4], p0[8 * s + 5]), pk2(p0[8 * s + 6], p0[8 * s + 7])};
                pw[2 + s] = (u32x4){pk2(p1[8 * s], p1[8 * s + 1]), pk2(p1[8 * s + 2], p1[8 * s + 3]), pk2(p1[8 * s + 4], p1[8 * s + 5]), pk2(p1[8 * s + 6], p1[8 * s + 7])};
            }
#pragma unroll
            for (int dh = 0; dh < 2; ++dh)
#pragma unroll
                for (int ks = 0; ks < 4; ++ks) {
                    const bf16x8 vf = *(const LAS bf16x8*)(Vb + (32 * dh + r32) * 144 + (16 * ks + 8 * hi) * 2);
                    o[dh] = __builtin_amdgcn_mfma_f32_32x32x16_bf16(vf, __builtin_bit_cast(bf16x8, pw[ks]), o[dh], 0, 0, 0);
                }
        }
        if (kt < kt_hi) AT_STORE(cur ^ 1);
        __syncthreads();
    }
#undef AT_LOAD
#undef AT_STORE
    l += __shfl_xor(l, 32);
    const float rl = 1.0f / l;
    bf16_t* op = MIX + qrow * DM + h * 64;
#pragma unroll
    for (int dh = 0; dh < 2; ++dh)
#pragma unroll
        for (int r4 = 0; r4 < 4; ++r4) {
            u32x2 w; w.x = pk2(o[dh][4 * r4] * rl, o[dh][4 * r4 + 1] * rl); w.y = pk2(o[dh][4 * r4 + 2] * rl, o[dh][4 * r4 + 3] * rl);
            *(u32x2*)(op + 32 * dh + 8 * r4 + 4 * hi) = w;
        }
}
__device__ __forceinline__ void attn_sample_unit(const Params& P, LAS unsigned char* lds, int li, int b, int h, const int tid) {
    const int lane = tid & 63, wid = tid >> 6;
    const bf16_t* QKV = (const bf16_t*)(P.ws + WS_R1); bf16_t* MIX = (bf16_t*)(P.ws + WS_MIX);
    LAS float* qs = (LAS float*)lds;
    LAS float* sc = qs + 1024;
    LAS float* tab = sc + 16 * 528;
    const size_t rb = (size_t)TP + b * SSEQ;
    for (int i = tid; i < 1024; i += 512) qs[i] = bf2f(QKV[(rb + (i >> 6)) * NQKV + h * 64 + (i & 63)]);
    if (tid < 257) tab[tid] = P.in[19][(size_t)(li * 16 + h) * 257 + tid];
    __syncthreads();
    const float* kc = P.in[5] + ((size_t)(li * 8 + b) * 512) * 1024 + h * 64;
    const float* vc = P.in[6] + ((size_t)(li * 8 + b) * 512) * 1024 + h * 64;
    for (int j = tid; j < 528; j += 512) {
        float kr[64];
        if (j < 512) {
#pragma unroll
            for (int d = 0; d < 16; ++d) { const f32x4 t = *(const f32x4*)(kc + (size_t)j * 1024 + 4 * d); kr[4 * d] = t[0]; kr[4 * d + 1] = t[1]; kr[4 * d + 2] = t[2]; kr[4 * d + 3] = t[3]; }
        } else {
#pragma unroll
            for (int d = 0; d < 64; ++d) kr[d] = bf2f(QKV[(rb + (j - 512)) * NQKV + 1024 + h * 64 + d]);
        }
        for (int q = 0; q < 16; ++q) {
            float s = 0.f;
#pragma unroll
            for (int d = 0; d < 64; ++d) s += qs[q * 64 + d] * kr[d];
            const int rel = (j < 512) ? (512 + q - j) : (q - (j - 512));
            sc[q * 528 + j] = s * 0.125f + tab[min(max(rel, -128), 128) + 128];
        }
    }
    __syncthreads();
    for (int q = 2 * wid; q < 2 * wid + 2; ++q) {
        float mx = -1e30f;
        for (int j = lane; j < 528; j += 64) mx = fmaxf(mx, sc[q * 528 + j]);
#pragma unroll
        for (int o = 1; o < 64; o <<= 1) mx = fmaxf(mx, __shfl_xor(mx, o));
        float sm = 0.f;
        for (int j = lane; j < 528; j += 64) { const float p = __expf(sc[q * 528 + j] - mx); sc[q * 528 + j] = p; sm += p; }
        sm = wave_sum(sm);
        const float inv = 1.0f / sm;
        for (int j = lane; j < 528; j += 64) sc[q * 528 + j] *= inv;
    }
    __syncthreads();
    {
        const int q = tid >> 5, d = 2 * (tid & 31);
        float a0 = 0.f, a1 = 0.f;
        for (int j = 0; j < 512; ++j) { const f32x2 v = *(const f32x2*)(vc + (size_t)j * 1024 + d); const float p = sc[q * 528 + j]; a0 += p * v[0]; a1 += p * v[1]; }
        for (int j = 0; j < 16; ++j) { const bf16_t* vp = QKV + (rb + j) * NQKV + 2048 + h * 64 + d; const float p = sc[q * 528 + 512 + j]; a0 += p * bf2f(vp[0]); a1 += p * bf2f(vp[1]); }
        *(unsigned*)(MIX + (rb + q) * DM + h * 64 + d) = pk2(a0, a1);
    }
    __syncthreads();
}

#define XB_TMO      128
#define XB_XCNT(j)  (256  + 64 * (j))
#define XB_XSUB(j)  (1280 + 64 * (j))
#define XB_XGEN(j)  (2304 + 64 * (j))
#define XB_TOP      3328
#define XB_TOPGEN   3392
#define XCD_BAR_WORDS 3456
#define XB_SPIN_CAP (1u << 20)
__device__ __forceinline__ unsigned xb_ld(unsigned* p)              { return __hip_atomic_load(p, __ATOMIC_RELAXED, __HIP_MEMORY_SCOPE_AGENT); }
__device__ __forceinline__ unsigned xb_add(unsigned* p, unsigned v) { return __hip_atomic_fetch_add(p, v, __ATOMIC_RELAXED, __HIP_MEMORY_SCOPE_AGENT); }
__device__ __forceinline__ unsigned xb_xcc_id() { return (unsigned)__builtin_amdgcn_s_getreg((3 << 11) | 20) & 0xFu; }
#define XB_SPIN(cond, bar) do { unsigned _sp = 0; while (cond) { __builtin_amdgcn_s_sleep(1); \
    if ((++_sp & 255u) == 0u) { if (xb_ld(&(bar)[XB_TMO])) break; if (_sp > XB_SPIN_CAP) { atomicAdd(&(bar)[XB_TMO], 1u); break; } } } } while (0)
struct XcdBarrier { unsigned* bar; unsigned x; volatile LAS unsigned* st; };
__device__ __forceinline__ XcdBarrier xcd_barrier_post(unsigned* bar, volatile LAS unsigned* st) {
    XcdBarrier b; b.bar = bar; b.x = xb_xcc_id(); b.st = st;
    if (threadIdx.x == 0) (void)xb_add(&bar[XB_XCNT(b.x)], 1u);
    return b;
}
__device__ __forceinline__ void xcd_barrier_complete(unsigned* bar, unsigned x, unsigned& nloc, unsigned& nx) {
    const unsigned G = gridDim.x * gridDim.y * gridDim.z;
    unsigned sum, cnt, mine, sp = 0u;
    for (;;) {
        sum = 0u; cnt = 0u; mine = 0u;
#pragma unroll
        for (unsigned j = 0; j < 16; ++j) { const unsigned c = xb_ld(&bar[XB_XCNT(j)]); sum += c; cnt += (c > 0u) ? 1u : 0u; mine = (j == x) ? c : mine; }
        if (sum == G) break;
        __builtin_amdgcn_s_sleep(1);
        if ((++sp & 255u) == 0u) { if (xb_ld(&bar[XB_TMO])) break; if (sp > XB_SPIN_CAP) { atomicAdd(&bar[XB_TMO], 1u); break; } }
    }
    nloc = mine > 0u ? mine : 1u; nx = cnt > 0u ? cnt : 1u;
}
__device__ __forceinline__ void xcd_barrier(const XcdBarrier& b) {
    asm volatile("s_waitcnt vmcnt(0)" ::: "memory");
    __syncthreads();
    if (threadIdx.x == 0) {
        unsigned* bar = b.bar;
        __builtin_amdgcn_s_waitcnt(0);
        unsigned nloc = b.st[0], nx = b.st[1];
        if (nloc == 0u) { xcd_barrier_complete(bar, b.x, nloc, nx); b.st[0] = nloc; b.st[1] = nx; }
        const unsigned old = xb_add(&bar[XB_XSUB(b.x)], 1u);
        const unsigned gen = old / nloc;
        if (old + 1u == (gen + 1u) * nloc) {
            __builtin_amdgcn_fence(__ATOMIC_RELEASE, "agent");
            asm volatile("s_waitcnt vmcnt(0)" ::: "memory");
            const unsigned og = xb_add(&bar[XB_TOP], 1u);
            const unsigned tg = og / nx;
            if (og + 1u == (tg + 1u) * nx) xb_add(&bar[XB_TOPGEN], 1u);
            else XB_SPIN(xb_ld(&bar[XB_TOPGEN]) == tg, bar);
            __builtin_amdgcn_fence(__ATOMIC_ACQUIRE, "agent");
            xb_add(&bar[XB_XGEN(b.x)], 1u);
            asm volatile("s_waitcnt vmcnt(0)" ::: "memory");
        } else {
            XB_SPIN(xb_ld(&bar[XB_XGEN(b.x)]) == gen, bar);
            __builtin_amdgcn_fence(__ATOMIC_ACQUIRE, "agent");
            asm volatile("s_waitcnt vmcnt(0)" ::: "memory");
        }
    }
    __syncthreads();
}

__global__ void __launch_bounds__(512, 2) hybrid_fwd(Params P) {
    extern __shared__ __attribute__((aligned(16))) unsigned char lds_raw[];
    LAS unsigned char* lds = (LAS unsigned char*)lds_raw;
    const int G = gridDim.x;
    volatile LAS unsigned* xst = (volatile LAS unsigned*)(lds + 131072 + 256);
    if (threadIdx.x < 2) xst[threadIdx.x] = 0u;
    __syncthreads();
    XcdBarrier xbar = xcd_barrier_post((unsigned*)(P.ws + WS_CTL), xst);
    int ph = P.ph_lo, rep = 0;
    while (ph < P.ph_hi) {
        int tid = threadIdx.x; asm volatile("" : "+v"(tid));
        int wg = blockIdx.x; asm volatile("" : "+s"(wg));
        const Params& Q = P;
        const int lane = tid & 63, wid = __builtin_amdgcn_readfirstlane(tid >> 6), gw = wg * 8 + wid, ngw = G * 8;
        unsigned char* ws = Q.ws;
        bf16_t* Xb = (bf16_t*)(ws + WS_XB); bf16_t* R1 = (bf16_t*)(ws + WS_R1); bf16_t* MIX = (bf16_t*)(ws + WS_MIX);
        float* GATES = (float*)(ws + WS_GATES); float* SSP = (float*)(ws + WS_SSP);
        int nrep = 1;
        if (ph == 0) nrep = REP_PRO; else if (ph != NPHASE - 1) { const int q_ = (ph - 1) % 11; if (q_ == 1) nrep = REP_MIX; else if (q_ == 7) nrep = REP_ATT; else if (q_ == 0 || q_ == 4 || q_ == 6 || q_ == 9) nrep = REP_PROJ; }
        if (ph == 0) phase_prologue(Q, lds, gw, ngw, wid, lane);
        else if (ph == NPHASE - 1) phase_final(Q, gw, ngw, lane);
        else {
            int layer, sub;
            { const int r_ = ph - 1, pair_ = r_ / 11, q_ = r_ % 11; if (q_ < 6) { layer = 2 * pair_; sub = (q_ < 2) ? q_ : (q_ == 2 ? 5 : q_ - 1); } else { layer = 2 * pair_ + 1; sub = q_ - 6; } }
            const int li = layer >> 1, odd = layer & 1;
            if (sub == 5) phase_fixup(Q, li, gw, ngw, lane);
            else if (sub == 1) {
                if (!odd) {
                    if (G == 256) {
                        if (wg < 128) delta_unit(Q, lds, li, false, wg >> 4, (wg >> 1) & 7, wg & 1, tid);
                        else if (wg < 192) { const int u = wg - 128; gla_unit(Q, lds, li, false, u >> 3, u & 7, tid); }
                        else { const int u = wg - 192; delta_unit(Q, lds, li, true, u >> 3, u & 7, 0, tid); delta_unit(Q, lds, li, true, u >> 3, u & 7, 1, tid); gla_unit(Q, lds, li, true, u >> 3, u & 7, tid);
                            if (layer == 0 && rep == 0) convert_mats(Q, lds, 4, 16, (wg - 192) * 8 + wid, 512, wid, lane); }
                    }
                } else {
                    for (int u = wg * 8; u < wg * 8 + 8; ++u) attn_prompt_unit(Q, lds, li, u >> 8, (u >> 4) & 15, u & 15, tid);
                    if (wg < 128) attn_sample_unit(Q, lds, li, wg >> 4, wg & 15, tid);
                }
            } else {
                pg8::Gemm g; int mode, Npos;
                g.M = TP;
                LAS unsigned long long* eap = (LAS unsigned long long*)(lds + EA_OFF);
#define EA_SET(i, p) eap[i] = (unsigned long long)(p)
                if (sub == 0) {
                    g.A = Xb; g.K = 1024;
                    if (!odd) { mode = 0; Npos = ABPAD; g.Bt = (const bf16_t*)(ws + WS_WIN + li * SZ_WIN);
                        if (tid == 0) { EA_SET(0, R1); EA_SET(1, SSP); EA_SET(2, GATES); EA_SET(3, Q.out + O_CONVP + (size_t)li * 8 * 3 * DNQKV); EA_SET(4, Q.out + O_CONVS + (size_t)li * 8 * 3 * DNQKV); } }
                    else { mode = 1; Npos = NQKV; g.Bt = (const bf16_t*)(ws + WS_WQKV + li * SZ_WQKV);
                        if (tid == 0) { EA_SET(0, R1); EA_SET(1, SSP); EA_SET(3, Q.out + O_CKP + (size_t)li * 8 * 512 * 1024); EA_SET(4, Q.out + O_CVP + (size_t)li * 8 * 512 * 1024); EA_SET(5, Q.out + O_CKS + (size_t)li * 8 * 16 * 1024); EA_SET(6, Q.out + O_CVS + (size_t)li * 8 * 16 * 1024); } }
                } else if (sub == 2) {
                    mode = 2; Npos = 1024; g.A = MIX; g.K = 1024; g.Bt = (const bf16_t*)(ws + (odd ? WS_WCOUT : WS_WOUT) + li * SZ_W1K);
                    if (tid == 0) { EA_SET(7, (layer == 0) ? Q.in[0] : Q.out); EA_SET(8, (layer == 0) ? Q.in[1] : Q.out + (size_t)TP * DM); EA_SET(9, Q.out); EA_SET(10, Xb); EA_SET(11, SSP); }
                } else if (sub == 3) {
                    mode = 3; Npos = NGU; g.A = Xb; g.K = 1024; g.Bt = (const bf16_t*)(ws + WS_WGU + layer * SZ_WGU);
                    if (tid == 0) { EA_SET(0, R1); EA_SET(1, SSP); }
                } else {
                    mode = 2; Npos = 1024; g.A = R1; g.K = DFF; g.Bt = (const bf16_t*)(ws + WS_WDN + layer * SZ_WDN);
                    if (tid == 0) { EA_SET(7, Q.out); EA_SET(8, Q.out + (size_t)TP * DM); EA_SET(9, Q.out); EA_SET(10, Xb); EA_SET(11, SSP); }
                }
#undef EA_SET
                g.N = Npos;
                __syncthreads();
                pg8::StaticOrder S; S.init(TP, Npos, G, wg);
                if (mode == 0) { small_gemm<0>(g.A, g.Bt, Npos, g.K, eap, lds, wg, G, wid, lane); Epi<0> E{eap}; pg8::gemm_phase<Epi<0>, true, true>(lds, g, S, E, tid); }
                else if (mode == 1) { small_gemm<1>(g.A, g.Bt, Npos, g.K, eap, lds, wg, G, wid, lane); Epi<1> E{eap}; pg8::gemm_phase<Epi<1>, true, true>(lds, g, S, E, tid); }
                else if (mode == 2) { small_gemm<2>(g.A, g.Bt, Npos, g.K, eap, lds, wg, G, wid, lane); Epi<2> E{eap}; pg8::gemm_phase<Epi<2>, true, true>(lds, g, S, E, tid); }
                else { small_gemm<3>(g.A, g.Bt, Npos, g.K, eap, lds, wg, G, wid, lane); Epi<3> E{eap}; pg8::gemm_phase<Epi<3>, true, true>(lds, g, S, E, tid); }
            }
        }
        if (++rep >= nrep) { rep = 0; ++ph; }
        if (ph < P.ph_hi) { if (ph == 1 && rep == 0) cg::this_grid().sync(); else xcd_barrier(xbar); }
    }
}

extern "C" void kernel_launch(void* const* d_in, const int* in_sizes, int n_in, void* d_out, int out_size, void* d_ws, size_t ws_size, hipStream_t stream) {
    static int grid = 0;
    if (grid == 0) {
        if (n_in != 25 || (size_t)out_size != O_END || ws_size < WS_END) { fprintf(stderr, "kernel_launch: unexpected sizes n_in %d out %d ws %zu (need %zu)\n", n_in, out_size, ws_size, (size_t)WS_END); grid = -1; return; }
        if (hipFuncSetAttribute((const void*)hybrid_fwd, hipFuncAttributeMaxDynamicSharedMemorySize, LDS_BYTES) != hipSuccess) { fprintf(stderr, "kernel_launch: hipFuncSetAttribute failed\n"); grid = -1; return; }
        int dev = 0, cus = 0, per_cu = 0;
        hipGetDevice(&dev); hipDeviceGetAttribute(&cus, hipDeviceAttributeMultiprocessorCount, dev);
        hipOccupancyMaxActiveBlocksPerMultiprocessor(&per_cu, (const void*)hybrid_fwd, 512, LDS_BYTES);
        (void)hipGetLastError();
        if (cus != 256 || per_cu < 1) fprintf(stderr, "kernel_launch: note: cus %d per_cu %d\n", cus, per_cu);
        grid = 256;
    }
    if (grid < 0) return;
    Params p{};
    for (int i = 0; i < 25; ++i) p.in[i] = (const float*)d_in[i];
    p.out = (float*)d_out; p.ws = (unsigned char*)d_ws;
#if MK_MULTI
    for (int ph = 0; ph < NPHASE; ++ph) { p.ph_lo = ph; p.ph_hi = ph + 1; hipLaunchKernelGGL(hybrid_fwd, dim3(grid), dim3(512), LDS_BYTES, stream, p); }
#else
    (void)hipMemsetAsync((char*)d_ws + WS_CTL, 0, CTL_BYTES, stream);
    p.ph_lo = 0; p.ph_hi = NPHASE;
    void* args[] = {&p};
    hipError_t e = hipLaunchCooperativeKernel((const void*)hybrid_fwd, dim3(grid), dim3(512), args, LDS_BYTES, stream);
    if (e != hipSuccess) fprintf(stderr, "cooperative launch failed: %s\n", hipGetErrorString(e));
#endif
}
```

```cpp
#include <hip/hip_runtime.h>
#include <hip/hip_cooperative_groups.h>
#include <cstdio>
#include <cstdint>
namespace cg = cooperative_groups;

#ifndef MK_MULTI
#define MK_MULTI 0
#endif

#ifndef REP_MIX
#define REP_MIX 1
#endif
#ifndef REP_ATT
#define REP_ATT 1
#endif
#ifndef REP_PRO
#define REP_PRO 1
#endif
#ifndef REP_PROJ
#define REP_PROJ 1
#endif
#define LAS __attribute__((address_space(3)))
#define GAS __attribute__((address_space(1)))
typedef unsigned short bf16_t;
typedef short bf16x8 __attribute__((ext_vector_type(8)));
typedef float f32x2 __attribute__((ext_vector_type(2)));
typedef float f32x4 __attribute__((ext_vector_type(4)));
typedef float f32x16 __attribute__((ext_vector_type(16)));
typedef unsigned u32x2 __attribute__((ext_vector_type(2)));
typedef unsigned u32x4 __attribute__((ext_vector_type(4)));

constexpr int DM = 1024, NB = 8, SEQ = 4096, SB = 8, SSEQ = 16, PAST = 2048;
constexpr int TP = NB * SEQ;
constexpr int TS = SB * SSEQ;
constexpr int TR = TP + TS;
constexpr int ABIN = 3616, ABPAD = 3840, DFF = 2816, NGU = 5632, NQKV = 3072, DNQKV = 1536;
constexpr float EPS = 1e-6f;
constexpr float LOG2E = 1.4426950408889634f;

constexpr size_t O_Y = 0;
constexpr size_t O_CONVP = (size_t)TR * DM;
constexpr size_t O_CONVS = O_CONVP + 2 * 8 * 3 * 1536;
constexpr size_t O_DNP = O_CONVS + 2 * 8 * 3 * 1536;
constexpr size_t O_DNS = O_DNP + 2 * 8 * 8 * 64 * 64;
constexpr size_t O_GLAP = O_DNS + 2 * 8 * 8 * 64 * 64;
constexpr size_t O_GLAS = O_GLAP + 2 * 8 * 8 * 32 * 64;
constexpr size_t O_CKP = O_GLAS + 2 * 8 * 8 * 32 * 64;
constexpr size_t O_CKS = O_CKP + (size_t)2 * 8 * 512 * 1024;
constexpr size_t O_CVP = O_CKS + 2 * 8 * 16 * 1024;
constexpr size_t O_CVS = O_CVP + (size_t)2 * 8 * 512 * 1024;
constexpr size_t O_END = O_CVS + 2 * 8 * 16 * 1024;

constexpr size_t SZ_WIN = (size_t)ABPAD * 1024 * 2, SZ_W1K = (size_t)1024 * 1024 * 2, SZ_WQKV = (size_t)NQKV * 1024 * 2, SZ_WGU = (size_t)NGU * 1024 * 2, SZ_WDN = (size_t)1024 * DFF * 2;
constexpr size_t WS_WIN = 0;
constexpr size_t WS_WOUT = WS_WIN + 2 * SZ_WIN;
constexpr size_t WS_WQKV = WS_WOUT + 2 * SZ_W1K;
constexpr size_t WS_WCOUT = WS_WQKV + 2 * SZ_WQKV;
constexpr size_t WS_WGU = WS_WCOUT + 2 * SZ_W1K;
constexpr size_t WS_WDN = WS_WGU + 4 * SZ_WGU;
constexpr size_t WS_XB = WS_WDN + 4 * SZ_WDN;
constexpr size_t WS_R1 = WS_XB + (size_t)TR * 1024 * 2;
constexpr size_t WS_MIX = WS_R1 + (size_t)TR * ABIN * 2;
constexpr size_t WS_GATES = WS_MIX + (size_t)TR * 1024 * 2;
constexpr size_t WS_SSP = WS_GATES + (size_t)TR * 32 * 4;
constexpr size_t WS_CTL = WS_SSP + (size_t)TR * 16 * 4;
constexpr size_t CTL_BYTES = 16384;
constexpr size_t WS_END = WS_CTL + CTL_BYTES;

constexpr int LDS_BYTES = 147456;
constexpr int NPHASE = 24;

struct Params { const float* in[25]; float* out; unsigned char* ws; int ph_lo, ph_hi; };

__device__ __forceinline__ unsigned f2bf(float f) { unsigned u = __builtin_bit_cast(unsigned, f); return (u + 0x7fffu + ((u >> 16) & 1u)) >> 16; }
typedef __bf16 hwbf16x2 __attribute__((ext_vector_type(2)));
__device__ __forceinline__ unsigned pk2(float lo, float hi) { const f32x2 v = {lo, hi}; return __builtin_bit_cast(unsigned, __builtin_convertvector(v, hwbf16x2)); }
__device__ __forceinline__ float bf2f(bf16_t b) { return __builtin_bit_cast(float, ((unsigned)b) << 16); }
template <int CTRL> __device__ __forceinline__ float dppf(float v) { return __builtin_bit_cast(float, __builtin_amdgcn_update_dpp(0, __builtin_bit_cast(int, v), CTRL, 0xF, 0xF, true)); }
__device__ __forceinline__ float quad_sum(float v) { v += dppf<0xB1>(v); v += dppf<0x4E>(v); return v; }
__device__ __forceinline__ float oct_sum(float v) { v = quad_sum(v); v += dppf<0x141>(v); return v; }
__device__ __forceinline__ float wave_sum(float v) {
    v = oct_sum(v); v += dppf<0x140>(v);
    const int i = __builtin_bit_cast(int, v);
    return (__builtin_bit_cast(float, __builtin_amdgcn_readlane(i, 0)) + __builtin_bit_cast(float, __builtin_amdgcn_readlane(i, 16))) +
           (__builtin_bit_cast(float, __builtin_amdgcn_readlane(i, 32)) + __builtin_bit_cast(float, __builtin_amdgcn_readlane(i, 48)));
}
__device__ __forceinline__ float fast_rcp(float x) { return __builtin_amdgcn_rcpf(x); }
__device__ __forceinline__ float silu_f(float x) { return x * fast_rcp(1.0f + __expf(-x)); }
__device__ __forceinline__ float sigmoid_f(float x) { return fast_rcp(1.0f + __expf(-x)); }
__device__ __forceinline__ float softplus_f(float x) { return fmaxf(x, 0.f) + __logf(1.0f + __expf(-fabsf(x))); }

namespace pg8 {
constexpr int BM = 256, BK = 64, HALF = 128, HTB = HALF * BK * 2, STAGE_BYTES = 8 * HTB, NXCD = 8, WGM = 8;
__host__ __device__ __forceinline__ int lds_byte(int r, int c) { const int st = (r >> 4) * 2 + (c >> 5), rr = r & 15, cc = c & 31, ob = rr * 64 + cc * 2; return st * 1024 + (ob ^ (((ob >> 9) & 1) << 5)); }
__host__ __device__ __forceinline__ void stage_rc(int b, int& R, int& C) { const int st = b / 1024, sb = b % 1024, swz = sb ^ (((sb >> 9) & 1) << 5); R = (st >> 1) * 16 + swz / 64; C = (st & 1) * 32 + (swz % 64) / 2; }
__host__ __device__ __forceinline__ int perm32(int rho) { const int n = rho >> 4, i = rho & 15; return 8 * (i >> 2) + 4 * n + (i & 3); }
struct Unit { int pm, pn; };
struct Gemm { const bf16_t* A; const bf16_t* Bt; int M, N, K; };
struct StaticOrder {
    int nM, nN, nwg, G, c;
    __host__ __device__ void init(int M, int N, int G_, int c_) { nM = M / BM; nN = N / BM; nwg = nM * nN; G = G_; c = c_; }
    __host__ __device__ bool next(int i, Unit& u) const {
        const long L = (long)i * G + c; if (L >= nwg) return false;
        int wgid = (int)L; { const int q = nwg / NXCD, r = nwg % NXCD, xcd = wgid % NXCD, off = wgid / NXCD; wgid = (xcd < r ? xcd * (q + 1) : r * (q + 1) + (xcd - r) * q) + off; }
        const int nig = WGM * nN, gid = wgid / nig, fm = gid * WGM, gsz = (nM - fm) < WGM ? (nM - fm) : WGM;
        u.pm = fm + ((wgid % nig) % gsz); u.pn = (wgid % nig) / gsz; return true;
    }
};

template <class Epi, bool ALIGN_EPI, bool SP2>
__device__ __forceinline__ void gemm_phase(LAS unsigned char* lds, const Gemm g, const StaticOrder& S, const Epi& E, const int tid) {
    const int wid = __builtin_amdgcn_readfirstlane(tid >> 6), lane = tid & 63, wr = wid >> 2, wc = wid & 3, fr = lane & 15, fq = lane >> 4;
    const int K = g.K, nt = K / BK;
    unsigned voffA[2], voffB[2];
#pragma unroll
    for (int i = 0; i < 2; ++i) { int R, C; stage_rc(tid * 16 + i * 8192, R, C); voffA[i] = (unsigned)(R * K + C) * 2u; voffB[i] = (unsigned)(R * K + C) * 2u; }
    const size_t kstep = (size_t)(BK * 2);
    const size_t hstep = (size_t)HALF * K * 2;
    const size_t tstep = 2 * hstep;
    const unsigned ldsw = (unsigned)wid * 1024u;
    const int aoff = lds_byte(wr * 64 + fr, fq * 8), boff = lds_byte(wc * 32 + fr, fq * 8);
#define PG8_SA(b, h) (((b) * 2 + (h)) * HTB)
#define PG8_SB(b, h) ((4 + (b) * 2 + (h)) * HTB)
#define PG8_STAGE(bufoff, gbase, voff) do { _Pragma("unroll") for (int _i = 0; _i < 2; ++_i) \
        __builtin_amdgcn_global_load_lds((const unsigned*)((const char*)(gbase) + (voff)[_i]), (LAS unsigned*)(lds + (bufoff) + ldsw + _i * 8192), 16, 0, 0); } while (0)
#define PG8_LDA(dst, b, h) do { _Pragma("unroll") for (int m = 0; m < 4; ++m) _Pragma("unroll") for (int k = 0; k < 2; ++k) dst[m][k] = *(const LAS bf16x8*)(lds + PG8_SA(b, h) + aoff + m * 2048 + k * 1024); } while (0)
#define PG8_LDB(dst, b, h) do { _Pragma("unroll") for (int n = 0; n < 2; ++n) _Pragma("unroll") for (int k = 0; k < 2; ++k) dst[n][k] = *(const LAS bf16x8*)(lds + PG8_SB(b, h) + boff + n * 2048 + k * 1024); } while (0)
#define PG8_MMA(ai, bj, At, Bt) do { __builtin_amdgcn_s_setprio(1); _Pragma("unroll") for (int m = 0; m < 4; ++m) _Pragma("unroll") for (int n = 0; n < 2; ++n) _Pragma("unroll") for (int k = 0; k < 2; ++k) \
        acc[ai][bj][m][n] = __builtin_amdgcn_mfma_f32_16x16x32_bf16(Bt[n][k], At[m][k], acc[ai][bj][m][n], 0, 0, 0); __builtin_amdgcn_s_setprio(0); } while (0)
#define PG8_WAIT_V(n) asm volatile("s_waitcnt vmcnt(" #n ")" ::: "memory")
#define PG8_WAIT_L(n) asm volatile("s_waitcnt lgkmcnt(" #n ")" ::: "memory")
#define PG8_BAR __builtin_amdgcn_s_barrier()
#define PG8_SCHED __builtin_amdgcn_sched_barrier(0)
    Unit cur, nxt; int ui = 0;
    if (!S.next(0, cur)) return;
    f32x4 acc[2][2][4][2];
#pragma unroll
    for (int a = 0; a < 2; ++a)
#pragma unroll
        for (int b = 0; b < 2; ++b)
#pragma unroll
            for (int m = 0; m < 4; ++m)
#pragma unroll
                for (int n = 0; n < 2; ++n) acc[a][b][m][n] = (f32x4){0.f, 0.f, 0.f, 0.f};
    bf16x8 At[4][2], B0[2][2], B1[2][2];
    const char* cA = (const char*)g.A + (size_t)cur.pm * tstep; const char* cB = (const char*)g.Bt + (size_t)cur.pn * tstep;
    if constexpr (SP2) {
        PG8_STAGE(PG8_SB(0, 0), cB, voffB); PG8_STAGE(PG8_SB(0, 1), cB + hstep, voffB); PG8_STAGE(PG8_SA(0, 0), cA, voffA); PG8_STAGE(PG8_SA(0, 1), cA + hstep, voffA);
        if (wr == 1) PG8_BAR;
        PG8_WAIT_V(2); PG8_BAR;
        PG8_STAGE(PG8_SB(1, 0), cB + kstep, voffB); PG8_STAGE(PG8_SA(1, 0), cA + kstep, voffA); PG8_STAGE(PG8_SB(1, 1), cB + hstep + kstep, voffB);
        PG8_WAIT_V(6); PG8_BAR;
    } else {
        PG8_STAGE(PG8_SB(0, 0), cB, voffB); PG8_STAGE(PG8_SA(0, 0), cA, voffA); PG8_STAGE(PG8_SB(0, 1), cB + hstep, voffB); PG8_STAGE(PG8_SA(0, 1), cA + hstep, voffA);
        if (wr == 1) PG8_BAR;
        PG8_WAIT_V(4); PG8_BAR;
        PG8_STAGE(PG8_SB(1, 0), cB + kstep, voffB); PG8_STAGE(PG8_SA(1, 0), cA + kstep, voffA); PG8_STAGE(PG8_SB(1, 1), cB + hstep + kstep, voffB);
        PG8_WAIT_V(6); PG8_BAR;
    }
    for (;;) {
        const bool has_next = S.next(ui + 1, nxt);
        const char* nA = has_next ? (const char*)g.A + (size_t)nxt.pm * tstep : cA; const char* nB = has_next ? (const char*)g.Bt + (size_t)nxt.pn * tstep : cB;
        for (int t = 0; t < nt; t += 2) {
            const bool last = (t == nt - 2);
            const char* a1 = cA + (size_t)(t + 1) * kstep;
            const char* a2 = last ? nA : cA + (size_t)(t + 2) * kstep; const char* b2 = last ? nB : cB + (size_t)(t + 2) * kstep;
            const char* a3 = a2 + kstep; const char* b3 = b2 + kstep;
            if constexpr (SP2) {
            PG8_LDB(B0, 0, 0); PG8_LDB(B1, 0, 1); PG8_SCHED; PG8_LDA(At, 0, 0); PG8_STAGE(PG8_SA(1, 1), a1 + hstep, voffA);
            PG8_WAIT_V(8); PG8_WAIT_L(0); PG8_BAR; PG8_MMA(0, 0, At, B0); PG8_MMA(0, 1, At, B1); PG8_BAR; PG8_SCHED;
            PG8_LDA(At, 0, 1); PG8_STAGE(PG8_SB(0, 0), b2, voffB); PG8_STAGE(PG8_SB(0, 1), b2 + hstep, voffB); PG8_STAGE(PG8_SA(0, 0), a2, voffA);
            PG8_WAIT_V(8); PG8_WAIT_L(0); PG8_BAR; PG8_MMA(1, 0, At, B0); PG8_MMA(1, 1, At, B1); PG8_BAR; PG8_SCHED;
            PG8_LDB(B0, 1, 0); PG8_LDB(B1, 1, 1); PG8_SCHED; PG8_LDA(At, 1, 0); PG8_STAGE(PG8_SA(0, 1), a2 + hstep, voffA);
            PG8_WAIT_V(8); PG8_WAIT_L(0); PG8_BAR; PG8_MMA(0, 0, At, B0); PG8_MMA(0, 1, At, B1); PG8_BAR; PG8_SCHED;
            PG8_LDA(At, 1, 1); PG8_STAGE(PG8_SB(1, 0), b3, voffB); PG8_STAGE(PG8_SB(1, 1), b3 + hstep, voffB); PG8_STAGE(PG8_SA(1, 0), a3, voffA);
            PG8_WAIT_V(8); PG8_WAIT_L(0); PG8_BAR; PG8_MMA(1, 0, At, B0); PG8_MMA(1, 1, At, B1); PG8_BAR; PG8_SCHED;
            } else {
            PG8_LDB(B0, 0, 0); PG8_SCHED; PG8_LDA(At, 0, 0); PG8_STAGE(PG8_SA(1, 1), a1 + hstep, voffA);
            PG8_WAIT_L(8); PG8_BAR; PG8_WAIT_L(0); PG8_MMA(0, 0, At, B0); PG8_BAR; PG8_SCHED;
            PG8_LDB(B1, 0, 1); PG8_STAGE(PG8_SB(0, 0), b2, voffB);
            PG8_BAR; PG8_WAIT_L(0); PG8_MMA(0, 1, At, B1); PG8_BAR;
            PG8_LDA(At, 0, 1); PG8_STAGE(PG8_SA(0, 0), a2, voffA);
            PG8_BAR; PG8_WAIT_L(0); PG8_MMA(1, 0, At, B0); PG8_BAR; PG8_SCHED;
            PG8_STAGE(PG8_SB(0, 1), b2 + hstep, voffB);
            PG8_WAIT_V(6); PG8_BAR; PG8_MMA(1, 1, At, B1); PG8_BAR;
            PG8_LDB(B0, 1, 0); PG8_SCHED; PG8_LDA(At, 1, 0); PG8_STAGE(PG8_SA(0, 1), a2 + hstep, voffA);
            PG8_WAIT_L(8); PG8_BAR; PG8_WAIT_L(0); PG8_MMA(0, 0, At, B0); PG8_BAR; PG8_SCHED;
            PG8_LDB(B1, 1, 1); PG8_STAGE(PG8_SB(1, 0), b3, voffB);
            PG8_BAR; PG8_WAIT_L(0); PG8_MMA(0, 1, At, B1); PG8_BAR;
            PG8_LDA(At, 1, 1); PG8_STAGE(PG8_SA(1, 0), a3, voffA);
            PG8_BAR; PG8_WAIT_L(0); PG8_MMA(1, 0, At, B0); PG8_BAR; PG8_SCHED;
            PG8_STAGE(PG8_SB(1, 1), b3 + hstep, voffB);
            PG8_WAIT_V(6); PG8_BAR; PG8_MMA(1, 1, At, B1); PG8_BAR;
            }
        }
        if constexpr (ALIGN_EPI) { if (wr == 0) PG8_BAR; }
        E(acc, cur, wr, wc, fr, fq);
        if (!has_next) break;
#pragma unroll
        for (int a = 0; a < 2; ++a)
#pragma unroll
            for (int b = 0; b < 2; ++b)
#pragma unroll
                for (int m = 0; m < 4; ++m)
#pragma unroll
                    for (int n = 0; n < 2; ++n) acc[a][b][m][n] = (f32x4){0.f, 0.f, 0.f, 0.f};
        cur = nxt; cA = nA; cB = nB; ++ui;
        if constexpr (ALIGN_EPI) { if (wr == 1) PG8_BAR; }
    }
    PG8_WAIT_V(0);
    if constexpr (!ALIGN_EPI) { if (wr == 0) PG8_BAR; }
    PG8_BAR;
#undef PG8_SA
#undef PG8_SB
#undef PG8_STAGE
#undef PG8_LDA
#undef PG8_LDB
#undef PG8_MMA
#undef PG8_WAIT_V
#undef PG8_WAIT_L
#undef PG8_BAR
#undef PG8_SCHED
}
}

struct EpiArgs {
    GAS bf16_t* out; const GAS float* ssp; GAS float* gates; GAS float* o0; GAS float* o1; GAS float* o2; GAS float* o3;
    const GAS float* base_p; const GAS float* base_s; GAS float* X; GAS bf16_t* Xb; GAS float* ssp_out;
};
__device__ __forceinline__ float row_rstd(const GAS float* ssp, int row) {
    const GAS f32x4* p = (const GAS f32x4*)(ssp + (size_t)row * 16);
    const f32x4 a = p[0], b = p[1], c = p[2], d = p[3];
    const float s = ((a[0] + a[1]) + (a[2] + a[3])) + ((b[0] + b[1]) + (b[2] + b[3])) + ((c[0] + c[1]) + (c[2] + c[3])) + ((d[0] + d[1]) + (d[2] + d[3]));
    return rsqrtf(s * (1.0f / 1024.0f) + EPS);
}
template <int MODE, bool SMALL>
__device__ __forceinline__ float epi_apply(const EpiArgs& a, int row, int g32, int fq, f32x4 v0, f32x4 v1, float rstd) {
    const int c0 = 32 * g32 + 8 * fq;
    if constexpr (MODE == 0) {
        if (g32 >= ABIN / 32) return 0.f;
        v0 *= rstd; v1 *= rstd;
        u32x4 w; w.x = pk2(v0[0], v0[1]); w.y = pk2(v0[2], v0[3]); w.z = pk2(v1[0], v1[1]); w.w = pk2(v1[2], v1[3]);
        *(GAS u32x4*)(a.out + (size_t)row * ABIN + c0) = w;
        if (g32 == 48 && fq < 2) { GAS float* gp = a.gates + (size_t)row * 32 + 8 * fq; *(GAS f32x4*)gp = v0; *(GAS f32x4*)(gp + 4) = v1; }
        if (g32 == 96 && fq >= 2) { GAS float* gp = a.gates + (size_t)row * 32 + 16 + 8 * (fq - 2); *(GAS f32x4*)gp = v0; *(GAS f32x4*)(gp + 4) = v1; }
        if (c0 < DNQKV) {
            if constexpr (!SMALL) { const int t = row & (SEQ - 1), b = row >> 12; if (t >= SEQ - 3) { GAS float* d = a.o0 + (size_t)(b * 3 + (t - (SEQ - 3))) * DNQKV + c0; *(GAS f32x4*)d = v0; *(GAS f32x4*)(d + 4) = v1; } }
            else { const int r = row - TP, t = r & 15, b = r >> 4; if (t >= SSEQ - 3) { GAS float* d = a.o1 + (size_t)(b * 3 + (t - (SSEQ - 3))) * DNQKV + c0; *(GAS f32x4*)d = v0; *(GAS f32x4*)(d + 4) = v1; } }
        }
        return 0.f;
    } else if constexpr (MODE == 1) {
        v0 *= rstd; v1 *= rstd;
        u32x4 w; w.x = pk2(v0[0], v0[1]); w.y = pk2(v0[2], v0[3]); w.z = pk2(v1[0], v1[1]); w.w = pk2(v1[2], v1[3]);
        *(GAS u32x4*)(a.out + (size_t)row * NQKV + c0) = w;
        if (c0 >= 1024) {
            const int isv = c0 >= 2048, cc = c0 - 1024 - 1024 * isv;
            if constexpr (!SMALL) { const int t = row & (SEQ - 1), b = row >> 12; if (t >= SEQ - 512) { GAS float* d = a.o0 + (size_t)isv * (O_CVP - O_CKP) + (size_t)(b * 512 + (t - (SEQ - 512))) * 1024 + cc; *(GAS f32x4*)d = v0; *(GAS f32x4*)(d + 4) = v1; } }
            else { const int r = row - TP; GAS float* d = a.o2 + (size_t)isv * (O_CVS - O_CKS) + (size_t)r * 1024 + cc; *(GAS f32x4*)d = v0; *(GAS f32x4*)(d + 4) = v1; }
        }
        return 0.f;
    } else if constexpr (MODE == 2) {
        const GAS float* bp = SMALL ? a.base_s + (size_t)(row - TP) * DM + c0 : a.base_p + (size_t)row * DM + c0;
        const f32x4 x0 = *(const GAS f32x4*)bp + v0, x1 = *(const GAS f32x4*)(bp + 4) + v1;
        GAS float* xp = a.X + (size_t)row * DM + c0; *(GAS f32x4*)xp = x0; *(GAS f32x4*)(xp + 4) = x1;
        u32x4 w; w.x = pk2(x0[0], x0[1]); w.y = pk2(x0[2], x0[3]); w.z = pk2(x1[0], x1[1]); w.w = pk2(x1[2], x1[3]);
        *(GAS u32x4*)(a.Xb + (size_t)row * DM + c0) = w;
        return ((x0[0] * x0[0] + x0[1] * x0[1]) + (x0[2] * x0[2] + x0[3] * x0[3])) + ((x1[0] * x1[0] + x1[1] * x1[1]) + (x1[2] * x1[2] + x1[3] * x1[3]));
    } else {
        v0 *= rstd; v1 *= rstd;
        float h[4];
#pragma unroll
        for (int j = 0; j < 4; ++j) h[j] = silu_f(v0[j]) * v1[j];
        u32x2 w; w.x = pk2(h[0], h[1]); w.y = pk2(h[2], h[3]);
        *(GAS u32x2*)(a.out + (size_t)row * DFF + 16 * g32 + 4 * fq) = w;
        return 0.f;
    }
}
constexpr int EA_OFF = 131072 + 512;
__device__ __forceinline__ EpiArgs load_ea(const LAS unsigned long long* ap) {
    EpiArgs a;
    a.out = (GAS bf16_t*)ap[0]; a.ssp = (const GAS float*)ap[1]; a.gates = (GAS float*)ap[2]; a.o0 = (GAS float*)ap[3]; a.o1 = (GAS float*)ap[4]; a.o2 = (GAS float*)ap[5]; a.o3 = (GAS float*)ap[6];
    a.base_p = (const GAS float*)ap[7]; a.base_s = (const GAS float*)ap[8]; a.X = (GAS float*)ap[9]; a.Xb = (GAS bf16_t*)ap[10]; a.ssp_out = (GAS float*)ap[11];
    return a;
}
template <int MODE> struct Epi {
    const LAS unsigned long long* ap;
    __device__ __forceinline__ void operator()(const f32x4 (&acc)[2][2][4][2], const pg8::Unit& u, int wr, int wc, int fr, int fq) const {
        const EpiArgs a = load_ea(ap);
#pragma unroll
        for (int ai = 0; ai < 2; ++ai)
#pragma unroll
            for (int m = 0; m < 4; ++m) {
                const int row = u.pm * 256 + ai * 128 + wr * 64 + m * 16 + fr;
                float rstd = 1.f; if constexpr (MODE != 2) rstd = row_rstd(a.ssp, row);
                float ss = 0.f;
#pragma unroll
                for (int bj = 0; bj < 2; ++bj) { const int g32 = (u.pn * 256 + bj * 128 + wc * 32) >> 5; ss += epi_apply<MODE, false>(a, row, g32, fq, acc[ai][bj][m][0], acc[ai][bj][m][1], rstd); }
                if constexpr (MODE == 2) { ss += __shfl_xor(ss, 16); ss += __shfl_xor(ss, 32); if (fq == 0) a.ssp_out[(size_t)row * 16 + u.pn * 4 + wc] = ss; }
            }
    }
};

template <int MODE>
__device__ __forceinline__ void small_gemm(const bf16_t* A, const bf16_t* Bt, int Npos, int K, const LAS unsigned long long* eap, LAS unsigned char* lds, int wg, int G, int wid, int lane) {
    const int fr = lane & 15, fq = lane >> 4, ncg = (MODE == 0 ? (ABIN + 63) / 64 : Npos / 64), nunits = (TS / 16) * ncg, KW = K / 8;
    LAS f32x4* part = (LAS f32x4*)lds;
    for (int u = wg; u < nunits; u += G) {
        const int rb = u % (TS / 16), cgp = u / (TS / 16), r0 = TP + rb * 16, p0 = cgp * 64;
        f32x4 acc[4];
#pragma unroll
        for (int f = 0; f < 4; ++f) acc[f] = (f32x4){0.f, 0.f, 0.f, 0.f};
        const bf16_t* ap = A + (size_t)(r0 + fr) * K + wid * KW + 8 * fq;
        const bf16_t* bp = Bt + (size_t)(p0 + fr) * K + wid * KW + 8 * fq;
        for (int k0 = 0; k0 < KW; k0 += 32) {
            const bf16x8 av = *(const bf16x8*)(ap + k0);
            bf16x8 wv[4];
#pragma unroll
            for (int f = 0; f < 4; ++f) wv[f] = *(const bf16x8*)(bp + (size_t)(16 * f) * K + k0);
#pragma unroll
            for (int f = 0; f < 4; ++f) acc[f] = __builtin_amdgcn_mfma_f32_16x16x32_bf16(wv[f], av, acc[f], 0, 0, 0);
        }
#pragma unroll
        for (int f = 0; f < 4; ++f) part[(wid * 4 + f) * 64 + lane] = acc[f];
        __syncthreads();
        if (wid == 0) {
#pragma unroll
            for (int w = 1; w < 8; ++w)
#pragma unroll
                for (int f = 0; f < 4; ++f) acc[f] += part[(w * 4 + f) * 64 + lane];
            const int row = r0 + fr;
            const EpiArgs a = load_ea(eap);
            float rstd = 1.f; if constexpr (MODE != 2) rstd = row_rstd(a.ssp, row);
            float ss = 0.f;
#pragma unroll
            for (int gq = 0; gq < 2; ++gq) ss += epi_apply<MODE, true>(a, row, (p0 >> 5) + gq, fq, acc[2 * gq], acc[2 * gq + 1], rstd);
            if constexpr (MODE == 2) { ss += __shfl_xor(ss, 16); ss += __shfl_xor(ss, 32); if (fq == 0) a.ssp_out[(size_t)row * 16 + cgp] = ss; }
        }
        __syncthreads();
    }
}

__device__ __forceinline__ void transpose_item(const float* W, int K, int Nsrc, int gu, const float* gamma, bf16_t* WT, LAS float* scr, int item, int npb, int lane) {
    const int kb = item / npb, nb = item % npb, k0 = 64 * kb, p0 = 32 * nb;
    const int cl = p0 + pg8::perm32(lane & 31);
    int src = cl; if (gu) src = ((cl >> 2) & 1) * DFF + 4 * (cl >> 3) + (cl & 3);
    const bool valid = src < Nsrc;
#pragma unroll 8
    for (int i = 0; i < 32; ++i) { const int kk = 2 * i + (lane >> 5); float v = 0.f; if (valid) { v = W[(size_t)(k0 + kk) * Nsrc + src]; if (gamma) v *= gamma[k0 + kk]; } scr[kk * 33 + (lane & 31)] = v; }
    asm volatile("s_waitcnt lgkmcnt(0)" ::: "memory");
    const int c = lane & 7;
#pragma unroll
    for (int j = 0; j < 4; ++j) { const int n = (lane >> 3) + 8 * j; const LAS float* s = scr + (8 * c) * 33 + n;
        u32x4 o; o.x = pk2(s[0 * 33], s[1 * 33]); o.y = pk2(s[2 * 33], s[3 * 33]); o.z = pk2(s[4 * 33], s[5 * 33]); o.w = pk2(s[6 * 33], s[7 * 33]);
        *(u32x4*)(WT + (size_t)(p0 + n) * K + k0 + 8 * c) = o; }
    asm volatile("s_waitcnt lgkmcnt(0)" ::: "memory");
}
__device__ __forceinline__ void convert_matrix(const float* W, int K, int Nsrc, int Npos, int gu, const float* gamma, bf16_t* WT, LAS float* scr, int gw, int ngw, int lane) {
    const int npb = Npos / 32, nitems = (K / 64) * npb;
    for (int it = gw; it < nitems; it += ngw) transpose_item(W, K, Nsrc, gu, gamma, WT, scr, it, npb, lane);
}
__device__ __forceinline__ void convert_mats(const Params& P, LAS unsigned char* lds, int m_lo, int m_hi, int gw, int ngw, int wid, int lane) {
    LAS float* scr = (LAS float*)(lds + wid * 8704);
    unsigned char* ws = P.ws;
    for (int mi = m_lo; mi < m_hi; ++mi) {
        int type, idx;
        if (mi < 4) { type = (mi == 0) ? 0 : (mi == 1) ? 1 : (mi == 2) ? 4 : 5; idx = 0; }
        else { const int r = mi - 4, grp = r >> 2, q = r & 3;
            if (q >= 2) { type = q + 2; idx = grp + 1; } else if (grp == 1) { type = q; idx = 1; } else { type = 2 + q; idx = grp >> 1; } }
        const float* W; const float* gamma = nullptr; bf16_t* WT; int K = 1024, Nsrc, Npos, gu = 0;
        if (type == 0) { W = P.in[8] + (size_t)idx * 1024 * ABIN; gamma = P.in[7] + idx * 1024; WT = (bf16_t*)(ws + WS_WIN + idx * SZ_WIN); Nsrc = ABIN; Npos = ABPAD; }
        else if (type == 1) { W = P.in[16] + (size_t)idx * 1024 * 1024; WT = (bf16_t*)(ws + WS_WOUT + idx * SZ_W1K); Nsrc = 1024; Npos = 1024; }
        else if (type == 2) { W = P.in[18] + (size_t)idx * 1024 * NQKV; gamma = P.in[17] + idx * 1024; WT = (bf16_t*)(ws + WS_WQKV + idx * SZ_WQKV); Nsrc = NQKV; Npos = NQKV; }
        else if (type == 3) { W = P.in[20] + (size_t)idx * 1024 * 1024; WT = (bf16_t*)(ws + WS_WCOUT + idx * SZ_W1K); Nsrc = 1024; Npos = 1024; }
        else if (type == 4) { W = P.in[22] + (size_t)idx * 1024 * NGU; gamma = P.in[21] + idx * 1024; WT = (bf16_t*)(ws + WS_WGU + idx * SZ_WGU); Nsrc = NGU; Npos = NGU; gu = 1; }
        else { W = P.in[23] + (size_t)idx * DFF * 1024; WT = (bf16_t*)(ws + WS_WDN + idx * SZ_WDN); K = DFF; Nsrc = 1024; Npos = 1024; }
        convert_matrix(W, K, Nsrc, Npos, gu, gamma, WT, scr, gw, ngw, lane);
    }
}
__device__ __forceinline__ void phase_prologue(const Params& P, LAS unsigned char* lds, int gw, int ngw, int wid, int lane) {
    convert_mats(P, lds, 0, 4, gw, ngw, wid, lane);
    unsigned char* ws = P.ws;
    bf16_t* Xb = (bf16_t*)(ws + WS_XB); float* ssp = (float*)(ws + WS_SSP);
    for (int row = gw; row < TR; row += ngw) {
        const float* xr = (row < TP) ? P.in[0] + (size_t)row * DM : P.in[1] + (size_t)(row - TP) * DM;
        f32x4 v[4]; float s = 0.f;
#pragma unroll
        for (int j = 0; j < 4; ++j) { v[j] = ((const f32x4*)xr)[lane + 64 * j]; s += (v[j][0] * v[j][0] + v[j][1] * v[j][1]) + (v[j][2] * v[j][2] + v[j][3] * v[j][3]); }
        s = wave_sum(s);
#pragma unroll
        for (int j = 0; j < 4; ++j) { u32x2 w; w.x = pk2(v[j][0], v[j][1]); w.y = pk2(v[j][2], v[j][3]); ((u32x2*)(Xb + (size_t)row * DM))[lane + 64 * j] = w; }
        if (lane < 16) ssp[(size_t)row * 16 + lane] = (lane == 0) ? s : 0.f;
    }
}
__device__ __forceinline__ void phase_final(const Params& P, int gw, int ngw, int lane) {
    const GAS float* ssp = (const GAS float*)(P.ws + WS_SSP); const float* g = P.in[24];
    f32x4 gv[4];
#pragma unroll
    for (int j = 0; j < 4; ++j) gv[j] = ((const f32x4*)g)[lane + 64 * j];
    for (int row = gw; row < TR; row += ngw) {
        const float rstd = row_rstd(ssp, row);
        f32x4* xr = (f32x4*)(P.out + (size_t)row * DM);
#pragma unroll
        for (int j = 0; j < 4; ++j) { f32x4 v = xr[lane + 64 * j]; xr[lane + 64 * j] = v * rstd * gv[j]; }
    }
}

constexpr int MX_CH = 32;
#define LDS_BARRIER() asm volatile("s_waitcnt lgkmcnt(0)\n\ts_barrier" ::: "memory")
__device__ __forceinline__ void delta_unit(const Params& P, LAS unsigned char* lds, int li, bool sample, int b, int h, int half, const int tid) {
    const int lane = tid & 63, wid = __builtin_amdgcn_readfirstlane(tid >> 6);
    const int L = sample ? SSEQ : SEQ, rowbase = sample ? TP + b * SSEQ : b * SEQ;
    const bf16_t* PROJ = (const bf16_t*)(P.ws + WS_R1); const float* GATES = (const float*)(P.ws + WS_GATES); bf16_t* MIX = (bf16_t*)(P.ws + WS_MIX);
    const int NC = (L + MX_CH - 1) / MX_CH;
    constexpr int SET = 4 * 8192 + 256;
    if (wid < 4) __builtin_amdgcn_s_setprio(2);
    const int e = 32 * half + (wid & 3) * 8 + (lane >> 3), dq = lane & 7;
    f32x2 S[4];
    float* sout = P.out + (sample ? O_DNS : O_DNP) + (size_t)((li * 8 + b) * 8 + h) * 4096;
    if (wid < 4) {
        if (sample) { const float* s0 = P.in[3] + (size_t)((li * 8 + b) * 8 + h) * 4096;
#pragma unroll
            for (int j = 0; j < 4; ++j) { S[j][0] = s0[(8 * dq + 2 * j) * 64 + e]; S[j][1] = s0[(8 * dq + 2 * j + 1) * 64 + e]; } }
        else {
#pragma unroll
            for (int j = 0; j < 4; ++j) S[j] = (f32x2){0.f, 0.f}; }
    }
    const int pw = wid - 4, c = lane;
    float cwq[4], cwk[4], cwv[4], alog = 0.f, dtb = 0.f;
    float rq[11], rk[11], rv[11], ga = 0.f, gb_ = 0.f;
    if (wid >= 4) {
        const float* cw = P.in[9] + (size_t)li * 4 * DNQKV;
#pragma unroll
        for (int t = 0; t < 4; ++t) { cwq[t] = cw[t * DNQKV + h * 64 + c]; cwk[t] = cw[t * DNQKV + 512 + h * 64 + c]; cwv[t] = cw[t * DNQKV + 1024 + h * 64 + c]; }
        alog = P.in[10][li * 8 + h]; dtb = P.in[11][li * 8 + h];
    }
#define DN_LOADS(jn) do { const int t0n_ = (jn) * MX_CH + pw * 8; if ((jn) < NC && t0n_ < L) { \
        _Pragma("unroll") for (int r = 0; r < 11; ++r) { const int t = t0n_ - 3 + r, tc = max(t, 0); const bf16_t* pr = PROJ + (size_t)(rowbase + tc) * ABIN + h * 64 + c; \
            const float m = (t >= 0) ? 1.f : 0.f; rq[r] = bf2f(pr[0]) * m; rk[r] = bf2f(pr[512]) * m; rv[r] = bf2f(pr[1024]) * m; } \
        { const float* gp = GATES + (size_t)(rowbase + t0n_ + (lane & 7)) * 32; ga = gp[h]; gb_ = gp[8 + h]; } \
        if (sample && t0n_ == 0) { _Pragma("unroll") for (int r = 0; r < 3; ++r) { const float* cb = P.in[2] + (size_t)((li * 8 + b) * 3 + r) * DNQKV + h * 64 + c; rq[r] = cb[0]; rk[r] = cb[512]; rv[r] = cb[1024]; } } } } while (0)
    if (wid >= 4) DN_LOADS(0);
    for (int j = 0; j < NC + 2; ++j) {
        if (wid >= 4) {
            if (j < NC) {
                LAS float* qs = (LAS float*)(lds + (j & 1) * SET); LAS float* ks = qs + 2048; LAS float* vs = qs + 4096; LAS float* sc = qs + 8192;
                const int t0 = j * MX_CH + pw * 8;
                if (t0 < L) {
#pragma unroll
                    for (int i = 0; i < 8; ++i) {
                        float q = cwq[0] * rq[i] + cwq[1] * rq[i + 1] + cwq[2] * rq[i + 2] + cwq[3] * rq[i + 3];
                        float k = cwk[0] * rk[i] + cwk[1] * rk[i + 1] + cwk[2] * rk[i + 2] + cwk[3] * rk[i + 3];
                        float v = cwv[0] * rv[i] + cwv[1] * rv[i + 1] + cwv[2] * rv[i + 2] + cwv[3] * rv[i + 3];
                        q = silu_f(q); k = silu_f(k); v = silu_f(v);
                        const float sq = wave_sum(q * q), sk = wave_sum(k * k);
                        const int tok = pw * 8 + i;
                        qs[tok * 64 + c] = q * rsqrtf(sq + EPS) * 0.125f; ks[tok * 64 + c] = k * rsqrtf(sk + EPS); vs[tok * 64 + c] = v;
                    }
                    if (lane < 8) { const float g = -__expf(alog) * softplus_f(ga + dtb); sc[(pw * 8 + lane) * 2] = __expf(g); sc[(pw * 8 + lane) * 2 + 1] = sigmoid_f(gb_); }
                }
            }
            DN_LOADS(j + 1);
            if (j >= 2) {
                LAS float* os = (LAS float*)(lds + (j & 1) * SET) + 6144;
                const int t0 = (j - 2) * MX_CH + pw * 8;
                if (t0 < L && (c >> 5) == half) {
#pragma unroll
                    for (int i = 0; i < 8; ++i) {
                        const int tok = pw * 8 + i; const size_t row = (size_t)(rowbase + t0 + i);
                        MIX[row * DM + h * 64 + c] = (bf16_t)f2bf(os[tok * 64 + c]);
                    }
                }
            }
        } else if (j >= 1 && j <= NC) {
            LAS float* qs = (LAS float*)(lds + ((j - 1) & 1) * SET); LAS float* ks = qs + 2048; LAS float* vs = qs + 4096; LAS float* os = qs + 6144; LAS float* sc = qs + 8192;
            const int ntok = min(MX_CH, L - (j - 1) * MX_CH);
            f32x4 kk[2], qq[2]; float ve; f32x2 gb;
#pragma unroll
            for (int i = 0; i < 2; ++i) { kk[i] = *(const LAS f32x4*)(ks + 8 * dq + 4 * i); qq[i] = *(const LAS f32x4*)(qs + 8 * dq + 4 * i); }
            ve = vs[e]; gb = *(const LAS f32x2*)(sc);
#pragma unroll 2
            for (int tok = 0; tok < ntok; ++tok) {
                const int tn = min(tok + 1, ntok - 1);
                f32x4 kn[2], qn[2];
#pragma unroll
                for (int i = 0; i < 2; ++i) { kn[i] = *(const LAS f32x4*)(ks + tn * 64 + 8 * dq + 4 * i); qn[i] = *(const LAS f32x4*)(qs + tn * 64 + 8 * dq + 4 * i); }
                const float vn = vs[tn * 64 + e]; const f32x2 gn = *(const LAS f32x2*)(sc + tn * 2);
                const float eg = gb[0], beta = gb[1];
                const f32x2 wa = (f32x2){kk[0][0], kk[0][1]} * S[0] + (f32x2){kk[0][2], kk[0][3]} * S[1];
                const f32x2 wb = (f32x2){kk[1][0], kk[1][1]} * S[2] + (f32x2){kk[1][2], kk[1][3]} * S[3];
                const f32x2 ws2 = wa + wb;
                const float w = oct_sum(ws2[0] + ws2[1]);
                const float dl = beta * (ve - eg * w);
                const f32x2 eg2 = (f32x2){eg, eg}, dl2 = (f32x2){dl, dl};
#pragma unroll
                for (int i = 0; i < 2; ++i) { S[2 * i] = S[2 * i] * eg2 + (f32x2){kk[i][0], kk[i][1]} * dl2; S[2 * i + 1] = S[2 * i + 1] * eg2 + (f32x2){kk[i][2], kk[i][3]} * dl2; }
                const f32x2 oa = (f32x2){qq[0][0], qq[0][1]} * S[0] + (f32x2){qq[0][2], qq[0][3]} * S[1];
                const f32x2 ob = (f32x2){qq[1][0], qq[1][1]} * S[2] + (f32x2){qq[1][2], qq[1][3]} * S[3];
                const f32x2 os2 = oa + ob;
                const float o = oct_sum(os2[0] + os2[1]);
                if (dq == 0) os[tok * 64 + e] = o;
#pragma unroll
                for (int i = 0; i < 2; ++i) { kk[i] = kn[i]; qq[i] = qn[i]; }
                ve = vn; gb = gn;
            }
        }
        LDS_BARRIER();
    }
#undef DN_LOADS
    if (wid < 4) {
#pragma unroll
        for (int j = 0; j < 4; ++j) { sout[(8 * dq + 2 * j) * 64 + e] = S[j][0]; sout[(8 * dq + 2 * j + 1) * 64 + e] = S[j][1]; }
    }
    __builtin_amdgcn_s_setprio(0);
}

__device__ __forceinline__ void gla_unit(const Params& P, LAS unsigned char* lds, int li, bool sample, int b, int h, const int tid) {
    const int lane = tid & 63, wid = __builtin_amdgcn_readfirstlane(tid >> 6);
    const int L = sample ? SSEQ : SEQ, rowbase = sample ? TP + b * SSEQ : b * SEQ;
    const bf16_t* PROJ = (const bf16_t*)(P.ws + WS_R1); const float* GATES = (const float*)(P.ws + WS_GATES); bf16_t* MIX = (bf16_t*)(P.ws + WS_MIX);
    const int NC = (L + MX_CH - 1) / MX_CH;
    constexpr int SET = 3 * 4096 + 2 * 8192;
    if (wid < 4) __builtin_amdgcn_s_setprio(2);
    const int e = (wid & 3) * 16 + (lane >> 2), dq = lane & 3;
    f32x2 S[4];
    float* sout = P.out + (sample ? O_GLAS : O_GLAP) + (size_t)((li * 8 + b) * 8 + h) * 2048;
    if (wid < 4) {
        if (sample) { const float* s0 = P.in[4] + (size_t)((li * 8 + b) * 8 + h) * 2048;
#pragma unroll
            for (int j = 0; j < 4; ++j) { S[j][0] = s0[(8 * dq + 2 * j) * 64 + e]; S[j][1] = s0[(8 * dq + 2 * j + 1) * 64 + e]; } }
        else {
#pragma unroll
            for (int j = 0; j < 4; ++j) S[j] = (f32x2){0.f, 0.f}; }
    }
    const int pw = wid - 4, c = lane, c32 = lane & 31;
    float w2[16], gkb = 0.f, onorm = 0.f;
    if (wid >= 4) {
#pragma unroll
        for (int r = 0; r < 16; ++r) w2[r] = P.in[13][(size_t)(li * 16 + r) * 256 + h * 32 + c32];
        gkb = P.in[14][li * 256 + h * 32 + c32]; onorm = P.in[15][li * 64 + c];
    }
    for (int j = 0; j < NC + 2; ++j) {
        if (wid >= 4) {
            if (j < NC) {
                LAS float* qs = (LAS float*)(lds + (j & 1) * SET); LAS float* ks = qs + 1024; LAS float* gs = qs + 2048; LAS float* vs = qs + 3072;
                const int t0 = j * MX_CH + pw * 8;
                if (t0 < L) {
                    const int g4 = (lane >> 5) * 4;
                    float rv[8], rq[4], rk[4]; f32x4 lrv[4][4];
#pragma unroll
                    for (int i = 0; i < 8; ++i) rv[i] = bf2f(PROJ[(size_t)(rowbase + t0 + i) * ABIN + 2576 + h * 64 + c]);
#pragma unroll
                    for (int i = 0; i < 4; ++i) { const size_t row = (size_t)(rowbase + t0 + g4 + i); const bf16_t* pr = PROJ + row * ABIN;
                        rq[i] = bf2f(pr[2064 + h * 32 + c32]); rk[i] = bf2f(pr[2320 + h * 32 + c32]);
#pragma unroll
                        for (int r = 0; r < 4; ++r) lrv[i][r] = *(const f32x4*)(GATES + row * 32 + 16 + 4 * r); }
#pragma unroll
                    for (int i = 0; i < 8; ++i) vs[(pw * 8 + i) * 64 + c] = rv[i];
#pragma unroll
                    for (int i = 0; i < 4; ++i) {
                        const int tok = pw * 8 + g4 + i;
                        float z = gkb;
#pragma unroll
                        for (int r = 0; r < 4; ++r) z += (lrv[i][r][0] * w2[4 * r] + lrv[i][r][1] * w2[4 * r + 1]) + (lrv[i][r][2] * w2[4 * r + 2] + lrv[i][r][3] * w2[4 * r + 3]);
                        const float ls = -softplus_f(-z);
                        qs[tok * 32 + c32] = rq[i] * 0.17677669529663687f; ks[tok * 32 + c32] = rk[i]; gs[tok * 32 + c32] = __expf(ls * (1.0f / 16.0f));
                    }
                }
            }
            if (j >= 2) {
                LAS float* os = (LAS float*)(lds + (j & 1) * SET) + 3072 + 2048;
                const int t0 = (j - 2) * MX_CH + pw * 8;
                if (t0 < L) {
#pragma unroll
                    for (int i = 0; i < 8; ++i) {
                        const int tok = pw * 8 + i; const size_t row = (size_t)(rowbase + t0 + i);
                        MIX[row * DM + 512 + h * 64 + c] = (bf16_t)f2bf(os[tok * 64 + c]);
                    }
                }
            }
        } else if (j >= 1 && j <= NC) {
            LAS float* qs = (LAS float*)(lds + ((j - 1) & 1) * SET); LAS float* ks = qs + 1024; LAS float* gs = qs + 2048; LAS float* vs = qs + 3072; LAS float* os = qs + 3072 + 2048;
            const int ntok = min(MX_CH, L - (j - 1) * MX_CH);
            f32x4 kk[2], qq[2], gg[2]; float ve;
#pragma unroll
            for (int i = 0; i < 2; ++i) { kk[i] = *(const LAS f32x4*)(ks + 8 * dq + 4 * i); qq[i] = *(const LAS f32x4*)(qs + 8 * dq + 4 * i); gg[i] = *(const LAS f32x4*)(gs + 8 * dq + 4 * i); }
            ve = vs[e];
            for (int tok = 0; tok < ntok; ++tok) {
                const int tn = min(tok + 1, ntok - 1);
                f32x4 kn[2], qn[2], gn[2];
#pragma unroll
                for (int i = 0; i < 2; ++i) { kn[i] = *(const LAS f32x4*)(ks + tn * 32 + 8 * dq + 4 * i); qn[i] = *(const LAS f32x4*)(qs + tn * 32 + 8 * dq + 4 * i); gn[i] = *(const LAS f32x4*)(gs + tn * 32 + 8 * dq + 4 * i); }
                const float vn = vs[tn * 64 + e];
                const f32x2 v2 = (f32x2){ve, ve};
                f32x2 oa[2];
#pragma unroll
                for (int i = 0; i < 2; ++i) {
                    S[2 * i] = S[2 * i] * (f32x2){gg[i][0], gg[i][1]} + (f32x2){kk[i][0], kk[i][1]} * v2; S[2 * i + 1] = S[2 * i + 1] * (f32x2){gg[i][2], gg[i][3]} + (f32x2){kk[i][2], kk[i][3]} * v2;
                    oa[i] = (f32x2){qq[i][0], qq[i][1]} * S[2 * i] + (f32x2){qq[i][2], qq[i][3]} * S[2 * i + 1];
                }
                const f32x2 os2 = oa[0] + oa[1];
                const float o = quad_sum(os2[0] + os2[1]);
                if (dq == 0) os[tok * 64 + e] = o;
#pragma unroll
                for (int i = 0; i < 2; ++i) { kk[i] = kn[i]; qq[i] = qn[i]; gg[i] = gn[i]; }
                ve = vn;
            }
        }
        __syncthreads();
    }
    if (wid < 4) {
#pragma unroll
        for (int j = 0; j < 4; ++j) { sout[(8 * dq + 2 * j) * 64 + e] = S[j][0]; sout[(8 * dq + 2 * j + 1) * 64 + e] = S[j][1]; }
    }
    __builtin_amdgcn_s_setprio(0);
}

__device__ __forceinline__ void phase_fixup(const Params& P, int li, int gw, int ngw, int lane) {
    bf16_t* MIX = (bf16_t*)(P.ws + WS_MIX); const bf16_t* PROJ = (const bf16_t*)(P.ws + WS_R1);
    const float* on = (lane < 32 ? P.in[12] : P.in[15]) + li * 64 + 16 * (lane & 3);
    float g[16];
#pragma unroll
    for (int j = 0; j < 16; ++j) g[j] = on[j];
    const int gcol = (lane < 32) ? 1552 + 16 * lane : 3104 + 16 * (lane - 32);
    for (int row = gw; row < TR; row += ngw) {
        u32x4* mp = (u32x4*)(MIX + (size_t)row * DM + 16 * lane);
        const u32x4* gp = (const u32x4*)(PROJ + (size_t)row * ABIN + gcol);
        const u32x4 m0 = mp[0], m1 = mp[1], g0 = gp[0], g1 = gp[1];
        float o[16], gt[16];
#pragma unroll
        for (int j = 0; j < 4; ++j) { o[2 * j] = __builtin_bit_cast(float, m0[j] << 16); o[2 * j + 1] = __builtin_bit_cast(float, m0[j] & 0xffff0000u); o[8 + 2 * j] = __builtin_bit_cast(float, m1[j] << 16); o[8 + 2 * j + 1] = __builtin_bit_cast(float, m1[j] & 0xffff0000u);
            gt[2 * j] = __builtin_bit_cast(float, g0[j] << 16); gt[2 * j + 1] = __builtin_bit_cast(float, g0[j] & 0xffff0000u); gt[8 + 2 * j] = __builtin_bit_cast(float, g1[j] << 16); gt[8 + 2 * j + 1] = __builtin_bit_cast(float, g1[j] & 0xffff0000u); }
        float ss = 0.f;
#pragma unroll
        for (int j = 0; j < 16; ++j) ss += o[j] * o[j];
        ss = quad_sum(ss);
        const float rstd = rsqrtf(ss * (1.0f / 64.0f) + EPS);
        float r[16];
#pragma unroll
        for (int j = 0; j < 16; ++j) r[j] = o[j] * rstd * g[j] * silu_f(gt[j]);
        u32x4 w0, w1;
#pragma unroll
        for (int j = 0; j < 4; ++j) { w0[j] = pk2(r[2 * j], r[2 * j + 1]); w1[j] = pk2(r[8 + 2 * j], r[8 + 2 * j + 1]); }
        mp[0] = w0; mp[1] = w1;
    }
}

constexpr int AT_KOFF = 0, AT_VOFF = 2 * 9216, AT_BIAS = 4 * 9216;
__device__ __forceinline__ int vpos(int kv) { return 16 * (kv >> 4) + 8 * ((kv >> 2) & 1) + 4 * ((kv >> 3) & 1) + (kv & 3); }
__device__ __forceinline__ void attn_build_bias(const Params& P, LAS unsigned char* lds, int li, int h, const int tid) {
    const float* tb = P.in[19] + (size_t)(li * 16 + h) * 257;
    LAS float* bt = (LAS float*)(lds + AT_BIAS);
    for (int i = tid; i < 4 * 2 * 64 * 32; i += 512) {
        const int r = i & 31, lane = (i >> 5) & 63, par = (i >> 11) & 1, dist = i >> 12, hi = lane >> 5, r32 = lane & 31;
        const int kv = ((r & 3) + 8 * ((r & 15) >> 2) + 4 * hi) + 32 * (r >> 4), rel = r32 + 32 * par - kv + 64 * dist;
        const float v = (dist == 3) ? tb[256] : tb[min(rel, 128) + 128];
        bt[(((dist * 2 + par) * 8 + (r >> 2)) * 64 + lane) * 4 + (r & 3)] = v * 8.0f;
    }
}
__device__ __forceinline__ void attn_tile(const LAS unsigned char* Kb, const LAS unsigned char* Vb, const LAS f32x4* bp, const bf16x8 (&qr)[4], f32x16 (&o)[2], float& m, float& l, int r32, int hi) {
    const float C2 = 0.125f * LOG2E;
    f32x16 p0, p1;
#pragma unroll
    for (int j = 0; j < 4; ++j) { const f32x4 t0 = bp[j * 64], t1 = bp[(4 + j) * 64];
        p0[4 * j] = t0[0]; p0[4 * j + 1] = t0[1]; p0[4 * j + 2] = t0[2]; p0[4 * j + 3] = t0[3]; p1[4 * j] = t1[0]; p1[4 * j + 1] = t1[1]; p1[4 * j + 2] = t1[2]; p1[4 * j + 3] = t1[3]; }
#pragma unroll
    for (int d0 = 0; d0 < 4; ++d0) {
        const bf16x8 a0 = *(const LAS bf16x8*)(Kb + r32 * 144 + d0 * 32 + hi * 16);
        const bf16x8 a1 = *(const LAS bf16x8*)(Kb + (32 + r32) * 144 + d0 * 32 + hi * 16);
        p0 = __builtin_amdgcn_mfma_f32_32x32x16_bf16(a0, qr[d0], p0, 0, 0, 0);
        p1 = __builtin_amdgcn_mfma_f32_32x32x16_bf16(a1, qr[d0], p1, 0, 0, 0);
    }
    float mx = fmaxf(p0[0], p1[0]);
#pragma unroll
    for (int r = 1; r < 16; ++r) mx = fmaxf(mx, fmaxf(p0[r], p1[r]));
    mx = fmaxf(mx, __shfl_xor(mx, 32)) * C2;
    if (__any(mx > m + 8.0f)) {
        const float mn = fmaxf(m, mx), scl = __builtin_amdgcn_exp2f(m - mn); m = mn; l *= scl;
#pragma unroll
        for (int r = 0; r < 16; ++r) { o[0][r] *= scl; o[1][r] *= scl; }
    }
    float ls = 0.f; const float nm = -m;
#pragma unroll
    for (int r = 0; r < 16; ++r) { p0[r] = __builtin_amdgcn_exp2f(p0[r] * C2 + nm); p1[r] = __builtin_amdgcn_exp2f(p1[r] * C2 + nm); ls += p0[r] + p1[r]; }
    l += ls;
    u32x4 pw[4];
#pragma unroll
    for (int s = 0; s < 2; ++s) {
        pw[s] = (u32x4){pk2(p0[8 * s], p0[8 * s + 1]), pk2(p0[8 * s + 2], p0[8 * s + 3]), pk2(p0[8 * s + 4], p0[8 * s + 5]), pk2(p0[8 * s + 6], p0[8 * s + 7])};
        pw[2 + s] = (u32x4){pk2(p1[8 * s], p1[8 * s + 1]), pk2(p1[8 * s + 2], p1[8 * s + 3]), pk2(p1[8 * s + 4], p1[8 * s + 5]), pk2(p1[8 * s + 6], p1[8 * s + 7])};
    }
#pragma unroll
    for (int dh = 0; dh < 2; ++dh)
#pragma unroll
        for (int ks = 0; ks < 4; ++ks) {
            const bf16x8 vf = *(const LAS bf16x8*)(Vb + (32 * dh + r32) * 144 + (16 * ks + 8 * hi) * 2);
            o[dh] = __builtin_amdgcn_mfma_f32_32x32x16_bf16(vf, __builtin_bit_cast(bf16x8, pw[ks]), o[dh], 0, 0, 0);
        }
}
__device__ __forceinline__ void attn_prompt_unit(const Params& P, LAS unsigned char* lds, int li, int b, int h, int g4, const int tid) {
    const int lane = tid & 63, wid = __builtin_amdgcn_readfirstlane(tid >> 6), r32 = lane & 31, hi = lane >> 5;
    const bf16_t* QKV = (const bf16_t*)(P.ws + WS_R1); bf16_t* MIX = (bf16_t*)(P.ws + WS_MIX);
    const int cw = 4 * g4 + (wid >> 1);
    const size_t qrow = (size_t)b * SEQ + 256 * g4 + 32 * wid + r32;
    bf16x8 qr[4];
#pragma unroll
    for (int d0 = 0; d0 < 4; ++d0) qr[d0] = *(const bf16x8*)(QKV + qrow * NQKV + h * 64 + d0 * 16 + hi * 8);
    const int kt_lo = max(0, 4 * g4 - 8), kt_hi = 4 * g4 + 3;
    const int srow = tid & 63, sch = tid >> 6;
    const bf16_t* kvsrc = QKV + ((size_t)b * SEQ + srow) * NQKV + 1024 + h * 64 + 8 * sch;
    const int vp = vpos(srow);
    bf16x8 kA, vA, kB, vB;
#define AT_LOAD(K_, V_, kt) do { const bf16_t* s_ = kvsrc + (size_t)(kt) * 64 * NQKV; K_ = *(const bf16x8*)s_; V_ = *(const bf16x8*)(s_ + 1024); } while (0)
#define AT_STORE(K_, V_, buf) do { *(LAS bf16x8*)(lds + AT_KOFF + (buf) * 9216 + srow * 144 + sch * 16) = K_; \
        _Pragma("unroll") for (int j_ = 0; j_ < 8; ++j_) *(LAS short*)(lds + AT_VOFF + (buf) * 9216 + (8 * sch + j_) * 144 + vp * 2) = V_[j_]; } while (0)
    AT_LOAD(kA, vA, kt_lo); AT_LOAD(kB, vB, kt_lo + 1);
    AT_STORE(kA, vA, 0);
    LDS_BARRIER();
    float m = -1e30f, l = 0.f; f32x16 o[2];
#pragma unroll
    for (int r = 0; r < 16; ++r) { o[0][r] = 0.f; o[1][r] = 0.f; }
    const LAS f32x4* btl = (const LAS f32x4*)(lds + AT_BIAS) + (wid & 1) * 512 + lane;
    for (int kt = kt_lo; kt <= kt_hi; kt += 2) {
        if (kt + 2 <= kt_hi) AT_LOAD(kA, vA, kt + 2);
        if (kt >= cw - 8 && kt <= cw) attn_tile(lds + AT_KOFF, lds + AT_VOFF, btl + min(cw - kt, 3) * 1024, qr, o, m, l, r32, hi);
        AT_STORE(kB, vB, 1);
        LDS_BARRIER();
        if (kt + 3 <= kt_hi) AT_LOAD(kB, vB, kt + 3);
        if (kt + 1 >= cw - 8 && kt + 1 <= cw) attn_tile(lds + AT_KOFF + 9216, lds + AT_VOFF + 9216, btl + min(cw - kt - 1, 3) * 1024, qr, o, m, l, r32, hi);
        if (kt + 2 <= kt_hi) AT_STORE(kA, vA, 0);
        LDS_BARRIER();
    }
#undef AT_LOAD
#undef AT_STORE
    l += __shfl_xor(l, 32);
    const float rl = 1.0f / l;
    bf16_t* op = MIX + qrow * DM + h * 64;
#pragma unroll
    for (int dh = 0; dh < 2; ++dh)
#pragma unroll
        for (int r4 = 0; r4 < 4; ++r4) {
            u32x2 w; w.x = pk2(o[dh][4 * r4] * rl, o[dh][4 * r4 + 1] * rl); w.y = pk2(o[dh][4 * r4 + 2] * rl, o[dh][4 * r4 + 3] * rl);
            *(u32x2*)(op + 32 * dh + 8 * r4 + 4 * hi) = w;
        }
}
__device__ __forceinline__ void attn_sample_unit(const Params& P, LAS unsigned char* lds, int li, int b, int h, const int tid) {
    const int lane = tid & 63, wid = tid >> 6;
    const bf16_t* QKV = (const bf16_t*)(P.ws + WS_R1); bf16_t* MIX = (bf16_t*)(P.ws + WS_MIX);
    LAS float* qs = (LAS float*)lds;
    LAS float* sc = qs + 1024;
    LAS float* tab = sc + 16 * 528;
    const size_t rb = (size_t)TP + b * SSEQ;
    for (int i = tid; i < 1024; i += 512) qs[i] = bf2f(QKV[(rb + (i >> 6)) * NQKV + h * 64 + (i & 63)]);
    if (tid < 257) tab[tid] = P.in[19][(size_t)(li * 16 + h) * 257 + tid];
    __syncthreads();
    const float* kc = P.in[5] + ((size_t)(li * 8 + b) * 512) * 1024 + h * 64;
    const float* vc = P.in[6] + ((size_t)(li * 8 + b) * 512) * 1024 + h * 64;
    for (int j = tid; j < 528; j += 512) {
        float kr[64];
        if (j < 512) {
#pragma unroll
            for (int d = 0; d < 16; ++d) { const f32x4 t = *(const f32x4*)(kc + (size_t)j * 1024 + 4 * d); kr[4 * d] = t[0]; kr[4 * d + 1] = t[1]; kr[4 * d + 2] = t[2]; kr[4 * d + 3] = t[3]; }
        } else {
#pragma unroll
            for (int d = 0; d < 64; ++d) kr[d] = bf2f(QKV[(rb + (j - 512)) * NQKV + 1024 + h * 64 + d]);
        }
        for (int q = 0; q < 16; ++q) {
            float s = 0.f;
#pragma unroll
            for (int d = 0; d < 64; ++d) s += qs[q * 64 + d] * kr[d];
            const int rel = (j < 512) ? (512 + q - j) : (q - (j - 512));
            sc[q * 528 + j] = s * 0.125f + tab[min(max(rel, -128), 128) + 128];
        }
    }
    __syncthreads();
    for (int q = 2 * wid; q < 2 * wid + 2; ++q) {
        float mx = -1e30f;
        for (int j = lane; j < 528; j += 64) mx = fmaxf(mx, sc[q * 528 + j]);
#pragma unroll
        for (int o = 1; o < 64; o <<= 1) mx = fmaxf(mx, __shfl_xor(mx, o));
        float sm = 0.f;
        for (int j = lane; j < 528; j += 64) { const float p = __expf(sc[q * 528 + j] - mx); sc[q * 528 + j] = p; sm += p; }
        sm = wave_sum(sm);
        const float inv = 1.0f / sm;
        for (int j = lane; j < 528; j += 64) sc[q * 528 + j] *= inv;
    }
    __syncthreads();
    {
        const int q = tid >> 5, d = 2 * (tid & 31);
        float a0 = 0.f, a1 = 0.f;
        for (int j = 0; j < 512; ++j) { const f32x2 v = *(const f32x2*)(vc + (size_t)j * 1024 + d); const float p = sc[q * 528 + j]; a0 += p * v[0]; a1 += p * v[1]; }
        for (int j = 0; j < 16; ++j) { const bf16_t* vp = QKV + (rb + j) * NQKV + 2048 + h * 64 + d; const float p = sc[q * 528 + 512 + j]; a0 += p * bf2f(vp[0]); a1 += p * bf2f(vp[1]); }
        *(unsigned*)(MIX + (rb + q) * DM + h * 64 + d) = pk2(a0, a1);
    }
    __syncthreads();
}

#define XB_TMO      128
#define XB_XCNT(j)  (256  + 64 * (j))
#define XB_XSUB(j)  (1280 + 64 * (j))
#define XB_XGEN(j)  (2304 + 64 * (j))
#define XB_TOP      3328
#define XB_TOPGEN   3392
#define XCD_BAR_WORDS 3456
#define XB_SPIN_CAP (1u << 20)
__device__ __forceinline__ unsigned xb_ld(unsigned* p)              { return __hip_atomic_load(p, __ATOMIC_RELAXED, __HIP_MEMORY_SCOPE_AGENT); }
__device__ __forceinline__ unsigned xb_add(unsigned* p, unsigned v) { return __hip_atomic_fetch_add(p, v, __ATOMIC_RELAXED, __HIP_MEMORY_SCOPE_AGENT); }
__device__ __forceinline__ unsigned xb_xcc_id() { return (unsigned)__builtin_amdgcn_s_getreg((3 << 11) | 20) & 0xFu; }
#define XB_SPIN(cond, bar) do { unsigned _sp = 0; while (cond) { __builtin_amdgcn_s_sleep(1); \
    if ((++_sp & 255u) == 0u) { if (xb_ld(&(bar)[XB_TMO])) break; if (_sp > XB_SPIN_CAP) { atomicAdd(&(bar)[XB_TMO], 1u); break; } } } } while (0)
struct XcdBarrier { unsigned* bar; unsigned x; volatile LAS unsigned* st; };
__device__ __forceinline__ XcdBarrier xcd_barrier_post(unsigned* bar, volatile LAS unsigned* st) {
    XcdBarrier b; b.bar = bar; b.x = xb_xcc_id(); b.st = st;
    if (threadIdx.x == 0) (void)xb_add(&bar[XB_XCNT(b.x)], 1u);
    return b;
}
__device__ __forceinline__ void xcd_barrier_complete(unsigned* bar, unsigned x, unsigned& nloc, unsigned& nx) {
    const unsigned G = gridDim.x * gridDim.y * gridDim.z;
    unsigned sum, cnt, mine, sp = 0u;
    for (;;) {
        sum = 0u; cnt = 0u; mine = 0u;
#pragma unroll
        for (unsigned j = 0; j < 16; ++j) { const unsigned c = xb_ld(&bar[XB_XCNT(j)]); sum += c; cnt += (c > 0u) ? 1u : 0u; mine = (j == x) ? c : mine; }
        if (sum == G) break;
        __builtin_amdgcn_s_sleep(1);
        if ((++sp & 255u) == 0u) { if (xb_ld(&bar[XB_TMO])) break; if (sp > XB_SPIN_CAP) { atomicAdd(&bar[XB_TMO], 1u); break; } }
    }
    nloc = mine > 0u ? mine : 1u; nx = cnt > 0u ? cnt : 1u;
}
__device__ __forceinline__ void xcd_barrier(const XcdBarrier& b) {
    asm volatile("s_waitcnt vmcnt(0)" ::: "memory");
    __syncthreads();
    if (threadIdx.x == 0) {
        unsigned* bar = b.bar;
        __builtin_amdgcn_s_waitcnt(0);
        unsigned nloc = b.st[0], nx = b.st[1];
        if (nloc == 0u) { xcd_barrier_complete(bar, b.x, nloc, nx); b.st[0] = nloc; b.st[1] = nx; }
        const unsigned old = xb_add(&bar[XB_XSUB(b.x)], 1u);
        const unsigned gen = old / nloc;
        if (old + 1u == (gen + 1u) * nloc) {
            __builtin_amdgcn_fence(__ATOMIC_RELEASE, "agent");
            asm volatile("s_waitcnt vmcnt(0)" ::: "memory");
            const unsigned og = xb_add(&bar[XB_TOP], 1u);
            const unsigned tg = og / nx;
            if (og + 1u == (tg + 1u) * nx) xb_add(&bar[XB_TOPGEN], 1u);
            else XB_SPIN(xb_ld(&bar[XB_TOPGEN]) == tg, bar);
            __builtin_amdgcn_fence(__ATOMIC_ACQUIRE, "agent");
            xb_add(&bar[XB_XGEN(b.x)], 1u);
            asm volatile("s_waitcnt vmcnt(0)" ::: "memory");
        } else {
            XB_SPIN(xb_ld(&bar[XB_XGEN(b.x)]) == gen, bar);
            __builtin_amdgcn_fence(__ATOMIC_ACQUIRE, "agent");
            asm volatile("s_waitcnt vmcnt(0)" ::: "memory");
        }
    }
    __syncthreads();
}

__global__ void __launch_bounds__(512, 2) hybrid_fwd(Params P) {
    extern __shared__ __attribute__((aligned(16))) unsigned char lds_raw[];
    LAS unsigned char* lds = (LAS unsigned char*)lds_raw;
    const int G = gridDim.x;
    volatile LAS unsigned* xst = (volatile LAS unsigned*)(lds + 131072 + 256);
    if (threadIdx.x < 2) xst[threadIdx.x] = 0u;
    __syncthreads();
    XcdBarrier xbar = xcd_barrier_post((unsigned*)(P.ws + WS_CTL), xst);
    int ph = P.ph_lo, rep = 0;
    while (ph < P.ph_hi) {
        int tid = threadIdx.x; asm volatile("" : "+v"(tid));
        int wg = blockIdx.x; asm volatile("" : "+s"(wg));
        const Params& Q = P;
        const int lane = tid & 63, wid = __builtin_amdgcn_readfirstlane(tid >> 6), gw = wg * 8 + wid, ngw = G * 8;
        unsigned char* ws = Q.ws;
        bf16_t* Xb = (bf16_t*)(ws + WS_XB); bf16_t* R1 = (bf16_t*)(ws + WS_R1); bf16_t* MIX = (bf16_t*)(ws + WS_MIX);
        float* GATES = (float*)(ws + WS_GATES); float* SSP = (float*)(ws + WS_SSP);
        int nrep = 1;
        if (ph == 0) nrep = REP_PRO; else if (ph != NPHASE - 1) { const int q_ = (ph - 1) % 11; if (q_ == 1) nrep = REP_MIX; else if (q_ == 7) nrep = REP_ATT; else if (q_ == 0 || q_ == 4 || q_ == 6 || q_ == 9) nrep = REP_PROJ; }
        if (ph == 0) phase_prologue(Q, lds, gw, ngw, wid, lane);
        else if (ph == NPHASE - 1) phase_final(Q, gw, ngw, lane);
        else {
            int layer, sub;
            { const int r_ = ph - 1, pair_ = r_ / 11, q_ = r_ % 11; if (q_ < 6) { layer = 2 * pair_; sub = (q_ < 2) ? q_ : (q_ == 2 ? 5 : q_ - 1); } else { layer = 2 * pair_ + 1; sub = q_ - 6; } }
            const int li = layer >> 1, odd = layer & 1;
            if (sub == 5) phase_fixup(Q, li, gw, ngw, lane);
            else if (sub == 1) {
                if (!odd) {
                    if (G == 256) {
                        if (wg < 128) delta_unit(Q, lds, li, false, wg >> 4, (wg >> 1) & 7, wg & 1, tid);
                        else if (wg < 192) { const int u = wg - 128; gla_unit(Q, lds, li, false, u >> 3, u & 7, tid); }
                        else { const int u = wg - 192; delta_unit(Q, lds, li, true, u >> 3, u & 7, 0, tid); delta_unit(Q, lds, li, true, u >> 3, u & 7, 1, tid); gla_unit(Q, lds, li, true, u >> 3, u & 7, tid);
                            if (layer == 0 && rep == 0) convert_mats(Q, lds, 4, 16, (wg - 192) * 8 + wid, 512, wid, lane); }
                    }
                } else {
                    attn_build_bias(Q, lds, li, (wg >> 1) & 15, tid);
                    for (int u = wg * 8; u < wg * 8 + 8; ++u) attn_prompt_unit(Q, lds, li, u >> 8, (u >> 4) & 15, u & 15, tid);
                    if (wg < 128) attn_sample_unit(Q, lds, li, wg >> 4, wg & 15, tid);
                }
            } else {
                pg8::Gemm g; int mode, Npos;
                g.M = TP;
                LAS unsigned long long* eap = (LAS unsigned long long*)(lds + EA_OFF);
#define EA_SET(i, p) eap[i] = (unsigned long long)(p)
                if (sub == 0) {
                    g.A = Xb; g.K = 1024;
                    if (!odd) { mode = 0; Npos = ABPAD; g.Bt = (const bf16_t*)(ws + WS_WIN + li * SZ_WIN);
                        if (tid == 0) { EA_SET(0, R1); EA_SET(1, SSP); EA_SET(2, GATES); EA_SET(3, Q.out + O_CONVP + (size_t)li * 8 * 3 * DNQKV); EA_SET(4, Q.out + O_CONVS + (size_t)li * 8 * 3 * DNQKV); } }
                    else { mode = 1; Npos = NQKV; g.Bt = (const bf16_t*)(ws + WS_WQKV + li * SZ_WQKV);
                        if (tid == 0) { EA_SET(0, R1); EA_SET(1, SSP); EA_SET(3, Q.out + O_CKP + (size_t)li * 8 * 512 * 1024); EA_SET(4, Q.out + O_CVP + (size_t)li * 8 * 512 * 1024); EA_SET(5, Q.out + O_CKS + (size_t)li * 8 * 16 * 1024); EA_SET(6, Q.out + O_CVS + (size_t)li * 8 * 16 * 1024); } }
                } else if (sub == 2) {
                    mode = 2; Npos = 1024; g.A = MIX; g.K = 1024; g.Bt = (const bf16_t*)(ws + (odd ? WS_WCOUT : WS_WOUT) + li * SZ_W1K);
                    if (tid == 0) { EA_SET(7, (layer == 0) ? Q.in[0] : Q.out); EA_SET(8, (layer == 0) ? Q.in[1] : Q.out + (size_t)TP * DM); EA_SET(9, Q.out); EA_SET(10, Xb); EA_SET(11, SSP); }
                } else if (sub == 3) {
                    mode = 3; Npos = NGU; g.A = Xb; g.K = 1024; g.Bt = (const bf16_t*)(ws + WS_WGU + layer * SZ_WGU);
                    if (tid == 0) { EA_SET(0, R1); EA_SET(1, SSP); }
                } else {
                    mode = 2; Npos = 1024; g.A = R1; g.K = DFF; g.Bt = (const bf16_t*)(ws + WS_WDN + layer * SZ_WDN);
                    if (tid == 0) { EA_SET(7, Q.out); EA_SET(8, Q.out + (size_t)TP * DM); EA_SET(9, Q.out); EA_SET(10, Xb); EA_SET(11, SSP); }
                }
#undef EA_SET
                g.N = Npos;
                __syncthreads();
                pg8::StaticOrder S; S.init(TP, Npos, G, wg);
                if (mode == 0) { small_gemm<0>(g.A, g.Bt, Npos, g.K, eap, lds, wg, G, wid, lane); Epi<0> E{eap}; pg8::gemm_phase<Epi<0>, true, true>(lds, g, S, E, tid); }
                else if (mode == 1) { small_gemm<1>(g.A, g.Bt, Npos, g.K, eap, lds, wg, G, wid, lane); Epi<1> E{eap}; pg8::gemm_phase<Epi<1>, true, true>(lds, g, S, E, tid); }
                else if (mode == 2) { small_gemm<2>(g.A, g.Bt, Npos, g.K, eap, lds, wg, G, wid, lane); Epi<2> E{eap}; pg8::gemm_phase<Epi<2>, true, true>(lds, g, S, E, tid); }
                else { small_gemm<3>(g.A, g.Bt, Npos, g.K, eap, lds, wg, G, wid, lane); Epi<3> E{eap}; pg8::gemm_phase<Epi<3>, true, true>(lds, g, S, E, tid); }
            }
        }
        if (++rep >= nrep) { rep = 0; ++ph; }
        if (ph < P.ph_hi) { if (ph == 1 && rep == 0) cg::this_grid().sync(); else xcd_barrier(xbar); }
    }
}

extern "C" void kernel_launch(void* const* d_in, const int* in_sizes, int n_in, void* d_out, int out_size, void* d_ws, size_t ws_size, hipStream_t stream) {
    static int grid = 0;
    if (grid == 0) {
        if (n_in != 25 || (size_t)out_size != O_END || ws_size < WS_END) { fprintf(stderr, "kernel_launch: unexpected sizes n_in %d out %d ws %zu (need %zu)\n", n_in, out_size, ws_size, (size_t)WS_END); grid = -1; return; }
        if (hipFuncSetAttribute((const void*)hybrid_fwd, hipFuncAttributeMaxDynamicSharedMemorySize, LDS_BYTES) != hipSuccess) { fprintf(stderr, "kernel_launch: hipFuncSetAttribute failed\n"); grid = -1; return; }
        int dev = 0, cus = 0, per_cu = 0;
        hipGetDevice(&dev); hipDeviceGetAttribute(&cus, hipDeviceAttributeMultiprocessorCount, dev);
        hipOccupancyMaxActiveBlocksPerMultiprocessor(&per_cu, (const void*)hybrid_fwd, 512, LDS_BYTES);
        (void)hipGetLastError();
        if (cus != 256 || per_cu < 1) fprintf(stderr, "kernel_launch: note: cus %d per_cu %d\n", cus, per_cu);
        grid = 256;
    }
    if (grid < 0) return;
    Params p{};
    for (int i = 0; i < 25; ++i) p.in[i] = (const float*)d_in[i];
    p.out = (float*)d_out; p.ws = (unsigned char*)d_ws;
#if MK_MULTI
    for (int ph = 0; ph < NPHASE; ++ph) { p.ph_lo = ph; p.ph_hi = ph + 1; hipLaunchKernelGGL(hybrid_fwd, dim3(grid), dim3(512), LDS_BYTES, stream, p); }
#else
    (void)hipMemsetAsync((char*)d_ws + WS_CTL, 0, CTL_BYTES, stream);
    p.ph_lo = 0; p.ph_hi = NPHASE;
    void* args[] = {&p};
    hipError_t e = hipLaunchCooperativeKernel((const void*)hybrid_fwd, dim3(grid), dim3(512), args, LDS_BYTES, stream);
    if (e != hipSuccess) fprintf(stderr, "cooperative launch failed: %s\n", hipGetErrorString(e));
#endif
}
```

```cpp
#include <hip/hip_runtime.h>
#include <hip/hip_cooperative_groups.h>
#include <cstdio>
#include <cstdint>
namespace cg = cooperative_groups;

#ifndef MK_MULTI
#define MK_MULTI 0
#endif

#ifndef REP_MIX
#define REP_MIX 1
#endif
#ifndef REP_ATT
#define REP_ATT 1
#endif
#ifndef REP_PRO
#define REP_PRO 1
#endif
#ifndef REP_PROJ
#define REP_PROJ 1
#endif
#define LAS __attribute__((address_space(3)))
#define GAS __attribute__((address_space(1)))
typedef unsigned short bf16_t;
typedef short bf16x8 __attribute__((ext_vector_type(8)));
typedef float f32x2 __attribute__((ext_vector_type(2)));
typedef float f32x4 __attribute__((ext_vector_type(4)));
typedef float f32x16 __attribute__((ext_vector_type(16)));
typedef unsigned u32x2 __attribute__((ext_vector_type(2)));
typedef unsigned u32x4 __attribute__((ext_vector_type(4)));

constexpr int DM = 1024, NB = 8, SEQ = 4096, SB = 8, SSEQ = 16, PAST = 2048;
constexpr int TP = NB * SEQ;
constexpr int TS = SB * SSEQ;
constexpr int TR = TP + TS;
constexpr int ABIN = 3616, ABPAD = 3840, DFF = 2816, NGU = 5632, NQKV = 3072, DNQKV = 1536;
constexpr float EPS = 1e-6f;
constexpr float LOG2E = 1.4426950408889634f;

constexpr size_t O_Y = 0;
constexpr size_t O_CONVP = (size_t)TR * DM;
constexpr size_t O_CONVS = O_CONVP + 2 * 8 * 3 * 1536;
constexpr size_t O_DNP = O_CONVS + 2 * 8 * 3 * 1536;
constexpr size_t O_DNS = O_DNP + 2 * 8 * 8 * 64 * 64;
constexpr size_t O_GLAP = O_DNS + 2 * 8 * 8 * 64 * 64;
constexpr size_t O_GLAS = O_GLAP + 2 * 8 * 8 * 32 * 64;
constexpr size_t O_CKP = O_GLAS + 2 * 8 * 8 * 32 * 64;
constexpr size_t O_CKS = O_CKP + (size_t)2 * 8 * 512 * 1024;
constexpr size_t O_CVP = O_CKS + 2 * 8 * 16 * 1024;
constexpr size_t O_CVS = O_CVP + (size_t)2 * 8 * 512 * 1024;
constexpr size_t O_END = O_CVS + 2 * 8 * 16 * 1024;

constexpr size_t SZ_WIN = (size_t)ABPAD * 1024 * 2, SZ_W1K = (size_t)1024 * 1024 * 2, SZ_WQKV = (size_t)NQKV * 1024 * 2, SZ_WGU = (size_t)NGU * 1024 * 2, SZ_WDN = (size_t)1024 * DFF * 2;
constexpr size_t WS_WIN = 0;
constexpr size_t WS_WOUT = WS_WIN + 2 * SZ_WIN;
constexpr size_t WS_WQKV = WS_WOUT + 2 * SZ_W1K;
constexpr size_t WS_WCOUT = WS_WQKV + 2 * SZ_WQKV;
constexpr size_t WS_WGU = WS_WCOUT + 2 * SZ_W1K;
constexpr size_t WS_WDN = WS_WGU + 4 * SZ_WGU;
constexpr size_t WS_XB = WS_WDN + 4 * SZ_WDN;
constexpr size_t WS_R1 = WS_XB + (size_t)TR * 1024 * 2;
constexpr size_t WS_MIX = WS_R1 + (size_t)TR * ABIN * 2;
constexpr size_t WS_GATES = WS_MIX + (size_t)TR * 1024 * 2;
constexpr size_t WS_SSP = WS_GATES + (size_t)TR * 32 * 4;
constexpr size_t WS_CTL = WS_SSP + (size_t)TR * 16 * 4;
constexpr size_t CTL_BYTES = 16384;
constexpr size_t WS_END = WS_CTL + CTL_BYTES;

constexpr int LDS_BYTES = 147456;
constexpr int NPHASE = 24;

struct Params { const float* in[25]; float* out; unsigned char* ws; int ph_lo, ph_hi; };

__device__ __forceinline__ unsigned f2bf(float f) { unsigned u = __builtin_bit_cast(unsigned, f); return (u + 0x7fffu + ((u >> 16) & 1u)) >> 16; }
typedef __bf16 hwbf16x2 __attribute__((ext_vector_type(2)));
__device__ __forceinline__ unsigned pk2(float lo, float hi) { const f32x2 v = {lo, hi}; return __builtin_bit_cast(unsigned, __builtin_convertvector(v, hwbf16x2)); }
__device__ __forceinline__ float bf2f(bf16_t b) { return __builtin_bit_cast(float, ((unsigned)b) << 16); }
template <int CTRL> __device__ __forceinline__ float dppf(float v) { return __builtin_bit_cast(float, __builtin_amdgcn_update_dpp(0, __builtin_bit_cast(int, v), CTRL, 0xF, 0xF, true)); }
__device__ __forceinline__ float quad_sum(float v) { v += dppf<0xB1>(v); v += dppf<0x4E>(v); return v; }
__device__ __forceinline__ float oct_sum(float v) { v = quad_sum(v); v += dppf<0x141>(v); return v; }
__device__ __forceinline__ float wave_sum(float v) {
    v = oct_sum(v); v += dppf<0x140>(v);
    const int i = __builtin_bit_cast(int, v);
    return (__builtin_bit_cast(float, __builtin_amdgcn_readlane(i, 0)) + __builtin_bit_cast(float, __builtin_amdgcn_readlane(i, 16))) +
           (__builtin_bit_cast(float, __builtin_amdgcn_readlane(i, 32)) + __builtin_bit_cast(float, __builtin_amdgcn_readlane(i, 48)));
}
__device__ __forceinline__ float fast_rcp(float x) { return __builtin_amdgcn_rcpf(x); }
__device__ __forceinline__ float silu_f(float x) { return x * fast_rcp(1.0f + __expf(-x)); }
__device__ __forceinline__ float sigmoid_f(float x) { return fast_rcp(1.0f + __expf(-x)); }
__device__ __forceinline__ float softplus_f(float x) { return fmaxf(x, 0.f) + __logf(1.0f + __expf(-fabsf(x))); }

namespace pg8 {
constexpr int BM = 256, BK = 64, HALF = 128, HTB = HALF * BK * 2, STAGE_BYTES = 8 * HTB, NXCD = 8, WGM = 8;
__host__ __device__ __forceinline__ int lds_byte(int r, int c) { const int st = (r >> 4) * 2 + (c >> 5), rr = r & 15, cc = c & 31, ob = rr * 64 + cc * 2; return st * 1024 + (ob ^ (((ob >> 9) & 1) << 5)); }
__host__ __device__ __forceinline__ void stage_rc(int b, int& R, int& C) { const int st = b / 1024, sb = b % 1024, swz = sb ^ (((sb >> 9) & 1) << 5); R = (st >> 1) * 16 + swz / 64; C = (st & 1) * 32 + (swz % 64) / 2; }
__host__ __device__ __forceinline__ int perm32(int rho) { const int n = rho >> 4, i = rho & 15; return 8 * (i >> 2) + 4 * n + (i & 3); }
struct Unit { int pm, pn; };
struct Gemm { const bf16_t* A; const bf16_t* Bt; int M, N, K; };
struct StaticOrder {
    int nM, nN, nwg, G, c;
    __host__ __device__ void init(int M, int N, int G_, int c_) { nM = M / BM; nN = N / BM; nwg = nM * nN; G = G_; c = c_; }
    __host__ __device__ bool next(int i, Unit& u) const {
        const long L = (long)i * G + c; if (L >= nwg) return false;
        int wgid = (int)L; { const int q = nwg / NXCD, r = nwg % NXCD, xcd = wgid % NXCD, off = wgid / NXCD; wgid = (xcd < r ? xcd * (q + 1) : r * (q + 1) + (xcd - r) * q) + off; }
        const int nig = WGM * nN, gid = wgid / nig, fm = gid * WGM, gsz = (nM - fm) < WGM ? (nM - fm) : WGM;
        u.pm = fm + ((wgid % nig) % gsz); u.pn = (wgid % nig) / gsz; return true;
    }
};

template <class Epi, bool ALIGN_EPI, bool SP2>
__device__ __forceinline__ void gemm_phase(LAS unsigned char* lds, const Gemm g, const StaticOrder& S, const Epi& E, const int tid) {
    const int wid = __builtin_amdgcn_readfirstlane(tid >> 6), lane = tid & 63, wr = wid >> 2, wc = wid & 3, fr = lane & 15, fq = lane >> 4;
    const int K = g.K, nt = K / BK;
    unsigned voffA[2], voffB[2];
#pragma unroll
    for (int i = 0; i < 2; ++i) { int R, C; stage_rc(tid * 16 + i * 8192, R, C); voffA[i] = (unsigned)(R * K + C) * 2u; voffB[i] = (unsigned)(R * K + C) * 2u; }
    const size_t kstep = (size_t)(BK * 2);
    const size_t hstep = (size_t)HALF * K * 2;
    const size_t tstep = 2 * hstep;
    const unsigned ldsw = (unsigned)wid * 1024u;
    const int aoff = lds_byte(wr * 64 + fr, fq * 8), boff = lds_byte(wc * 32 + fr, fq * 8);
#define PG8_SA(b, h) (((b) * 2 + (h)) * HTB)
#define PG8_SB(b, h) ((4 + (b) * 2 + (h)) * HTB)
#define PG8_STAGE(bufoff, gbase, voff) do { _Pragma("unroll") for (int _i = 0; _i < 2; ++_i) \
        __builtin_amdgcn_global_load_lds((const unsigned*)((const char*)(gbase) + (voff)[_i]), (LAS unsigned*)(lds + (bufoff) + ldsw + _i * 8192), 16, 0, 0); } while (0)
#define PG8_LDA(dst, b, h) do { _Pragma("unroll") for (int m = 0; m < 4; ++m) _Pragma("unroll") for (int k = 0; k < 2; ++k) dst[m][k] = *(const LAS bf16x8*)(lds + PG8_SA(b, h) + aoff + m * 2048 + k * 1024); } while (0)
#define PG8_LDB(dst, b, h) do { _Pragma("unroll") for (int n = 0; n < 2; ++n) _Pragma("unroll") for (int k = 0; k < 2; ++k) dst[n][k] = *(const LAS bf16x8*)(lds + PG8_SB(b, h) + boff + n * 2048 + k * 1024); } while (0)
#define PG8_MMA(ai, bj, At, Bt) do { __builtin_amdgcn_s_setprio(1); _Pragma("unroll") for (int m = 0; m < 4; ++m) _Pragma("unroll") for (int n = 0; n < 2; ++n) _Pragma("unroll") for (int k = 0; k < 2; ++k) \
        acc[ai][bj][m][n] = __builtin_amdgcn_mfma_f32_16x16x32_bf16(Bt[n][k], At[m][k], acc[ai][bj][m][n], 0, 0, 0); __builtin_amdgcn_s_setprio(0); } while (0)
#define PG8_WAIT_V(n) asm volatile("s_waitcnt vmcnt(" #n ")" ::: "memory")
#define PG8_WAIT_L(n) asm volatile("s_waitcnt lgkmcnt(" #n ")" ::: "memory")
#define PG8_BAR __builtin_amdgcn_s_barrier()
#define PG8_SCHED __builtin_amdgcn_sched_barrier(0)
    Unit cur, nxt; int ui = 0;
    if (!S.next(0, cur)) return;
    f32x4 acc[2][2][4][2];
#pragma unroll
    for (int a = 0; a < 2; ++a)
#pragma unroll
        for (int b = 0; b < 2; ++b)
#pragma unroll
            for (int m = 0; m < 4; ++m)
#pragma unroll
                for (int n = 0; n < 2; ++n) acc[a][b][m][n] = (f32x4){0.f, 0.f, 0.f, 0.f};
    bf16x8 At[4][2], B0[2][2], B1[2][2];
    const char* cA = (const char*)g.A + (size_t)cur.pm * tstep; const char* cB = (const char*)g.Bt + (size_t)cur.pn * tstep;
    if constexpr (SP2) {
        PG8_STAGE(PG8_SB(0, 0), cB, voffB); PG8_STAGE(PG8_SB(0, 1), cB + hstep, voffB); PG8_STAGE(PG8_SA(0, 0), cA, voffA); PG8_STAGE(PG8_SA(0, 1), cA + hstep, voffA);
        if (wr == 1) PG8_BAR;
        PG8_WAIT_V(2); PG8_BAR;
        PG8_STAGE(PG8_SB(1, 0), cB + kstep, voffB); PG8_STAGE(PG8_SA(1, 0), cA + kstep, voffA); PG8_STAGE(PG8_SB(1, 1), cB + hstep + kstep, voffB);
        PG8_WAIT_V(6); PG8_BAR;
    } else {
        PG8_STAGE(PG8_SB(0, 0), cB, voffB); PG8_STAGE(PG8_SA(0, 0), cA, voffA); PG8_STAGE(PG8_SB(0, 1), cB + hstep, voffB); PG8_STAGE(PG8_SA(0, 1), cA + hstep, voffA);
        if (wr == 1) PG8_BAR;
        PG8_WAIT_V(4); PG8_BAR;
        PG8_STAGE(PG8_SB(1, 0), cB + kstep, voffB); PG8_STAGE(PG8_SA(1, 0), cA + kstep, voffA); PG8_STAGE(PG8_SB(1, 1), cB + hstep + kstep, voffB);
        PG8_WAIT_V(6); PG8_BAR;
    }
    for (;;) {
        const bool has_next = S.next(ui + 1, nxt);
        const char* nA = has_next ? (const char*)g.A + (size_t)nxt.pm * tstep : cA; const char* nB = has_next ? (const char*)g.Bt + (size_t)nxt.pn * tstep : cB;
        for (int t = 0; t < nt; t += 2) {
            const bool last = (t == nt - 2);
            const char* a1 = cA + (size_t)(t + 1) * kstep;
            const char* a2 = last ? nA : cA + (size_t)(t + 2) * kstep; const char* b2 = last ? nB : cB + (size_t)(t + 2) * kstep;
            const char* a3 = a2 + kstep; const char* b3 = b2 + kstep;
            if constexpr (SP2) {
            PG8_LDB(B0, 0, 0); PG8_LDB(B1, 0, 1); PG8_SCHED; PG8_LDA(At, 0, 0); PG8_STAGE(PG8_SA(1, 1), a1 + hstep, voffA);
            PG8_WAIT_V(8); PG8_WAIT_L(0); PG8_BAR; PG8_MMA(0, 0, At, B0); PG8_MMA(0, 1, At, B1); PG8_BAR; PG8_SCHED;
            PG8_LDA(At, 0, 1); PG8_STAGE(PG8_SB(0, 0), b2, voffB); PG8_STAGE(PG8_SB(0, 1), b2 + hstep, voffB); PG8_STAGE(PG8_SA(0, 0), a2, voffA);
            PG8_WAIT_V(8); PG8_WAIT_L(0); PG8_BAR; PG8_MMA(1, 0, At, B0); PG8_MMA(1, 1, At, B1); PG8_BAR; PG8_SCHED;
            PG8_LDB(B0, 1, 0); PG8_LDB(B1, 1, 1); PG8_SCHED; PG8_LDA(At, 1, 0); PG8_STAGE(PG8_SA(0, 1), a2 + hstep, voffA);
            PG8_WAIT_V(8); PG8_WAIT_L(0); PG8_BAR; PG8_MMA(0, 0, At, B0); PG8_MMA(0, 1, At, B1); PG8_BAR; PG8_SCHED;
            PG8_LDA(At, 1, 1); PG8_STAGE(PG8_SB(1, 0), b3, voffB); PG8_STAGE(PG8_SB(1, 1), b3 + hstep, voffB); PG8_STAGE(PG8_SA(1, 0), a3, voffA);
            PG8_WAIT_V(8); PG8_WAIT_L(0); PG8_BAR; PG8_MMA(1, 0, At, B0); PG8_MMA(1, 1, At, B1); PG8_BAR; PG8_SCHED;
            } else {
            PG8_LDB(B0, 0, 0); PG8_SCHED; PG8_LDA(At, 0, 0); PG8_STAGE(PG8_SA(1, 1), a1 + hstep, voffA);
            PG8_WAIT_L(8); PG8_BAR; PG8_WAIT_L(0); PG8_MMA(0, 0, At, B0); PG8_BAR; PG8_SCHED;
            PG8_LDB(B1, 0, 1); PG8_STAGE(PG8_SB(0, 0), b2, voffB);
            PG8_BAR; PG8_WAIT_L(0); PG8_MMA(0, 1, At, B1); PG8_BAR;
            PG8_LDA(At, 0, 1); PG8_STAGE(PG8_SA(0, 0), a2, voffA);
            PG8_BAR; PG8_WAIT_L(0); PG8_MMA(1, 0, At, B0); PG8_BAR; PG8_SCHED;
            PG8_STAGE(PG8_SB(0, 1), b2 + hstep, voffB);
            PG8_WAIT_V(6); PG8_BAR; PG8_MMA(1, 1, At, B1); PG8_BAR;
            PG8_LDB(B0, 1, 0); PG8_SCHED; PG8_LDA(At, 1, 0); PG8_STAGE(PG8_SA(0, 1), a2 + hstep, voffA);
            PG8_WAIT_L(8); PG8_BAR; PG8_WAIT_L(0); PG8_MMA(0, 0, At, B0); PG8_BAR; PG8_SCHED;
            PG8_LDB(B1, 1, 1); PG8_STAGE(PG8_SB(1, 0), b3, voffB);
            PG8_BAR; PG8_WAIT_L(0); PG8_MMA(0, 1, At, B1); PG8_BAR;
            PG8_LDA(At, 1, 1); PG8_STAGE(PG8_SA(1, 0), a3, voffA);
            PG8_BAR; PG8_WAIT_L(0); PG8_MMA(1, 0, At, B0); PG8_BAR; PG8_SCHED;
            PG8_STAGE(PG8_SB(1, 1), b3 + hstep, voffB);
            PG8_WAIT_V(6); PG8_BAR; PG8_MMA(1, 1, At, B1); PG8_BAR;
            }
        }
        if constexpr (ALIGN_EPI) { if (wr == 0) PG8_BAR; }
        E(acc, cur, wr, wc, fr, fq);
        if (!has_next) break;
#pragma unroll
        for (int a = 0; a < 2; ++a)
#pragma unroll
            for (int b = 0; b < 2; ++b)
#pragma unroll
                for (int m = 0; m < 4; ++m)
#pragma unroll
                    for (int n = 0; n < 2; ++n) acc[a][b][m][n] = (f32x4){0.f, 0.f, 0.f, 0.f};
        cur = nxt; cA = nA; cB = nB; ++ui;
        if constexpr (ALIGN_EPI) { if (wr == 1) PG8_BAR; }
    }
    PG8_WAIT_V(0);
    if constexpr (!ALIGN_EPI) { if (wr == 0) PG8_BAR; }
    PG8_BAR;
#undef PG8_SA
#undef PG8_SB
#undef PG8_STAGE
#undef PG8_LDA
#undef PG8_LDB
#undef PG8_MMA
#undef PG8_WAIT_V
#undef PG8_WAIT_L
#undef PG8_BAR
#undef PG8_SCHED
}
}

struct EpiArgs {
    GAS bf16_t* out; const GAS float* ssp; GAS float* gates; GAS float* o0; GAS float* o1; GAS float* o2; GAS float* o3;
    const GAS float* base_p; const GAS float* base_s; GAS float* X; GAS bf16_t* Xb; GAS float* ssp_out;
};
__device__ __forceinline__ float row_rstd(const GAS float* ssp, int row) {
    const GAS f32x4* p = (const GAS f32x4*)(ssp + (size_t)row * 16);
    const f32x4 a = p[0], b = p[1], c = p[2], d = p[3];
    const float s = ((a[0] + a[1]) + (a[2] + a[3])) + ((b[0] + b[1]) + (b[2] + b[3])) + ((c[0] + c[1]) + (c[2] + c[3])) + ((d[0] + d[1]) + (d[2] + d[3]));
    return rsqrtf(s * (1.0f / 1024.0f) + EPS);
}
template <int MODE, bool SMALL>
__device__ __forceinline__ float epi_apply(const EpiArgs& a, int row, int g32, int fq, f32x4 v0, f32x4 v1, float rstd) {
    const int c0 = 32 * g32 + 8 * fq;
    if constexpr (MODE == 0) {
        if (g32 >= ABIN / 32) return 0.f;
        v0 *= rstd; v1 *= rstd;
        u32x4 w; w.x = pk2(v0[0], v0[1]); w.y = pk2(v0[2], v0[3]); w.z = pk2(v1[0], v1[1]); w.w = pk2(v1[2], v1[3]);
        *(GAS u32x4*)(a.out + (size_t)row * ABIN + c0) = w;
        if (g32 == 48 && fq < 2) { GAS float* gp = a.gates + (size_t)row * 32 + 8 * fq; *(GAS f32x4*)gp = v0; *(GAS f32x4*)(gp + 4) = v1; }
        if (g32 == 96 && fq >= 2) { GAS float* gp = a.gates + (size_t)row * 32 + 16 + 8 * (fq - 2); *(GAS f32x4*)gp = v0; *(GAS f32x4*)(gp + 4) = v1; }
        if (c0 < DNQKV) {
            if constexpr (!SMALL) { const int t = row & (SEQ - 1), b = row >> 12; if (t >= SEQ - 3) { GAS float* d = a.o0 + (size_t)(b * 3 + (t - (SEQ - 3))) * DNQKV + c0; *(GAS f32x4*)d = v0; *(GAS f32x4*)(d + 4) = v1; } }
            else { const int r = row - TP, t = r & 15, b = r >> 4; if (t >= SSEQ - 3) { GAS float* d = a.o1 + (size_t)(b * 3 + (t - (SSEQ - 3))) * DNQKV + c0; *(GAS f32x4*)d = v0; *(GAS f32x4*)(d + 4) = v1; } }
        }
        return 0.f;
    } else if constexpr (MODE == 1) {
        v0 *= rstd; v1 *= rstd;
        u32x4 w; w.x = pk2(v0[0], v0[1]); w.y = pk2(v0[2], v0[3]); w.z = pk2(v1[0], v1[1]); w.w = pk2(v1[2], v1[3]);
        *(GAS u32x4*)(a.out + (size_t)row * NQKV + c0) = w;
        if (c0 >= 1024) {
            const int isv = c0 >= 2048, cc = c0 - 1024 - 1024 * isv;
            if constexpr (!SMALL) { const int t = row & (SEQ - 1), b = row >> 12; if (t >= SEQ - 512) { GAS float* d = a.o0 + (size_t)isv * (O_CVP - O_CKP) + (size_t)(b * 512 + (t - (SEQ - 512))) * 1024 + cc; *(GAS f32x4*)d = v0; *(GAS f32x4*)(d + 4) = v1; } }
            else { const int r = row - TP; GAS float* d = a.o2 + (size_t)isv * (O_CVS - O_CKS) + (size_t)r * 1024 + cc; *(GAS f32x4*)d = v0; *(GAS f32x4*)(d + 4) = v1; }
        }
        return 0.f;
    } else if constexpr (MODE == 2) {
        const GAS float* bp = SMALL ? a.base_s + (size_t)(row - TP) * DM + c0 : a.base_p + (size_t)row * DM + c0;
        const f32x4 x0 = *(const GAS f32x4*)bp + v0, x1 = *(const GAS f32x4*)(bp + 4) + v1;
        GAS float* xp = a.X + (size_t)row * DM + c0; *(GAS f32x4*)xp = x0; *(GAS f32x4*)(xp + 4) = x1;
        u32x4 w; w.x = pk2(x0[0], x0[1]); w.y = pk2(x0[2], x0[3]); w.z = pk2(x1[0], x1[1]); w.w = pk2(x1[2], x1[3]);
        *(GAS u32x4*)(a.Xb + (size_t)row * DM + c0) = w;
        return ((x0[0] * x0[0] + x0[1] * x0[1]) + (x0[2] * x0[2] + x0[3] * x0[3])) + ((x1[0] * x1[0] + x1[1] * x1[1]) + (x1[2] * x1[2] + x1[3] * x1[3]));
    } else {
        v0 *= rstd; v1 *= rstd;
        float h[4];
#pragma unroll
        for (int j = 0; j < 4; ++j) h[j] = silu_f(v0[j]) * v1[j];
        u32x2 w; w.x = pk2(h[0], h[1]); w.y = pk2(h[2], h[3]);
        *(GAS u32x2*)(a.out + (size_t)row * DFF + 16 * g32 + 4 * fq) = w;
        return 0.f;
    }
}
constexpr int EA_OFF = 131072 + 512;
__device__ __forceinline__ EpiArgs load_ea(const LAS unsigned long long* ap) {
    EpiArgs a;
    a.out = (GAS bf16_t*)ap[0]; a.ssp = (const GAS float*)ap[1]; a.gates = (GAS float*)ap[2]; a.o0 = (GAS float*)ap[3]; a.o1 = (GAS float*)ap[4]; a.o2 = (GAS float*)ap[5]; a.o3 = (GAS float*)ap[6];
    a.base_p = (const GAS float*)ap[7]; a.base_s = (const GAS float*)ap[8]; a.X = (GAS float*)ap[9]; a.Xb = (GAS bf16_t*)ap[10]; a.ssp_out = (GAS float*)ap[11];
    return a;
}
template <int MODE> struct Epi {
    const LAS unsigned long long* ap;
    __device__ __forceinline__ void operator()(const f32x4 (&acc)[2][2][4][2], const pg8::Unit& u, int wr, int wc, int fr, int fq) const {
        const EpiArgs a = load_ea(ap);
#pragma unroll
        for (int ai = 0; ai < 2; ++ai)
#pragma unroll
            for (int m = 0; m < 4; ++m) {
                const int row = u.pm * 256 + ai * 128 + wr * 64 + m * 16 + fr;
                float rstd = 1.f; if constexpr (MODE != 2) rstd = row_rstd(a.ssp, row);
                float ss = 0.f;
#pragma unroll
                for (int bj = 0; bj < 2; ++bj) { const int g32 = (u.pn * 256 + bj * 128 + wc * 32) >> 5; ss += epi_apply<MODE, false>(a, row, g32, fq, acc[ai][bj][m][0], acc[ai][bj][m][1], rstd); }
                if constexpr (MODE == 2) { ss += __shfl_xor(ss, 16); ss += __shfl_xor(ss, 32); if (fq == 0) a.ssp_out[(size_t)row * 16 + u.pn * 4 + wc] = ss; }
            }
    }
};

template <int MODE>
__device__ __forceinline__ void small_gemm(const bf16_t* A, const bf16_t* Bt, int Npos, int K, const LAS unsigned long long* eap, LAS unsigned char* lds, int wg, int G, int wid, int lane) {
    const int fr = lane & 15, fq = lane >> 4, ncg = (MODE == 0 ? (ABIN + 63) / 64 : Npos / 64), nunits = (TS / 16) * ncg, KW = K / 8;
    LAS f32x4* part = (LAS f32x4*)lds;
    for (int u = wg; u < nunits; u += G) {
        const int rb = u % (TS / 16), cgp = u / (TS / 16), r0 = TP + rb * 16, p0 = cgp * 64;
        f32x4 acc[4];
#pragma unroll
        for (int f = 0; f < 4; ++f) acc[f] = (f32x4){0.f, 0.f, 0.f, 0.f};
        const bf16_t* ap = A + (size_t)(r0 + fr) * K + wid * KW + 8 * fq;
        const bf16_t* bp = Bt + (size_t)(p0 + fr) * K + wid * KW + 8 * fq;
        for (int k0 = 0; k0 < KW; k0 += 32) {
            const bf16x8 av = *(const bf16x8*)(ap + k0);
            bf16x8 wv[4];
#pragma unroll
            for (int f = 0; f < 4; ++f) wv[f] = *(const bf16x8*)(bp + (size_t)(16 * f) * K + k0);
#pragma unroll
            for (int f = 0; f < 4; ++f) acc[f] = __builtin_amdgcn_mfma_f32_16x16x32_bf16(wv[f], av, acc[f], 0, 0, 0);
        }
#pragma unroll
        for (int f = 0; f < 4; ++f) part[(wid * 4 + f) * 64 + lane] = acc[f];
        __syncthreads();
        if (wid == 0) {
#pragma unroll
            for (int w = 1; w < 8; ++w)
#pragma unroll
                for (int f = 0; f < 4; ++f) acc[f] += part[(w * 4 + f) * 64 + lane];
            const int row = r0 + fr;
            const EpiArgs a = load_ea(eap);
            float rstd = 1.f; if constexpr (MODE != 2) rstd = row_rstd(a.ssp, row);
            float ss = 0.f;
#pragma unroll
            for (int gq = 0; gq < 2; ++gq) ss += epi_apply<MODE, true>(a, row, (p0 >> 5) + gq, fq, acc[2 * gq], acc[2 * gq + 1], rstd);
            if constexpr (MODE == 2) { ss += __shfl_xor(ss, 16); ss += __shfl_xor(ss, 32); if (fq == 0) a.ssp_out[(size_t)row * 16 + cgp] = ss; }
        }
        __syncthreads();
    }
}

__device__ __forceinline__ void transpose_item(const float* W, int K, int Nsrc, int gu, const float* gamma, bf16_t* WT, LAS float* scr, int item, int npb, int lane) {
    const int kb = item / npb, nb = item % npb, k0 = 64 * kb, p0 = 32 * nb;
    const int cl = p0 + pg8::perm32(lane & 31);
    int src = cl; if (gu) src = ((cl >> 2) & 1) * DFF + 4 * (cl >> 3) + (cl & 3);
    const bool valid = src < Nsrc;
#pragma unroll 8
    for (int i = 0; i < 32; ++i) { const int kk = 2 * i + (lane >> 5); float v = 0.f; if (valid) { v = W[(size_t)(k0 + kk) * Nsrc + src]; if (gamma) v *= gamma[k0 + kk]; } scr[kk * 33 + (lane & 31)] = v; }
    asm volatile("s_waitcnt lgkmcnt(0)" ::: "memory");
    const int c = lane & 7;
#pragma unroll
    for (int j = 0; j < 4; ++j) { const int n = (lane >> 3) + 8 * j; const LAS float* s = scr + (8 * c) * 33 + n;
        u32x4 o; o.x = pk2(s[0 * 33], s[1 * 33]); o.y = pk2(s[2 * 33], s[3 * 33]); o.z = pk2(s[4 * 33], s[5 * 33]); o.w = pk2(s[6 * 33], s[7 * 33]);
        *(u32x4*)(WT + (size_t)(p0 + n) * K + k0 + 8 * c) = o; }
    asm volatile("s_waitcnt lgkmcnt(0)" ::: "memory");
}
__device__ __forceinline__ void convert_matrix(const float* W, int K, int Nsrc, int Npos, int gu, const float* gamma, bf16_t* WT, LAS float* scr, int gw, int ngw, int lane) {
    const int npb = Npos / 32, nitems = (K / 64) * npb;
    for (int it = gw; it < nitems; it += ngw) transpose_item(W, K, Nsrc, gu, gamma, WT, scr, it, npb, lane);
}
__device__ __forceinline__ void convert_mats(const Params& P, LAS unsigned char* lds, int m_lo, int m_hi, int gw, int ngw, int wid, int lane) {
    LAS float* scr = (LAS float*)(lds + wid * 8704);
    unsigned char* ws = P.ws;
    for (int mi = m_lo; mi < m_hi; ++mi) {
        int type, idx;
        if (mi < 4) { type = (mi == 0) ? 0 : (mi == 1) ? 1 : (mi == 2) ? 4 : 5; idx = 0; }
        else { const int r = mi - 4, grp = r >> 2, q = r & 3;
            if (q >= 2) { type = q + 2; idx = grp + 1; } else if (grp == 1) { type = q; idx = 1; } else { type = 2 + q; idx = grp >> 1; } }
        const float* W; const float* gamma = nullptr; bf16_t* WT; int K = 1024, Nsrc, Npos, gu = 0;
        if (type == 0) { W = P.in[8] + (size_t)idx * 1024 * ABIN; gamma = P.in[7] + idx * 1024; WT = (bf16_t*)(ws + WS_WIN + idx * SZ_WIN); Nsrc = ABIN; Npos = ABPAD; }
        else if (type == 1) { W = P.in[16] + (size_t)idx * 1024 * 1024; WT = (bf16_t*)(ws + WS_WOUT + idx * SZ_W1K); Nsrc = 1024; Npos = 1024; }
        else if (type == 2) { W = P.in[18] + (size_t)idx * 1024 * NQKV; gamma = P.in[17] + idx * 1024; WT = (bf16_t*)(ws + WS_WQKV + idx * SZ_WQKV); Nsrc = NQKV; Npos = NQKV; }
        else if (type == 3) { W = P.in[20] + (size_t)idx * 1024 * 1024; WT = (bf16_t*)(ws + WS_WCOUT + idx * SZ_W1K); Nsrc = 1024; Npos = 1024; }
        else if (type == 4) { W = P.in[22] + (size_t)idx * 1024 * NGU; gamma = P.in[21] + idx * 1024; WT = (bf16_t*)(ws + WS_WGU + idx * SZ_WGU); Nsrc = NGU; Npos = NGU; gu = 1; }
        else { W = P.in[23] + (size_t)idx * DFF * 1024; WT = (bf16_t*)(ws + WS_WDN + idx * SZ_WDN); K = DFF; Nsrc = 1024; Npos = 1024; }
        convert_matrix(W, K, Nsrc, Npos, gu, gamma, WT, scr, gw, ngw, lane);
    }
}
__device__ __forceinline__ void phase_prologue(const Params& P, LAS unsigned char* lds, int gw, int ngw, int wid, int lane) {
    convert_mats(P, lds, 0, 4, gw, ngw, wid, lane);
    unsigned char* ws = P.ws;
    bf16_t* Xb = (bf16_t*)(ws + WS_XB); float* ssp = (float*)(ws + WS_SSP);
    for (int row = gw; row < TR; row += ngw) {
        const float* xr = (row < TP) ? P.in[0] + (size_t)row * DM : P.in[1] + (size_t)(row - TP) * DM;
        f32x4 v[4]; float s = 0.f;
#pragma unroll
        for (int j = 0; j < 4; ++j) { v[j] = ((const f32x4*)xr)[lane + 64 * j]; s += (v[j][0] * v[j][0] + v[j][1] * v[j][1]) + (v[j][2] * v[j][2] + v[j][3] * v[j][3]); }
        s = wave_sum(s);
#pragma unroll
        for (int j = 0; j < 4; ++j) { u32x2 w; w.x = pk2(v[j][0], v[j][1]); w.y = pk2(v[j][2], v[j][3]); ((u32x2*)(Xb + (size_t)row * DM))[lane + 64 * j] = w; }
        if (lane < 16) ssp[(size_t)row * 16 + lane] = (lane == 0) ? s : 0.f;
    }
}
__device__ __forceinline__ void phase_final(const Params& P, int gw, int ngw, int lane) {
    const GAS float* ssp = (const GAS float*)(P.ws + WS_SSP); const float* g = P.in[24];
    f32x4 gv[4];
#pragma unroll
    for (int j = 0; j < 4; ++j) gv[j] = ((const f32x4*)g)[lane + 64 * j];
    for (int row = gw; row < TR; row += ngw) {
        const float rstd = row_rstd(ssp, row);
        f32x4* xr = (f32x4*)(P.out + (size_t)row * DM);
#pragma unroll
        for (int j = 0; j < 4; ++j) { f32x4 v = xr[lane + 64 * j]; xr[lane + 64 * j] = v * rstd * gv[j]; }
    }
}

constexpr int MX_CH = 32;
#define LDS_BARRIER() asm volatile("s_waitcnt lgkmcnt(0)\n\ts_barrier" ::: "memory")
__device__ __forceinline__ void delta_unit(const Params& P, LAS unsigned char* lds, int li, bool sample, int b, int h, int half, const int tid) {
    const int lane = tid & 63, wid = __builtin_amdgcn_readfirstlane(tid >> 6);
    const int L = sample ? SSEQ : SEQ, rowbase = sample ? TP + b * SSEQ : b * SEQ;
    const bf16_t* PROJ = (const bf16_t*)(P.ws + WS_R1); const float* GATES = (const float*)(P.ws + WS_GATES); bf16_t* MIX = (bf16_t*)(P.ws + WS_MIX);
    const int NC = (L + MX_CH - 1) / MX_CH;
    constexpr int SET = 4 * 8192 + 256;
    if (wid < 4) __builtin_amdgcn_s_setprio(2);
    const int e = 32 * half + (wid & 3) * 8 + (lane >> 3), dq = lane & 7;
    f32x2 S[4];
    float* sout = P.out + (sample ? O_DNS : O_DNP) + (size_t)((li * 8 + b) * 8 + h) * 4096;
    if (wid < 4) {
        if (sample) { const float* s0 = P.in[3] + (size_t)((li * 8 + b) * 8 + h) * 4096;
#pragma unroll
            for (int j = 0; j < 4; ++j) { S[j][0] = s0[(8 * dq + 2 * j) * 64 + e]; S[j][1] = s0[(8 * dq + 2 * j + 1) * 64 + e]; } }
        else {
#pragma unroll
            for (int j = 0; j < 4; ++j) S[j] = (f32x2){0.f, 0.f}; }
    }
    const int pw = wid - 4, c = lane;
    float cwq[4], cwk[4], cwv[4], alog = 0.f, dtb = 0.f;
    float rq[11], rk[11], rv[11], ga = 0.f, gb_ = 0.f;
    if (wid >= 4) {
        const float* cw = P.in[9] + (size_t)li * 4 * DNQKV;
#pragma unroll
        for (int t = 0; t < 4; ++t) { cwq[t] = cw[t * DNQKV + h * 64 + c]; cwk[t] = cw[t * DNQKV + 512 + h * 64 + c]; cwv[t] = cw[t * DNQKV + 1024 + h * 64 + c]; }
        alog = P.in[10][li * 8 + h]; dtb = P.in[11][li * 8 + h];
    }
#define DN_LOADS(jn) do { const int t0n_ = (jn) * MX_CH + pw * 8; if ((jn) < NC && t0n_ < L) { \
        _Pragma("unroll") for (int r = 0; r < 11; ++r) { const int t = t0n_ - 3 + r, tc = max(t, 0); const bf16_t* pr = PROJ + (size_t)(rowbase + tc) * ABIN + h * 64 + c; \
            const float m = (t >= 0) ? 1.f : 0.f; rq[r] = bf2f(pr[0]) * m; rk[r] = bf2f(pr[512]) * m; rv[r] = bf2f(pr[1024]) * m; } \
        { const float* gp = GATES + (size_t)(rowbase + t0n_ + (lane & 7)) * 32; ga = gp[h]; gb_ = gp[8 + h]; } \
        if (sample && t0n_ == 0) { _Pragma("unroll") for (int r = 0; r < 3; ++r) { const float* cb = P.in[2] + (size_t)((li * 8 + b) * 3 + r) * DNQKV + h * 64 + c; rq[r] = cb[0]; rk[r] = cb[512]; rv[r] = cb[1024]; } } } } while (0)
    if (wid >= 4) DN_LOADS(0);
    for (int j = 0; j < NC + 2; ++j) {
        if (wid >= 4) {
            if (j < NC) {
                LAS float* qs = (LAS float*)(lds + (j & 1) * SET); LAS float* ks = qs + 2048; LAS float* vs = qs + 4096; LAS float* sc = qs + 8192;
                const int t0 = j * MX_CH + pw * 8;
                if (t0 < L) {
#pragma unroll
                    for (int i = 0; i < 8; ++i) {
                        float q = cwq[0] * rq[i] + cwq[1] * rq[i + 1] + cwq[2] * rq[i + 2] + cwq[3] * rq[i + 3];
                        float k = cwk[0] * rk[i] + cwk[1] * rk[i + 1] + cwk[2] * rk[i + 2] + cwk[3] * rk[i + 3];
                        float v = cwv[0] * rv[i] + cwv[1] * rv[i + 1] + cwv[2] * rv[i + 2] + cwv[3] * rv[i + 3];
                        q = silu_f(q); k = silu_f(k); v = silu_f(v);
                        const float sq = wave_sum(q * q), sk = wave_sum(k * k);
                        const int tok = pw * 8 + i;
                        qs[tok * 64 + c] = q * rsqrtf(sq + EPS) * 0.125f; ks[tok * 64 + c] = k * rsqrtf(sk + EPS); vs[tok * 64 + c] = v;
                    }
                    if (lane < 8) { const float g = -__expf(alog) * softplus_f(ga + dtb); sc[(pw * 8 + lane) * 2] = __expf(g); sc[(pw * 8 + lane) * 2 + 1] = sigmoid_f(gb_); }
                }
            }
            DN_LOADS(j + 1);
            if (j >= 2) {
                LAS float* os = (LAS float*)(lds + (j & 1) * SET) + 6144;
                const int t0 = (j - 2) * MX_CH + pw * 8;
                if (t0 < L && (c >> 5) == half) {
#pragma unroll
                    for (int i = 0; i < 8; ++i) {
                        const int tok = pw * 8 + i; const size_t row = (size_t)(rowbase + t0 + i);
                        MIX[row * DM + h * 64 + c] = (bf16_t)f2bf(os[tok * 64 + c]);
                    }
                }
            }
        } else if (j >= 1 && j <= NC) {
            LAS float* qs = (LAS float*)(lds + ((j - 1) & 1) * SET); LAS float* ks = qs + 2048; LAS float* vs = qs + 4096; LAS float* os = qs + 6144; LAS float* sc = qs + 8192;
            const int ntok = min(MX_CH, L - (j - 1) * MX_CH);
            f32x4 kA0, kA1, qA0, qA1, kB0, kB1, qB0, qB1; float vA, vB; f32x2 gA, gB;
            kA0 = *(const LAS f32x4*)(ks + 8 * dq); kA1 = *(const LAS f32x4*)(ks + 8 * dq + 4); qA0 = *(const LAS f32x4*)(qs + 8 * dq); qA1 = *(const LAS f32x4*)(qs + 8 * dq + 4);
            vA = vs[e]; gA = *(const LAS f32x2*)(sc);
#define DN_STEP(TOK, K0, K1, Q0, Q1, VE, GB, NK0, NK1, NQ0, NQ1, NVE, NGB) do { \
                const int tn_ = min((TOK) + 1, ntok - 1); \
                NK0 = *(const LAS f32x4*)(ks + tn_ * 64 + 8 * dq); NK1 = *(const LAS f32x4*)(ks + tn_ * 64 + 8 * dq + 4); NQ0 = *(const LAS f32x4*)(qs + tn_ * 64 + 8 * dq); NQ1 = *(const LAS f32x4*)(qs + tn_ * 64 + 8 * dq + 4); \
                NVE = vs[tn_ * 64 + e]; NGB = *(const LAS f32x2*)(sc + tn_ * 2); \
                const float eg = GB[0], beta = GB[1]; \
                const f32x2 wa = (f32x2){K0[0], K0[1]} * S[0] + (f32x2){K0[2], K0[3]} * S[1]; \
                const f32x2 wb = (f32x2){K1[0], K1[1]} * S[2] + (f32x2){K1[2], K1[3]} * S[3]; \
                const f32x2 ws2 = wa + wb; \
                const float w = oct_sum(ws2[0] + ws2[1]); \
                const float dl = beta * (VE - eg * w); \
                const f32x2 eg2 = (f32x2){eg, eg}, dl2 = (f32x2){dl, dl}; \
                S[0] = S[0] * eg2 + (f32x2){K0[0], K0[1]} * dl2; S[1] = S[1] * eg2 + (f32x2){K0[2], K0[3]} * dl2; \
                S[2] = S[2] * eg2 + (f32x2){K1[0], K1[1]} * dl2; S[3] = S[3] * eg2 + (f32x2){K1[2], K1[3]} * dl2; \
                const f32x2 oa = (f32x2){Q0[0], Q0[1]} * S[0] + (f32x2){Q0[2], Q0[3]} * S[1]; \
                const f32x2 ob = (f32x2){Q1[0], Q1[1]} * S[2] + (f32x2){Q1[2], Q1[3]} * S[3]; \
                const f32x2 os2 = oa + ob; \
                os[(TOK) * 64 + e] = oct_sum(os2[0] + os2[1]); } while (0)
            for (int tok = 0; tok < ntok; tok += 2) {
                DN_STEP(tok, kA0, kA1, qA0, qA1, vA, gA, kB0, kB1, qB0, qB1, vB, gB);
                DN_STEP(tok + 1, kB0, kB1, qB0, qB1, vB, gB, kA0, kA1, qA0, qA1, vA, gA);
            }
#undef DN_STEP
        }
        LDS_BARRIER();
    }
#undef DN_LOADS
    if (wid < 4) {
#pragma unroll
        for (int j = 0; j < 4; ++j) { sout[(8 * dq + 2 * j) * 64 + e] = S[j][0]; sout[(8 * dq + 2 * j + 1) * 64 + e] = S[j][1]; }
    }
    __builtin_amdgcn_s_setprio(0);
}

__device__ __forceinline__ void gla_unit(const Params& P, LAS unsigned char* lds, int li, bool sample, int b, int h, const int tid) {
    const int lane = tid & 63, wid = __builtin_amdgcn_readfirstlane(tid >> 6);
    const int L = sample ? SSEQ : SEQ, rowbase = sample ? TP + b * SSEQ : b * SEQ;
    const bf16_t* PROJ = (const bf16_t*)(P.ws + WS_R1); const float* GATES = (const float*)(P.ws + WS_GATES); bf16_t* MIX = (bf16_t*)(P.ws + WS_MIX);
    const int NC = (L + MX_CH - 1) / MX_CH;
    constexpr int SET = 3 * 4096 + 2 * 8192;
    if (wid < 4) __builtin_amdgcn_s_setprio(2);
    const int e = (wid & 3) * 16 + (lane >> 2), dq = lane & 3;
    f32x2 S[4];
    float* sout = P.out + (sample ? O_GLAS : O_GLAP) + (size_t)((li * 8 + b) * 8 + h) * 2048;
    if (wid < 4) {
        if (sample) { const float* s0 = P.in[4] + (size_t)((li * 8 + b) * 8 + h) * 2048;
#pragma unroll
            for (int j = 0; j < 4; ++j) { S[j][0] = s0[(8 * dq + 2 * j) * 64 + e]; S[j][1] = s0[(8 * dq + 2 * j + 1) * 64 + e]; } }
        else {
#pragma unroll
            for (int j = 0; j < 4; ++j) S[j] = (f32x2){0.f, 0.f}; }
    }
    const int pw = wid - 4, c = lane, c32 = lane & 31;
    float w2[16], gkb = 0.f, onorm = 0.f;
    if (wid >= 4) {
#pragma unroll
        for (int r = 0; r < 16; ++r) w2[r] = P.in[13][(size_t)(li * 16 + r) * 256 + h * 32 + c32];
        gkb = P.in[14][li * 256 + h * 32 + c32]; onorm = P.in[15][li * 64 + c];
    }
    for (int j = 0; j < NC + 2; ++j) {
        if (wid >= 4) {
            if (j < NC) {
                LAS float* qs = (LAS float*)(lds + (j & 1) * SET); LAS float* ks = qs + 1024; LAS float* gs = qs + 2048; LAS float* vs = qs + 3072;
                const int t0 = j * MX_CH + pw * 8;
                if (t0 < L) {
                    const int g4 = (lane >> 5) * 4;
                    float rv[8], rq[4], rk[4]; f32x4 lrv[4][4];
#pragma unroll
                    for (int i = 0; i < 8; ++i) rv[i] = bf2f(PROJ[(size_t)(rowbase + t0 + i) * ABIN + 2576 + h * 64 + c]);
#pragma unroll
                    for (int i = 0; i < 4; ++i) { const size_t row = (size_t)(rowbase + t0 + g4 + i); const bf16_t* pr = PROJ + row * ABIN;
                        rq[i] = bf2f(pr[2064 + h * 32 + c32]); rk[i] = bf2f(pr[2320 + h * 32 + c32]);
#pragma unroll
                        for (int r = 0; r < 4; ++r) lrv[i][r] = *(const f32x4*)(GATES + row * 32 + 16 + 4 * r); }
#pragma unroll
                    for (int i = 0; i < 8; ++i) vs[(pw * 8 + i) * 64 + c] = rv[i];
#pragma unroll
                    for (int i = 0; i < 4; ++i) {
                        const int tok = pw * 8 + g4 + i;
                        float z = gkb;
#pragma unroll
                        for (int r = 0; r < 4; ++r) z += (lrv[i][r][0] * w2[4 * r] + lrv[i][r][1] * w2[4 * r + 1]) + (lrv[i][r][2] * w2[4 * r + 2] + lrv[i][r][3] * w2[4 * r + 3]);
                        const float ls = -softplus_f(-z);
                        qs[tok * 32 + c32] = rq[i] * 0.17677669529663687f; ks[tok * 32 + c32] = rk[i]; gs[tok * 32 + c32] = __expf(ls * (1.0f / 16.0f));
                    }
                }
            }
            if (j >= 2) {
                LAS float* os = (LAS float*)(lds + (j & 1) * SET) + 3072 + 2048;
                const int t0 = (j - 2) * MX_CH + pw * 8;
                if (t0 < L) {
#pragma unroll
                    for (int i = 0; i < 8; ++i) {
                        const int tok = pw * 8 + i; const size_t row = (size_t)(rowbase + t0 + i);
                        MIX[row * DM + 512 + h * 64 + c] = (bf16_t)f2bf(os[tok * 64 + c]);
                    }
                }
            }
        } else if (j >= 1 && j <= NC) {
            LAS float* qs = (LAS float*)(lds + ((j - 1) & 1) * SET); LAS float* ks = qs + 1024; LAS float* gs = qs + 2048; LAS float* vs = qs + 3072; LAS float* os = qs + 3072 + 2048;
            const int ntok = min(MX_CH, L - (j - 1) * MX_CH);
            f32x4 kk[2], qq[2], gg[2]; float ve;
#pragma unroll
            for (int i = 0; i < 2; ++i) { kk[i] = *(const LAS f32x4*)(ks + 8 * dq + 4 * i); qq[i] = *(const LAS f32x4*)(qs + 8 * dq + 4 * i); gg[i] = *(const LAS f32x4*)(gs + 8 * dq + 4 * i); }
            ve = vs[e];
            for (int tok = 0; tok < ntok; ++tok) {
                const int tn = min(tok + 1, ntok - 1);
                f32x4 kn[2], qn[2], gn[2];
#pragma unroll
                for (int i = 0; i < 2; ++i) { kn[i] = *(const LAS f32x4*)(ks + tn * 32 + 8 * dq + 4 * i); qn[i] = *(const LAS f32x4*)(qs + tn * 32 + 8 * dq + 4 * i); gn[i] = *(const LAS f32x4*)(gs + tn * 32 + 8 * dq + 4 * i); }
                const float vn = vs[tn * 64 + e];
                const f32x2 v2 = (f32x2){ve, ve};
                f32x2 oa[2];
#pragma unroll
                for (int i = 0; i < 2; ++i) {
                    S[2 * i] = S[2 * i] * (f32x2){gg[i][0], gg[i][1]} + (f32x2){kk[i][0], kk[i][1]} * v2; S[2 * i + 1] = S[2 * i + 1] * (f32x2){gg[i][2], gg[i][3]} + (f32x2){kk[i][2], kk[i][3]} * v2;
                    oa[i] = (f32x2){qq[i][0], qq[i][1]} * S[2 * i] + (f32x2){qq[i][2], qq[i][3]} * S[2 * i + 1];
                }
                const f32x2 os2 = oa[0] + oa[1];
                const float o = quad_sum(os2[0] + os2[1]);
                if (dq == 0) os[tok * 64 + e] = o;
#pragma unroll
                for (int i = 0; i < 2; ++i) { kk[i] = kn[i]; qq[i] = qn[i]; gg[i] = gn[i]; }
                ve = vn;
            }
        }
        __syncthreads();
    }
    if (wid < 4) {
#pragma unroll
        for (int j = 0; j < 4; ++j) { sout[(8 * dq + 2 * j) * 64 + e] = S[j][0]; sout[(8 * dq + 2 * j + 1) * 64 + e] = S[j][1]; }
    }
    __builtin_amdgcn_s_setprio(0);
}

__device__ __forceinline__ void phase_fixup(const Params& P, int li, int gw, int ngw, int lane) {
    bf16_t* MIX = (bf16_t*)(P.ws + WS_MIX); const bf16_t* PROJ = (const bf16_t*)(P.ws + WS_R1);
    const float* on = (lane < 32 ? P.in[12] : P.in[15]) + li * 64 + 16 * (lane & 3);
    float g[16];
#pragma unroll
    for (int j = 0; j < 16; ++j) g[j] = on[j];
    const int gcol = (lane < 32) ? 1552 + 16 * lane : 3104 + 16 * (lane - 32);
    for (int row = gw; row < TR; row += ngw) {
        u32x4* mp = (u32x4*)(MIX + (size_t)row * DM + 16 * lane);
        const u32x4* gp = (const u32x4*)(PROJ + (size_t)row * ABIN + gcol);
        const u32x4 m0 = mp[0], m1 = mp[1], g0 = gp[0], g1 = gp[1];
        float o[16], gt[16];
#pragma unroll
        for (int j = 0; j < 4; ++j) { o[2 * j] = __builtin_bit_cast(float, m0[j] << 16); o[2 * j + 1] = __builtin_bit_cast(float, m0[j] & 0xffff0000u); o[8 + 2 * j] = __builtin_bit_cast(float, m1[j] << 16); o[8 + 2 * j + 1] = __builtin_bit_cast(float, m1[j] & 0xffff0000u);
            gt[2 * j] = __builtin_bit_cast(float, g0[j] << 16); gt[2 * j + 1] = __builtin_bit_cast(float, g0[j] & 0xffff0000u); gt[8 + 2 * j] = __builtin_bit_cast(float, g1[j] << 16); gt[8 + 2 * j + 1] = __builtin_bit_cast(float, g1[j] & 0xffff0000u); }
        float ss = 0.f;
#pragma unroll
        for (int j = 0; j < 16; ++j) ss += o[j] * o[j];
        ss = quad_sum(ss);
        const float rstd = rsqrtf(ss * (1.0f / 64.0f) + EPS);
        float r[16];
#pragma unroll
        for (int j = 0; j < 16; ++j) r[j] = o[j] * rstd * g[j] * silu_f(gt[j]);
        u32x4 w0, w1;
#pragma unroll
        for (int j = 0; j < 4; ++j) { w0[j] = pk2(r[2 * j], r[2 * j + 1]); w1[j] = pk2(r[8 + 2 * j], r[8 + 2 * j + 1]); }
        mp[0] = w0; mp[1] = w1;
    }
}

constexpr int AT_KOFF = 0, AT_VOFF = 2 * 9216, AT_BIAS = 4 * 9216;
__device__ __forceinline__ int vpos(int kv) { return 16 * (kv >> 4) + 8 * ((kv >> 2) & 1) + 4 * ((kv >> 3) & 1) + (kv & 3); }
__device__ __forceinline__ void attn_build_bias(const Params& P, LAS unsigned char* lds, int li, int h, const int tid) {
    const float* tb = P.in[19] + (size_t)(li * 16 + h) * 257;
    LAS float* bt = (LAS float*)(lds + AT_BIAS);
    for (int i = tid; i < 4 * 2 * 64 * 32; i += 512) {
        const int r = i & 31, lane = (i >> 5) & 63, par = (i >> 11) & 1, dist = i >> 12, hi = lane >> 5, r32 = lane & 31;
        const int kv = ((r & 3) + 8 * ((r & 15) >> 2) + 4 * hi) + 32 * (r >> 4), rel = r32 + 32 * par - kv + 64 * dist;
        const float v = (dist == 3) ? tb[256] : tb[min(rel, 128) + 128];
        bt[(((dist * 2 + par) * 8 + (r >> 2)) * 64 + lane) * 4 + (r & 3)] = v * 8.0f;
    }
}
__device__ __forceinline__ void attn_tile(const LAS unsigned char* Kb, const LAS unsigned char* Vb, const LAS f32x4* bp, const bf16x8 (&qr)[4], f32x16 (&o)[2], float& m, float& l, int r32, int hi) {
    const float C2 = 0.125f * LOG2E;
    f32x16 p0, p1;
#pragma unroll
    for (int j = 0; j < 4; ++j) { const f32x4 t0 = bp[j * 64], t1 = bp[(4 + j) * 64];
        p0[4 * j] = t0[0]; p0[4 * j + 1] = t0[1]; p0[4 * j + 2] = t0[2]; p0[4 * j + 3] = t0[3]; p1[4 * j] = t1[0]; p1[4 * j + 1] = t1[1]; p1[4 * j + 2] = t1[2]; p1[4 * j + 3] = t1[3]; }
#pragma unroll
    for (int d0 = 0; d0 < 4; ++d0) {
        const bf16x8 a0 = *(const LAS bf16x8*)(Kb + r32 * 144 + d0 * 32 + hi * 16);
        const bf16x8 a1 = *(const LAS bf16x8*)(Kb + (32 + r32) * 144 + d0 * 32 + hi * 16);
        p0 = __builtin_amdgcn_mfma_f32_32x32x16_bf16(a0, qr[d0], p0, 0, 0, 0);
        p1 = __builtin_amdgcn_mfma_f32_32x32x16_bf16(a1, qr[d0], p1, 0, 0, 0);
    }
    float mx = fmaxf(p0[0], p1[0]);
#pragma unroll
    for (int r = 1; r < 16; ++r) mx = fmaxf(mx, fmaxf(p0[r], p1[r]));
    mx = fmaxf(mx, __shfl_xor(mx, 32)) * C2;
    if (__any(mx > m + 8.0f)) {
        const float mn = fmaxf(m, mx), scl = __builtin_amdgcn_exp2f(m - mn); m = mn; l *= scl;
#pragma unroll
        for (int r = 0; r < 16; ++r) { o[0][r] *= scl; o[1][r] *= scl; }
    }
    float ls = 0.f; const float nm = -m;
#pragma unroll
    for (int r = 0; r < 16; ++r) { p0[r] = __builtin_amdgcn_exp2f(p0[r] * C2 + nm); p1[r] = __builtin_amdgcn_exp2f(p1[r] * C2 + nm); ls += p0[r] + p1[r]; }
    l += ls;
    u32x4 pw[4];
#pragma unroll
    for (int s = 0; s < 2; ++s) {
        pw[s] = (u32x4){pk2(p0[8 * s], p0[8 * s + 1]), pk2(p0[8 * s + 2], p0[8 * s + 3]), pk2(p0[8 * s + 4], p0[8 * s + 5]), pk2(p0[8 * s + 6], p0[8 * s + 7])};
        pw[2 + s] = (u32x4){pk2(p1[8 * s], p1[8 * s + 1]), pk2(p1[8 * s + 2], p1[8 * s + 3]), pk2(p1[8 * s + 4], p1[8 * s + 5]), pk2(p1[8 * s + 6], p1[8 * s + 7])};
    }
#pragma unroll
    for (int dh = 0; dh < 2; ++dh)
#pragma unroll
        for (int ks = 0; ks < 4; ++ks) {
            const bf16x8 vf = *(const LAS bf16x8*)(Vb + (32 * dh + r32) * 144 + (16 * ks + 8 * hi) * 2);
            o[dh] = __builtin_amdgcn_mfma_f32_32x32x16_bf16(vf, __builtin_bit_cast(bf16x8, pw[ks]), o[dh], 0, 0, 0);
        }
}
__device__ __forceinline__ void attn_prompt_unit(const Params& P, LAS unsigned char* lds, int li, int b, int h, int g4, const int tid) {
    const int lane = tid & 63, wid = __builtin_amdgcn_readfirstlane(tid >> 6), r32 = lane & 31, hi = lane >> 5;
    const bf16_t* QKV = (const bf16_t*)(P.ws + WS_R1); bf16_t* MIX = (bf16_t*)(P.ws + WS_MIX);
    const int cw = 4 * g4 + (wid >> 1);
    const size_t qrow = (size_t)b * SEQ + 256 * g4 + 32 * wid + r32;
    bf16x8 qr[4];
#pragma unroll
    for (int d0 = 0; d0 < 4; ++d0) qr[d0] = *(const bf16x8*)(QKV + qrow * NQKV + h * 64 + d0 * 16 + hi * 8);
    const int kt_lo = max(0, 4 * g4 - 8), kt_hi = 4 * g4 + 3;
    const int srow = tid & 63, sch = tid >> 6;
    const bf16_t* kvsrc = QKV + ((size_t)b * SEQ + srow) * NQKV + 1024 + h * 64 + 8 * sch;
    const int vp = vpos(srow);
    bf16x8 kA, vA, kB, vB;
#define AT_LOAD(K_, V_, kt) do { const bf16_t* s_ = kvsrc + (size_t)(kt) * 64 * NQKV; K_ = *(const bf16x8*)s_; V_ = *(const bf16x8*)(s_ + 1024); } while (0)
#define AT_STORE(K_, V_, buf) do { *(LAS bf16x8*)(lds + AT_KOFF + (buf) * 9216 + srow * 144 + sch * 16) = K_; \
        _Pragma("unroll") for (int j_ = 0; j_ < 8; ++j_) *(LAS short*)(lds + AT_VOFF + (buf) * 9216 + (8 * sch + j_) * 144 + vp * 2) = V_[j_]; } while (0)
    AT_LOAD(kA, vA, kt_lo); AT_LOAD(kB, vB, kt_lo + 1);
    AT_STORE(kA, vA, 0);
    LDS_BARRIER();
    float m = -1e30f, l = 0.f; f32x16 o[2];
#pragma unroll
    for (int r = 0; r < 16; ++r) { o[0][r] = 0.f; o[1][r] = 0.f; }
    const LAS f32x4* btl = (const LAS f32x4*)(lds + AT_BIAS) + (wid & 1) * 512 + lane;
    for (int kt = kt_lo; kt <= kt_hi; kt += 2) {
        if (kt + 2 <= kt_hi) AT_LOAD(kA, vA, kt + 2);
        if (kt >= cw - 8 && kt <= cw) attn_tile(lds + AT_KOFF, lds + AT_VOFF, btl + min(cw - kt, 3) * 1024, qr, o, m, l, r32, hi);
        AT_STORE(kB, vB, 1);
        LDS_BARRIER();
        if (kt + 3 <= kt_hi) AT_LOAD(kB, vB, kt + 3);
        if (kt + 1 >= cw - 8 && kt + 1 <= cw) attn_tile(lds + AT_KOFF + 9216, lds + AT_VOFF + 9216, btl + min(cw - kt - 1, 3) * 1024, qr, o, m, l, r32, hi);
        if (kt + 2 <= kt_hi) AT_STORE(kA, vA, 0);
        LDS_BARRIER();
    }
#undef AT_LOAD
#undef AT_STORE
    l += __shfl_xor(l, 32);
    const float rl = 1.0f / l;
    bf16_t* op = MIX + qrow * DM + h * 64;
#pragma unroll
    for (int dh = 0; dh < 2; ++dh)
#pragma unroll
        for (int r4 = 0; r4 < 4; ++r4) {
            u32x2 w; w.x = pk2(o[dh][4 * r4] * rl, o[dh][4 * r4 + 1] * rl); w.y = pk2(o[dh][4 * r4 + 2] * rl, o[dh][4 * r4 + 3] * rl);
            *(u32x2*)(op + 32 * dh + 8 * r4 + 4 * hi) = w;
        }
}
__device__ __forceinline__ void attn_sample_unit(const Params& P, LAS unsigned char* lds, int li, int b, int h, const int tid) {
    const int lane = tid & 63, wid = tid >> 6;
    const bf16_t* QKV = (const bf16_t*)(P.ws + WS_R1); bf16_t* MIX = (bf16_t*)(P.ws + WS_MIX);
    LAS float* qs = (LAS float*)lds;
    LAS float* sc = qs + 1024;
    LAS float* tab = sc + 16 * 528;
    const size_t rb = (size_t)TP + b * SSEQ;
    for (int i = tid; i < 1024; i += 512) qs[i] = bf2f(QKV[(rb + (i >> 6)) * NQKV + h * 64 + (i & 63)]);
    if (tid < 257) tab[tid] = P.in[19][(size_t)(li * 16 + h) * 257 + tid];
    __syncthreads();
    const float* kc = P.in[5] + ((size_t)(li * 8 + b) * 512) * 1024 + h * 64;
    const float* vc = P.in[6] + ((size_t)(li * 8 + b) * 512) * 1024 + h * 64;
    for (int j = tid; j < 528; j += 512) {
        float kr[64];
        if (j < 512) {
#pragma unroll
            for (int d = 0; d < 16; ++d) { const f32x4 t = *(const f32x4*)(kc + (size_t)j * 1024 + 4 * d); kr[4 * d] = t[0]; kr[4 * d + 1] = t[1]; kr[4 * d + 2] = t[2]; kr[4 * d + 3] = t[3]; }
        } else {
#pragma unroll
            for (int d = 0; d < 64; ++d) kr[d] = bf2f(QKV[(rb + (j - 512)) * NQKV + 1024 + h * 64 + d]);
        }
        for (int q = 0; q < 16; ++q) {
            float s = 0.f;
#pragma unroll
            for (int d = 0; d < 64; ++d) s += qs[q * 64 + d] * kr[d];
            const int rel = (j < 512) ? (512 + q - j) : (q - (j - 512));
            sc[q * 528 + j] = s * 0.125f + tab[min(max(rel, -128), 128) + 128];
        }
    }
    __syncthreads();
    for (int q = 2 * wid; q < 2 * wid + 2; ++q) {
        float mx = -1e30f;
        for (int j = lane; j < 528; j += 64) mx = fmaxf(mx, sc[q * 528 + j]);
#pragma unroll
        for (int o = 1; o < 64; o <<= 1) mx = fmaxf(mx, __shfl_xor(mx, o));
        float sm = 0.f;
        for (int j = lane; j < 528; j += 64) { const float p = __expf(sc[q * 528 + j] - mx); sc[q * 528 + j] = p; sm += p; }
        sm = wave_sum(sm);
        const float inv = 1.0f / sm;
        for (int j = lane; j < 528; j += 64) sc[q * 528 + j] *= inv;
    }
    __syncthreads();
    {
        const int q = tid >> 5, d = 2 * (tid & 31);
        float a0 = 0.f, a1 = 0.f;
        for (int j = 0; j < 512; ++j) { const f32x2 v = *(const f32x2*)(vc + (size_t)j * 1024 + d); const float p = sc[q * 528 + j]; a0 += p * v[0]; a1 += p * v[1]; }
        for (int j = 0; j < 16; ++j) { const bf16_t* vp = QKV + (rb + j) * NQKV + 2048 + h * 64 + d; const float p = sc[q * 528 + 512 + j]; a0 += p * bf2f(vp[0]); a1 += p * bf2f(vp[1]); }
        *(unsigned*)(MIX + (rb + q) * DM + h * 64 + d) = pk2(a0, a1);
    }
    __syncthreads();
}

#define XB_TMO      128
#define XB_XCNT(j)  (256  + 64 * (j))
#define XB_XSUB(j)  (1280 + 64 * (j))
#define XB_XGEN(j)  (2304 + 64 * (j))
#define XB_TOP      3328
#define XB_TOPGEN   3392
#define XCD_BAR_WORDS 3456
#define XB_SPIN_CAP (1u << 20)
__device__ __forceinline__ unsigned xb_ld(unsigned* p)              { return __hip_atomic_load(p, __ATOMIC_RELAXED, __HIP_MEMORY_SCOPE_AGENT); }
__device__ __forceinline__ unsigned xb_add(unsigned* p, unsigned v) { return __hip_atomic_fetch_add(p, v, __ATOMIC_RELAXED, __HIP_MEMORY_SCOPE_AGENT); }
__device__ __forceinline__ unsigned xb_xcc_id() { return (unsigned)__builtin_amdgcn_s_getreg((3 << 11) | 20) & 0xFu; }
#define XB_SPIN(cond, bar) do { unsigned _sp = 0; while (cond) { __builtin_amdgcn_s_sleep(1); \
    if ((++_sp & 255u) == 0u) { if (xb_ld(&(bar)[XB_TMO])) break; if (_sp > XB_SPIN_CAP) { atomicAdd(&(bar)[XB_TMO], 1u); break; } } } } while (0)
struct XcdBarrier { unsigned* bar; unsigned x; volatile LAS unsigned* st; };
__device__ __forceinline__ XcdBarrier xcd_barrier_post(unsigned* bar, volatile LAS unsigned* st) {
    XcdBarrier b; b.bar = bar; b.x = xb_xcc_id(); b.st = st;
    if (threadIdx.x == 0) (void)xb_add(&bar[XB_XCNT(b.x)], 1u);
    return b;
}
__device__ __forceinline__ void xcd_barrier_complete(unsigned* bar, unsigned x, unsigned& nloc, unsigned& nx) {
    const unsigned G = gridDim.x * gridDim.y * gridDim.z;
    unsigned sum, cnt, mine, sp = 0u;
    for (;;) {
        sum = 0u; cnt = 0u; mine = 0u;
#pragma unroll
        for (unsigned j = 0; j < 16; ++j) { const unsigned c = xb_ld(&bar[XB_XCNT(j)]); sum += c; cnt += (c > 0u) ? 1u : 0u; mine = (j == x) ? c : mine; }
        if (sum == G) break;
        __builtin_amdgcn_s_sleep(1);
        if ((++sp & 255u) == 0u) { if (xb_ld(&bar[XB_TMO])) break; if (sp > XB_SPIN_CAP) { atomicAdd(&bar[XB_TMO], 1u); break; } }
    }
    nloc = mine > 0u ? mine : 1u; nx = cnt > 0u ? cnt : 1u;
}
__device__ __forceinline__ void xcd_barrier(const XcdBarrier& b) {
    asm volatile("s_waitcnt vmcnt(0)" ::: "memory");
    __syncthreads();
    if (threadIdx.x == 0) {
        unsigned* bar = b.bar;
        __builtin_amdgcn_s_waitcnt(0);
        unsigned nloc = b.st[0], nx = b.st[1];
        if (nloc == 0u) { xcd_barrier_complete(bar, b.x, nloc, nx); b.st[0] = nloc; b.st[1] = nx; }
        const unsigned old = xb_add(&bar[XB_XSUB(b.x)], 1u);
        const unsigned gen = old / nloc;
        if (old + 1u == (gen + 1u) * nloc) {
            __builtin_amdgcn_fence(__ATOMIC_RELEASE, "agent");
            asm volatile("s_waitcnt vmcnt(0)" ::: "memory");
            const unsigned og = xb_add(&bar[XB_TOP], 1u);
            const unsigned tg = og / nx;
            if (og + 1u == (tg + 1u) * nx) xb_add(&bar[XB_TOPGEN], 1u);
            else XB_SPIN(xb_ld(&bar[XB_TOPGEN]) == tg, bar);
            __builtin_amdgcn_fence(__ATOMIC_ACQUIRE, "agent");
            xb_add(&bar[XB_XGEN(b.x)], 1u);
            asm volatile("s_waitcnt vmcnt(0)" ::: "memory");
        } else {
            XB_SPIN(xb_ld(&bar[XB_XGEN(b.x)]) == gen, bar);
            __builtin_amdgcn_fence(__ATOMIC_ACQUIRE, "agent");
            asm volatile("s_waitcnt vmcnt(0)" ::: "memory");
        }
    }
    __syncthreads();
}

__global__ void __launch_bounds__(512, 2) hybrid_fwd(Params P) {
    extern __shared__ __attribute__((aligned(16))) unsigned char lds_raw[];
    LAS unsigned char* lds = (LAS unsigned char*)lds_raw;
    const int G = gridDim.x;
    volatile LAS unsigned* xst = (volatile LAS unsigned*)(lds + 131072 + 256);
    if (threadIdx.x < 2) xst[threadIdx.x] = 0u;
    __syncthreads();
    XcdBarrier xbar = xcd_barrier_post((unsigned*)(P.ws + WS_CTL), xst);
    int ph = P.ph_lo, rep = 0;
    while (ph < P.ph_hi) {
        int tid = threadIdx.x; asm volatile("" : "+v"(tid));
        int wg = blockIdx.x; asm volatile("" : "+s"(wg));
        const Params& Q = P;
        const int lane = tid & 63, wid = __builtin_amdgcn_readfirstlane(tid >> 6), gw = wg * 8 + wid, ngw = G * 8;
        unsigned char* ws = Q.ws;
        bf16_t* Xb = (bf16_t*)(ws + WS_XB); bf16_t* R1 = (bf16_t*)(ws + WS_R1); bf16_t* MIX = (bf16_t*)(ws + WS_MIX);
        float* GATES = (float*)(ws + WS_GATES); float* SSP = (float*)(ws + WS_SSP);
        int nrep = 1;
        if (ph == 0) nrep = REP_PRO; else if (ph != NPHASE - 1) { const int q_ = (ph - 1) % 11; if (q_ == 1) nrep = REP_MIX; else if (q_ == 7) nrep = REP_ATT; else if (q_ == 0 || q_ == 4 || q_ == 6 || q_ == 9) nrep = REP_PROJ; }
        if (ph == 0) phase_prologue(Q, lds, gw, ngw, wid, lane);
        else if (ph == NPHASE - 1) phase_final(Q, gw, ngw, lane);
        else {
            int layer, sub;
            { const int r_ = ph - 1, pair_ = r_ / 11, q_ = r_ % 11; if (q_ < 6) { layer = 2 * pair_; sub = (q_ < 2) ? q_ : (q_ == 2 ? 5 : q_ - 1); } else { layer = 2 * pair_ + 1; sub = q_ - 6; } }
            const int li = layer >> 1, odd = layer & 1;
            if (sub == 5) phase_fixup(Q, li, gw, ngw, lane);
            else if (sub == 1) {
                if (!odd) {
                    if (G == 256) {
                        if (wg < 128) delta_unit(Q, lds, li, false, wg >> 4, (wg >> 1) & 7, wg & 1, tid);
                        else if (wg < 192) { const int u = wg - 128; gla_unit(Q, lds, li, false, u >> 3, u & 7, tid); }
                        else { const int u = wg - 192; delta_unit(Q, lds, li, true, u >> 3, u & 7, 0, tid); delta_unit(Q, lds, li, true, u >> 3, u & 7, 1, tid); gla_unit(Q, lds, li, true, u >> 3, u & 7, tid);
                            if (layer == 0 && rep == 0) convert_mats(Q, lds, 4, 16, (wg - 192) * 8 + wid, 512, wid, lane); }
                    }
                } else {
                    attn_build_bias(Q, lds, li, (wg >> 1) & 15, tid);
                    for (int u = wg * 8; u < wg * 8 + 8; ++u) attn_prompt_unit(Q, lds, li, u >> 8, (u >> 4) & 15, u & 15, tid);
                    if (wg < 128) attn_sample_unit(Q, lds, li, wg >> 4, wg & 15, tid);
                }
            } else {
                pg8::Gemm g; int mode, Npos;
                g.M = TP;
                LAS unsigned long long* eap = (LAS unsigned long long*)(lds + EA_OFF);
#define EA_SET(i, p) eap[i] = (unsigned long long)(p)
                if (sub == 0) {
                    g.A = Xb; g.K = 1024;
                    if (!odd) { mode = 0; Npos = ABPAD; g.Bt = (const bf16_t*)(ws + WS_WIN + li * SZ_WIN);
                        if (tid == 0) { EA_SET(0, R1); EA_SET(1, SSP); EA_SET(2, GATES); EA_SET(3, Q.out + O_CONVP + (size_t)li * 8 * 3 * DNQKV); EA_SET(4, Q.out + O_CONVS + (size_t)li * 8 * 3 * DNQKV); } }
                    else { mode = 1; Npos = NQKV; g.Bt = (const bf16_t*)(ws + WS_WQKV + li * SZ_WQKV);
                        if (tid == 0) { EA_SET(0, R1); EA_SET(1, SSP); EA_SET(3, Q.out + O_CKP + (size_t)li * 8 * 512 * 1024); EA_SET(4, Q.out + O_CVP + (size_t)li * 8 * 512 * 1024); EA_SET(5, Q.out + O_CKS + (size_t)li * 8 * 16 * 1024); EA_SET(6, Q.out + O_CVS + (size_t)li * 8 * 16 * 1024); } }
                } else if (sub == 2) {
                    mode = 2; Npos = 1024; g.A = MIX; g.K = 1024; g.Bt = (const bf16_t*)(ws + (odd ? WS_WCOUT : WS_WOUT) + li * SZ_W1K);
                    if (tid == 0) { EA_SET(7, (layer == 0) ? Q.in[0] : Q.out); EA_SET(8, (layer == 0) ? Q.in[1] : Q.out + (size_t)TP * DM); EA_SET(9, Q.out); EA_SET(10, Xb); EA_SET(11, SSP); }
                } else if (sub == 3) {
                    mode = 3; Npos = NGU; g.A = Xb; g.K = 1024; g.Bt = (const bf16_t*)(ws + WS_WGU + layer * SZ_WGU);
                    if (tid == 0) { EA_SET(0, R1); EA_SET(1, SSP); }
                } else {
                    mode = 2; Npos = 1024; g.A = R1; g.K = DFF; g.Bt = (const bf16_t*)(ws + WS_WDN + layer * SZ_WDN);
                    if (tid == 0) { EA_SET(7, Q.out); EA_SET(8, Q.out + (size_t)TP * DM); EA_SET(9, Q.out); EA_SET(10, Xb); EA_SET(11, SSP); }
                }
#undef EA_SET
                g.N = Npos;
                __syncthreads();
                pg8::StaticOrder S; S.init(TP, Npos, G, wg);
                if (mode == 0) { small_gemm<0>(g.A, g.Bt, Npos, g.K, eap, lds, wg, G, wid, lane); Epi<0> E{eap}; pg8::gemm_phase<Epi<0>, true, true>(lds, g, S, E, tid); }
                else if (mode == 1) { small_gemm<1>(g.A, g.Bt, Npos, g.K, eap, lds, wg, G, wid, lane); Epi<1> E{eap}; pg8::gemm_phase<Epi<1>, true, true>(lds, g, S, E, tid); }
                else if (mode == 2) { small_gemm<2>(g.A, g.Bt, Npos, g.K, eap, lds, wg, G, wid, lane); Epi<2> E{eap}; pg8::gemm_phase<Epi<2>, true, true>(lds, g, S, E, tid); }
                else { small_gemm<3>(g.A, g.Bt, Npos, g.K, eap, lds, wg, G, wid, lane); Epi<3> E{eap}; pg8::gemm_phase<Epi<3>, true, true>(lds, g, S, E, tid); }
            }
        }
        if (++rep >= nrep) { rep = 0; ++ph; }
        if (ph < P.ph_hi) { if (ph == 1 && rep == 0) cg::this_grid().sync(); else xcd_barrier(xbar); }
    }
}

extern "C" void kernel_launch(void* const* d_in, const int* in_sizes, int n_in, void* d_out, int out_size, void* d_ws, size_t ws_size, hipStream_t stream) {
    static int grid = 0;
    if (grid == 0) {
        if (n_in != 25 || (size_t)out_size != O_END || ws_size < WS_END) { fprintf(stderr, "kernel_launch: unexpected sizes n_in %d out %d ws %zu (need %zu)\n", n_in, out_size, ws_size, (size_t)WS_END); grid = -1; return; }
        if (hipFuncSetAttribute((const void*)hybrid_fwd, hipFuncAttributeMaxDynamicSharedMemorySize, LDS_BYTES) != hipSuccess) { fprintf(stderr, "kernel_launch: hipFuncSetAttribute failed\n"); grid = -1; return; }
        int dev = 0, cus = 0, per_cu = 0;
        hipGetDevice(&dev); hipDeviceGetAttribute(&cus, hipDeviceAttributeMultiprocessorCount, dev);
        hipOccupancyMaxActiveBlocksPerMultiprocessor(&per_cu, (const void*)hybrid_fwd, 512, LDS_BYTES);
        (void)hipGetLastError();
        if (cus != 256 || per_cu < 1) fprintf(stderr, "kernel_launch: note: cus %d per_cu %d\n", cus, per_cu);
        grid = 256;
    }
    if (grid < 0) return;
    Params p{};
    for (int i = 0; i < 25; ++i) p.in[i] = (const float*)d_in[i];
    p.out = (float*)d_out; p.ws = (unsigned char*)d_ws;
#if MK_MULTI
    for (int ph = 0; ph < NPHASE; ++ph) { p.ph_lo = ph; p.ph_hi = ph + 1; hipLaunchKernelGGL(hybrid_fwd, dim3(grid), dim3(512), LDS_BYTES, stream, p); }
#else
    (void)hipMemsetAsync((char*)d_ws + WS_CTL, 0, CTL_BYTES, stream);
    p.ph_lo = 0; p.ph_hi = NPHASE;
    void* args[] = {&p};
    hipError_t e = hipLaunchCooperativeKernel((const void*)hybrid_fwd, dim3(grid), dim3(512), args, LDS_BYTES, stream);
    if (e != hipSuccess) fprintf(stderr, "cooperative launch failed: %s\n", hipGetErrorString(e));
#endif
}
```

```cpp
#include <hip/hip_runtime.h>
#include <hip/hip_cooperative_groups.h>
#include <cstdio>
#include <cstdint>
namespace cg = cooperative_groups;

#ifndef MK_MULTI
#define MK_MULTI 0
#endif

#ifndef REP_MIX
#define REP_MIX 1
#endif
#ifndef REP_ATT
#define REP_ATT 1
#endif
#ifndef REP_PRO
#define REP_PRO 1
#endif
#ifndef REP_PROJ
#define REP_PROJ 1
#endif
#define LAS __attribute__((address_space(3)))
#define GAS __attribute__((address_space(1)))
typedef unsigned short bf16_t;
typedef short bf16x8 __attribute__((ext_vector_type(8)));
typedef float f32x2 __attribute__((ext_vector_type(2)));
typedef float f32x4 __attribute__((ext_vector_type(4)));
typedef float f32x16 __attribute__((ext_vector_type(16)));
typedef unsigned u32x2 __attribute__((ext_vector_type(2)));
typedef unsigned u32x4 __attribute__((ext_vector_type(4)));

constexpr int DM = 1024, NB = 8, SEQ = 4096, SB = 8, SSEQ = 16, PAST = 2048;
constexpr int TP = NB * SEQ;
constexpr int TS = SB * SSEQ;
constexpr int TR = TP + TS;
constexpr int ABIN = 3616, ABPAD = 3840, DFF = 2816, NGU = 5632, NQKV = 3072, DNQKV = 1536;
constexpr float EPS = 1e-6f;
constexpr float LOG2E = 1.4426950408889634f;

constexpr size_t O_Y = 0;
constexpr size_t O_CONVP = (size_t)TR * DM;
constexpr size_t O_CONVS = O_CONVP + 2 * 8 * 3 * 1536;
constexpr size_t O_DNP = O_CONVS + 2 * 8 * 3 * 1536;
constexpr size_t O_DNS = O_DNP + 2 * 8 * 8 * 64 * 64;
constexpr size_t O_GLAP = O_DNS + 2 * 8 * 8 * 64 * 64;
constexpr size_t O_GLAS = O_GLAP + 2 * 8 * 8 * 32 * 64;
constexpr size_t O_CKP = O_GLAS + 2 * 8 * 8 * 32 * 64;
constexpr size_t O_CKS = O_CKP + (size_t)2 * 8 * 512 * 1024;
constexpr size_t O_CVP = O_CKS + 2 * 8 * 16 * 1024;
constexpr size_t O_CVS = O_CVP + (size_t)2 * 8 * 512 * 1024;
constexpr size_t O_END = O_CVS + 2 * 8 * 16 * 1024;

constexpr size_t SZ_WIN = (size_t)ABPAD * 1024 * 2, SZ_W1K = (size_t)1024 * 1024 * 2, SZ_WQKV = (size_t)NQKV * 1024 * 2, SZ_WGU = (size_t)NGU * 1024 * 2, SZ_WDN = (size_t)1024 * DFF * 2;
constexpr size_t WS_WIN = 0;
constexpr size_t WS_WOUT = WS_WIN + 2 * SZ_WIN;
constexpr size_t WS_WQKV = WS_WOUT + 2 * SZ_W1K;
constexpr size_t WS_WCOUT = WS_WQKV + 2 * SZ_WQKV;
constexpr size_t WS_WGU = WS_WCOUT + 2 * SZ_W1K;
constexpr size_t WS_WDN = WS_WGU + 4 * SZ_WGU;
constexpr size_t WS_XB = WS_WDN + 4 * SZ_WDN;
constexpr size_t WS_R1 = WS_XB + (size_t)TR * 1024 * 2;
constexpr size_t WS_MIX = WS_R1 + (size_t)TR * ABIN * 2;
constexpr size_t WS_GATES = WS_MIX + (size_t)TR * 1024 * 2;
constexpr size_t WS_SSP = WS_GATES + (size_t)TR * 32 * 4;
constexpr size_t WS_CTL = WS_SSP + (size_t)TR * 16 * 4;
constexpr size_t CTL_BYTES = 16384;
constexpr size_t WS_END = WS_CTL + CTL_BYTES;

constexpr int LDS_BYTES = 147456;
constexpr int NPHASE = 24;

struct Params { const float* in[25]; float* out; unsigned char* ws; int ph_lo, ph_hi; };

__device__ __forceinline__ unsigned f2bf(float f) { unsigned u = __builtin_bit_cast(unsigned, f); return (u + 0x7fffu + ((u >> 16) & 1u)) >> 16; }
typedef __bf16 hwbf16x2 __attribute__((ext_vector_type(2)));
__device__ __forceinline__ unsigned pk2(float lo, float hi) { const f32x2 v = {lo, hi}; return __builtin_bit_cast(unsigned, __builtin_convertvector(v, hwbf16x2)); }
__device__ __forceinline__ float bf2f(bf16_t b) { return __builtin_bit_cast(float, ((unsigned)b) << 16); }
template <int CTRL> __device__ __forceinline__ float dppf(float v) { return __builtin_bit_cast(float, __builtin_amdgcn_update_dpp(0, __builtin_bit_cast(int, v), CTRL, 0xF, 0xF, true)); }
__device__ __forceinline__ float quad_sum(float v) { v += dppf<0xB1>(v); v += dppf<0x4E>(v); return v; }
__device__ __forceinline__ float oct_sum(float v) { v = quad_sum(v); v += dppf<0x141>(v); return v; }
__device__ __forceinline__ float wave_sum(float v) {
    v = oct_sum(v); v += dppf<0x140>(v);
    const int i = __builtin_bit_cast(int, v);
    return (__builtin_bit_cast(float, __builtin_amdgcn_readlane(i, 0)) + __builtin_bit_cast(float, __builtin_amdgcn_readlane(i, 16))) +
           (__builtin_bit_cast(float, __builtin_amdgcn_readlane(i, 32)) + __builtin_bit_cast(float, __builtin_amdgcn_readlane(i, 48)));
}
__device__ __forceinline__ float fast_rcp(float x) { return __builtin_amdgcn_rcpf(x); }
__device__ __forceinline__ float silu_f(float x) { return x * fast_rcp(1.0f + __expf(-x)); }
__device__ __forceinline__ float sigmoid_f(float x) { return fast_rcp(1.0f + __expf(-x)); }
__device__ __forceinline__ float softplus_f(float x) { return fmaxf(x, 0.f) + __logf(1.0f + __expf(-fabsf(x))); }

namespace pg8 {
constexpr int BM = 256, BK = 64, HALF = 128, HTB = HALF * BK * 2, STAGE_BYTES = 8 * HTB, NXCD = 8, WGM = 8;
__host__ __device__ __forceinline__ int lds_byte(int r, int c) { const int st = (r >> 4) * 2 + (c >> 5), rr = r & 15, cc = c & 31, ob = rr * 64 + cc * 2; return st * 1024 + (ob ^ (((ob >> 9) & 1) << 5)); }
__host__ __device__ __forceinline__ void stage_rc(int b, int& R, int& C) { const int st = b / 1024, sb = b % 1024, swz = sb ^ (((sb >> 9) & 1) << 5); R = (st >> 1) * 16 + swz / 64; C = (st & 1) * 32 + (swz % 64) / 2; }
__host__ __device__ __forceinline__ int perm32(int rho) { const int n = rho >> 4, i = rho & 15; return 8 * (i >> 2) + 4 * n + (i & 3); }
struct Unit { int pm, pn; };
struct Gemm { const bf16_t* A; const bf16_t* Bt; int M, N, K; };
struct StaticOrder {
    int nM, nN, nwg, G, c;
    __host__ __device__ void init(int M, int N, int G_, int c_) { nM = M / BM; nN = N / BM; nwg = nM * nN; G = G_; c = c_; }
    __host__ __device__ bool next(int i, Unit& u) const {
        const long L = (long)i * G + c; if (L >= nwg) return false;
        int wgid = (int)L; { const int q = nwg / NXCD, r = nwg % NXCD, xcd = wgid % NXCD, off = wgid / NXCD; wgid = (xcd < r ? xcd * (q + 1) : r * (q + 1) + (xcd - r) * q) + off; }
        const int nig = WGM * nN, gid = wgid / nig, fm = gid * WGM, gsz = (nM - fm) < WGM ? (nM - fm) : WGM;
        u.pm = fm + ((wgid % nig) % gsz); u.pn = (wgid % nig) / gsz; return true;
    }
};

template <class Epi, bool ALIGN_EPI, bool SP2>
__device__ __forceinline__ void gemm_phase(LAS unsigned char* lds, const Gemm g, const StaticOrder& S, const Epi& E, const int tid) {
    const int wid = __builtin_amdgcn_readfirstlane(tid >> 6), lane = tid & 63, wr = wid >> 2, wc = wid & 3, fr = lane & 15, fq = lane >> 4;
    const int K = g.K, nt = K / BK;
    unsigned voffA[2], voffB[2];
#pragma unroll
    for (int i = 0; i < 2; ++i) { int R, C; stage_rc(tid * 16 + i * 8192, R, C); voffA[i] = (unsigned)(R * K + C) * 2u; voffB[i] = (unsigned)(R * K + C) * 2u; }
    const size_t kstep = (size_t)(BK * 2);
    const size_t hstep = (size_t)HALF * K * 2;
    const size_t tstep = 2 * hstep;
    const unsigned ldsw = (unsigned)wid * 1024u;
    const int aoff = lds_byte(wr * 64 + fr, fq * 8), boff = lds_byte(wc * 32 + fr, fq * 8);
#define PG8_SA(b, h) (((b) * 2 + (h)) * HTB)
#define PG8_SB(b, h) ((4 + (b) * 2 + (h)) * HTB)
#define PG8_STAGE(bufoff, gbase, voff) do { _Pragma("unroll") for (int _i = 0; _i < 2; ++_i) \
        __builtin_amdgcn_global_load_lds((const unsigned*)((const char*)(gbase) + (voff)[_i]), (LAS unsigned*)(lds + (bufoff) + ldsw + _i * 8192), 16, 0, 0); } while (0)
#define PG8_LDA(dst, b, h) do { _Pragma("unroll") for (int m = 0; m < 4; ++m) _Pragma("unroll") for (int k = 0; k < 2; ++k) dst[m][k] = *(const LAS bf16x8*)(lds + PG8_SA(b, h) + aoff + m * 2048 + k * 1024); } while (0)
#define PG8_LDB(dst, b, h) do { _Pragma("unroll") for (int n = 0; n < 2; ++n) _Pragma("unroll") for (int k = 0; k < 2; ++k) dst[n][k] = *(const LAS bf16x8*)(lds + PG8_SB(b, h) + boff + n * 2048 + k * 1024); } while (0)
#define PG8_MMA(ai, bj, At, Bt) do { __builtin_amdgcn_s_setprio(1); _Pragma("unroll") for (int m = 0; m < 4; ++m) _Pragma("unroll") for (int n = 0; n < 2; ++n) _Pragma("unroll") for (int k = 0; k < 2; ++k) \
        acc[ai][bj][m][n] = __builtin_amdgcn_mfma_f32_16x16x32_bf16(Bt[n][k], At[m][k], acc[ai][bj][m][n], 0, 0, 0); __builtin_amdgcn_s_setprio(0); } while (0)
#define PG8_WAIT_V(n) asm volatile("s_waitcnt vmcnt(" #n ")" ::: "memory")
#define PG8_WAIT_L(n) asm volatile("s_waitcnt lgkmcnt(" #n ")" ::: "memory")
#define PG8_BAR __builtin_amdgcn_s_barrier()
#define PG8_SCHED __builtin_amdgcn_sched_barrier(0)
    Unit cur, nxt; int ui = 0;
    if (!S.next(0, cur)) return;
    f32x4 acc[2][2][4][2];
#pragma unroll
    for (int a = 0; a < 2; ++a)
#pragma unroll
        for (int b = 0; b < 2; ++b)
#pragma unroll
            for (int m = 0; m < 4; ++m)
#pragma unroll
                for (int n = 0; n < 2; ++n) acc[a][b][m][n] = (f32x4){0.f, 0.f, 0.f, 0.f};
    bf16x8 At[4][2], B0[2][2], B1[2][2];
    const char* cA = (const char*)g.A + (size_t)cur.pm * tstep; const char* cB = (const char*)g.Bt + (size_t)cur.pn * tstep;
    if constexpr (SP2) {
        PG8_STAGE(PG8_SB(0, 0), cB, voffB); PG8_STAGE(PG8_SB(0, 1), cB + hstep, voffB); PG8_STAGE(PG8_SA(0, 0), cA, voffA); PG8_STAGE(PG8_SA(0, 1), cA + hstep, voffA);
        if (wr == 1) PG8_BAR;
        PG8_WAIT_V(2); PG8_BAR;
        PG8_STAGE(PG8_SB(1, 0), cB + kstep, voffB); PG8_STAGE(PG8_SA(1, 0), cA + kstep, voffA); PG8_STAGE(PG8_SB(1, 1), cB + hstep + kstep, voffB);
        PG8_WAIT_V(6); PG8_BAR;
    } else {
        PG8_STAGE(PG8_SB(0, 0), cB, voffB); PG8_STAGE(PG8_SA(0, 0), cA, voffA); PG8_STAGE(PG8_SB(0, 1), cB + hstep, voffB); PG8_STAGE(PG8_SA(0, 1), cA + hstep, voffA);
        if (wr == 1) PG8_BAR;
        PG8_WAIT_V(4); PG8_BAR;
        PG8_STAGE(PG8_SB(1, 0), cB + kstep, voffB); PG8_STAGE(PG8_SA(1, 0), cA + kstep, voffA); PG8_STAGE(PG8_SB(1, 1), cB + hstep + kstep, voffB);
        PG8_WAIT_V(6); PG8_BAR;
    }
    for (;;) {
        const bool has_next = S.next(ui + 1, nxt);
        const char* nA = has_next ? (const char*)g.A + (size_t)nxt.pm * tstep : cA; const char* nB = has_next ? (const char*)g.Bt + (size_t)nxt.pn * tstep : cB;
        for (int t = 0; t < nt; t += 2) {
            const bool last = (t == nt - 2);
            const char* a1 = cA + (size_t)(t + 1) * kstep;
            const char* a2 = last ? nA : cA + (size_t)(t + 2) * kstep; const char* b2 = last ? nB : cB + (size_t)(t + 2) * kstep;
            const char* a3 = a2 + kstep; const char* b3 = b2 + kstep;
            if constexpr (SP2) {
            PG8_LDB(B0, 0, 0); PG8_LDB(B1, 0, 1); PG8_SCHED; PG8_LDA(At, 0, 0); PG8_STAGE(PG8_SA(1, 1), a1 + hstep, voffA);
            PG8_WAIT_V(8); PG8_WAIT_L(0); PG8_BAR; PG8_MMA(0, 0, At, B0); PG8_MMA(0, 1, At, B1); PG8_BAR; PG8_SCHED;
            PG8_LDA(At, 0, 1); PG8_STAGE(PG8_SB(0, 0), b2, voffB); PG8_STAGE(PG8_SB(0, 1), b2 + hstep, voffB); PG8_STAGE(PG8_SA(0, 0), a2, voffA);
            PG8_WAIT_V(8); PG8_WAIT_L(0); PG8_BAR; PG8_MMA(1, 0, At, B0); PG8_MMA(1, 1, At, B1); PG8_BAR; PG8_SCHED;
            PG8_LDB(B0, 1, 0); PG8_LDB(B1, 1, 1); PG8_SCHED; PG8_LDA(At, 1, 0); PG8_STAGE(PG8_SA(0, 1), a2 + hstep, voffA);
            PG8_WAIT_V(8); PG8_WAIT_L(0); PG8_BAR; PG8_MMA(0, 0, At, B0); PG8_MMA(0, 1, At, B1); PG8_BAR; PG8_SCHED;
            PG8_LDA(At, 1, 1); PG8_STAGE(PG8_SB(1, 0), b3, voffB); PG8_STAGE(PG8_SB(1, 1), b3 + hstep, voffB); PG8_STAGE(PG8_SA(1, 0), a3, voffA);
            PG8_WAIT_V(8); PG8_WAIT_L(0); PG8_BAR; PG8_MMA(1, 0, At, B0); PG8_MMA(1, 1, At, B1); PG8_BAR; PG8_SCHED;
            } else {
            PG8_LDB(B0, 0, 0); PG8_SCHED; PG8_LDA(At, 0, 0); PG8_STAGE(PG8_SA(1, 1), a1 + hstep, voffA);
            PG8_WAIT_L(8); PG8_BAR; PG8_WAIT_L(0); PG8_MMA(0, 0, At, B0); PG8_BAR; PG8_SCHED;
            PG8_LDB(B1, 0, 1); PG8_STAGE(PG8_SB(0, 0), b2, voffB);
            PG8_BAR; PG8_WAIT_L(0); PG8_MMA(0, 1, At, B1); PG8_BAR;
            PG8_LDA(At, 0, 1); PG8_STAGE(PG8_SA(0, 0), a2, voffA);
            PG8_BAR; PG8_WAIT_L(0); PG8_MMA(1, 0, At, B0); PG8_BAR; PG8_SCHED;
            PG8_STAGE(PG8_SB(0, 1), b2 + hstep, voffB);
            PG8_WAIT_V(6); PG8_BAR; PG8_MMA(1, 1, At, B1); PG8_BAR;
            PG8_LDB(B0, 1, 0); PG8_SCHED; PG8_LDA(At, 1, 0); PG8_STAGE(PG8_SA(0, 1), a2 + hstep, voffA);
            PG8_WAIT_L(8); PG8_BAR; PG8_WAIT_L(0); PG8_MMA(0, 0, At, B0); PG8_BAR; PG8_SCHED;
            PG8_LDB(B1, 1, 1); PG8_STAGE(PG8_SB(1, 0), b3, voffB);
            PG8_BAR; PG8_WAIT_L(0); PG8_MMA(0, 1, At, B1); PG8_BAR;
            PG8_LDA(At, 1, 1); PG8_STAGE(PG8_SA(1, 0), a3, voffA);
            PG8_BAR; PG8_WAIT_L(0); PG8_MMA(1, 0, At, B0); PG8_BAR; PG8_SCHED;
            PG8_STAGE(PG8_SB(1, 1), b3 + hstep, voffB);
            PG8_WAIT_V(6); PG8_BAR; PG8_MMA(1, 1, At, B1); PG8_BAR;
            }
        }
        if constexpr (ALIGN_EPI) { if (wr == 0) PG8_BAR; }
        E(acc, cur, wr, wc, fr, fq);
        if (!has_next) break;
#pragma unroll
        for (int a = 0; a < 2; ++a)
#pragma unroll
            for (int b = 0; b < 2; ++b)
#pragma unroll
                for (int m = 0; m < 4; ++m)
#pragma unroll
                    for (int n = 0; n < 2; ++n) acc[a][b][m][n] = (f32x4){0.f, 0.f, 0.f, 0.f};
        cur = nxt; cA = nA; cB = nB; ++ui;
        if constexpr (ALIGN_EPI) { if (wr == 1) PG8_BAR; }
    }
    PG8_WAIT_V(0);
    if constexpr (!ALIGN_EPI) { if (wr == 0) PG8_BAR; }
    PG8_BAR;
#undef PG8_SA
#undef PG8_SB
#undef PG8_STAGE
#undef PG8_LDA
#undef PG8_LDB
#undef PG8_MMA
#undef PG8_WAIT_V
#undef PG8_WAIT_L
#undef PG8_BAR
#undef PG8_SCHED
}
}

struct EpiArgs {
    GAS bf16_t* out; const GAS float* ssp; GAS float* gates; GAS float* o0; GAS float* o1; GAS float* o2; GAS float* o3;
    const GAS float* base_p; const GAS float* base_s; GAS float* X; GAS bf16_t* Xb; GAS float* ssp_out;
};
__device__ __forceinline__ float row_rstd(const GAS float* ssp, int row) {
    const GAS f32x4* p = (const GAS f32x4*)(ssp + (size_t)row * 16);
    const f32x4 a = p[0], b = p[1], c = p[2], d = p[3];
    const float s = ((a[0] + a[1]) + (a[2] + a[3])) + ((b[0] + b[1]) + (b[2] + b[3])) + ((c[0] + c[1]) + (c[2] + c[3])) + ((d[0] + d[1]) + (d[2] + d[3]));
    return rsqrtf(s * (1.0f / 1024.0f) + EPS);
}
template <int MODE, bool SMALL>
__device__ __forceinline__ float epi_apply(const EpiArgs& a, int row, int g32, int fq, f32x4 v0, f32x4 v1, float rstd) {
    const int c0 = 32 * g32 + 8 * fq;
    if constexpr (MODE == 0) {
        if (g32 >= ABIN / 32) return 0.f;
        v0 *= rstd; v1 *= rstd;
        u32x4 w; w.x = pk2(v0[0], v0[1]); w.y = pk2(v0[2], v0[3]); w.z = pk2(v1[0], v1[1]); w.w = pk2(v1[2], v1[3]);
        *(GAS u32x4*)(a.out + (size_t)row * ABIN + c0) = w;
        if (g32 == 48 && fq < 2) { GAS float* gp = a.gates + (size_t)row * 32 + 8 * fq; *(GAS f32x4*)gp = v0; *(GAS f32x4*)(gp + 4) = v1; }
        if (g32 == 96 && fq >= 2) { GAS float* gp = a.gates + (size_t)row * 32 + 16 + 8 * (fq - 2); *(GAS f32x4*)gp = v0; *(GAS f32x4*)(gp + 4) = v1; }
        if (c0 < DNQKV) {
            if constexpr (!SMALL) { const int t = row & (SEQ - 1), b = row >> 12; if (t >= SEQ - 3) { GAS float* d = a.o0 + (size_t)(b * 3 + (t - (SEQ - 3))) * DNQKV + c0; *(GAS f32x4*)d = v0; *(GAS f32x4*)(d + 4) = v1; } }
            else { const int r = row - TP, t = r & 15, b = r >> 4; if (t >= SSEQ - 3) { GAS float* d = a.o1 + (size_t)(b * 3 + (t - (SSEQ - 3))) * DNQKV + c0; *(GAS f32x4*)d = v0; *(GAS f32x4*)(d + 4) = v1; } }
        }
        return 0.f;
    } else if constexpr (MODE == 1) {
        v0 *= rstd; v1 *= rstd;
        u32x4 w; w.x = pk2(v0[0], v0[1]); w.y = pk2(v0[2], v0[3]); w.z = pk2(v1[0], v1[1]); w.w = pk2(v1[2], v1[3]);
        *(GAS u32x4*)(a.out + (size_t)row * NQKV + c0) = w;
        if (c0 >= 1024) {
            const int isv = c0 >= 2048, cc = c0 - 1024 - 1024 * isv;
            if constexpr (!SMALL) { const int t = row & (SEQ - 1), b = row >> 12; if (t >= SEQ - 512) { GAS float* d = a.o0 + (size_t)isv * (O_CVP - O_CKP) + (size_t)(b * 512 + (t - (SEQ - 512))) * 1024 + cc; *(GAS f32x4*)d = v0; *(GAS f32x4*)(d + 4) = v1; } }
            else { const int r = row - TP; GAS float* d = a.o2 + (size_t)isv * (O_CVS - O_CKS) + (size_t)r * 1024 + cc; *(GAS f32x4*)d = v0; *(GAS f32x4*)(d + 4) = v1; }
        }
        return 0.f;
    } else if constexpr (MODE == 2) {
        const GAS float* bp = SMALL ? a.base_s + (size_t)(row - TP) * DM + c0 : a.base_p + (size_t)row * DM + c0;
        const f32x4 x0 = *(const GAS f32x4*)bp + v0, x1 = *(const GAS f32x4*)(bp + 4) + v1;
        GAS float* xp = a.X + (size_t)row * DM + c0; *(GAS f32x4*)xp = x0; *(GAS f32x4*)(xp + 4) = x1;
        u32x4 w; w.x = pk2(x0[0], x0[1]); w.y = pk2(x0[2], x0[3]); w.z = pk2(x1[0], x1[1]); w.w = pk2(x1[2], x1[3]);
        *(GAS u32x4*)(a.Xb + (size_t)row * DM + c0) = w;
        return ((x0[0] * x0[0] + x0[1] * x0[1]) + (x0[2] * x0[2] + x0[3] * x0[3])) + ((x1[0] * x1[0] + x1[1] * x1[1]) + (x1[2] * x1[2] + x1[3] * x1[3]));
    } else {
        v0 *= rstd; v1 *= rstd;
        float h[4];
#pragma unroll
        for (int j = 0; j < 4; ++j) h[j] = silu_f(v0[j]) * v1[j];
        u32x2 w; w.x = pk2(h[0], h[1]); w.y = pk2(h[2], h[3]);
        *(GAS u32x2*)(a.out + (size_t)row * DFF + 16 * g32 + 4 * fq) = w;
        return 0.f;
    }
}
constexpr int EA_OFF = 131072 + 512;
__device__ __forceinline__ EpiArgs load_ea(const LAS unsigned long long* ap) {
    EpiArgs a;
    a.out = (GAS bf16_t*)ap[0]; a.ssp = (const GAS float*)ap[1]; a.gates = (GAS float*)ap[2]; a.o0 = (GAS float*)ap[3]; a.o1 = (GAS float*)ap[4]; a.o2 = (GAS float*)ap[5]; a.o3 = (GAS float*)ap[6];
    a.base_p = (const GAS float*)ap[7]; a.base_s = (const GAS float*)ap[8]; a.X = (GAS float*)ap[9]; a.Xb = (GAS bf16_t*)ap[10]; a.ssp_out = (GAS float*)ap[11];
    return a;
}
template <int MODE> struct Epi {
    const LAS unsigned long long* ap;
    __device__ __forceinline__ void operator()(const f32x4 (&acc)[2][2][4][2], const pg8::Unit& u, int wr, int wc, int fr, int fq) const {
        const EpiArgs a = load_ea(ap);
        if constexpr (MODE != 2) {
            f32x4 pq[2][4]; float rs[2][4];
#pragma unroll
            for (int ai = 0; ai < 2; ++ai)
#pragma unroll
                for (int m = 0; m < 4; ++m) { const int row = u.pm * 256 + ai * 128 + wr * 64 + m * 16 + fr; pq[ai][m] = *(const GAS f32x4*)(a.ssp + (size_t)row * 16 + 4 * fq); }
#pragma unroll
            for (int ai = 0; ai < 2; ++ai)
#pragma unroll
                for (int m = 0; m < 4; ++m) { float sp = (pq[ai][m][0] + pq[ai][m][1]) + (pq[ai][m][2] + pq[ai][m][3]); sp += __shfl_xor(sp, 16); sp += __shfl_xor(sp, 32); rs[ai][m] = rsqrtf(sp * (1.0f / 1024.0f) + EPS); }
#pragma unroll
            for (int ai = 0; ai < 2; ++ai)
#pragma unroll
                for (int m = 0; m < 4; ++m) {
                    const int row = u.pm * 256 + ai * 128 + wr * 64 + m * 16 + fr;
#pragma unroll
                    for (int bj = 0; bj < 2; ++bj) { const int g32 = (u.pn * 256 + bj * 128 + wc * 32) >> 5; (void)epi_apply<MODE, false>(a, row, g32, fq, acc[ai][bj][m][0], acc[ai][bj][m][1], rs[ai][m]); }
                }
        } else {
#pragma unroll
            for (int g2 = 0; g2 < 4; ++g2) {
                const int ai = g2 >> 1, m0 = (g2 & 1) * 2;
                f32x4 bs[2][2][2];
#pragma unroll
                for (int mm = 0; mm < 2; ++mm)
#pragma unroll
                    for (int bj = 0; bj < 2; ++bj) { const int row = u.pm * 256 + ai * 128 + wr * 64 + (m0 + mm) * 16 + fr, c0 = u.pn * 256 + bj * 128 + wc * 32 + 8 * fq;
                        const GAS float* bp = a.base_p + (size_t)row * DM + c0; bs[mm][bj][0] = *(const GAS f32x4*)bp; bs[mm][bj][1] = *(const GAS f32x4*)(bp + 4); }
#pragma unroll
                for (int mm = 0; mm < 2; ++mm) {
                    const int m = m0 + mm, row = u.pm * 256 + ai * 128 + wr * 64 + m * 16 + fr; float ss = 0.f;
#pragma unroll
                    for (int bj = 0; bj < 2; ++bj) { const int c0 = u.pn * 256 + bj * 128 + wc * 32 + 8 * fq;
                        const f32x4 x0 = bs[mm][bj][0] + acc[ai][bj][m][0], x1 = bs[mm][bj][1] + acc[ai][bj][m][1];
                        GAS float* xp = a.X + (size_t)row * DM + c0; *(GAS f32x4*)xp = x0; *(GAS f32x4*)(xp + 4) = x1;
                        u32x4 w; w.x = pk2(x0[0], x0[1]); w.y = pk2(x0[2], x0[3]); w.z = pk2(x1[0], x1[1]); w.w = pk2(x1[2], x1[3]);
                        *(GAS u32x4*)(a.Xb + (size_t)row * DM + c0) = w;
                        ss += ((x0[0] * x0[0] + x0[1] * x0[1]) + (x0[2] * x0[2] + x0[3] * x0[3])) + ((x1[0] * x1[0] + x1[1] * x1[1]) + (x1[2] * x1[2] + x1[3] * x1[3])); }
                    ss += __shfl_xor(ss, 16); ss += __shfl_xor(ss, 32); if (fq == 0) a.ssp_out[(size_t)row * 16 + u.pn * 4 + wc] = ss;
                }
            }
        }
    }
};

template <int MODE>
__device__ __forceinline__ void small_gemm(const bf16_t* A, const bf16_t* Bt, int Npos, int K, const LAS unsigned long long* eap, LAS unsigned char* lds, int wg, int G, int wid, int lane) {
    const int fr = lane & 15, fq = lane >> 4, ncg = (MODE == 0 ? (ABIN + 63) / 64 : Npos / 64), nunits = (TS / 16) * ncg, KW = K / 8;
    LAS f32x4* part = (LAS f32x4*)lds;
    for (int u = wg; u < nunits; u += G) {
        const int rb = u % (TS / 16), cgp = u / (TS / 16), r0 = TP + rb * 16, p0 = cgp * 64;
        f32x4 acc[4];
#pragma unroll
        for (int f = 0; f < 4; ++f) acc[f] = (f32x4){0.f, 0.f, 0.f, 0.f};
        const bf16_t* ap = A + (size_t)(r0 + fr) * K + wid * KW + 8 * fq;
        const bf16_t* bp = Bt + (size_t)(p0 + fr) * K + wid * KW + 8 * fq;
        for (int k0 = 0; k0 < KW; k0 += 32) {
            const bf16x8 av = *(const bf16x8*)(ap + k0);
            bf16x8 wv[4];
#pragma unroll
            for (int f = 0; f < 4; ++f) wv[f] = *(const bf16x8*)(bp + (size_t)(16 * f) * K + k0);
#pragma unroll
            for (int f = 0; f < 4; ++f) acc[f] = __builtin_amdgcn_mfma_f32_16x16x32_bf16(wv[f], av, acc[f], 0, 0, 0);
        }
#pragma unroll
        for (int f = 0; f < 4; ++f) part[(wid * 4 + f) * 64 + lane] = acc[f];
        __syncthreads();
        if (wid == 0) {
#pragma unroll
            for (int w = 1; w < 8; ++w)
#pragma unroll
                for (int f = 0; f < 4; ++f) acc[f] += part[(w * 4 + f) * 64 + lane];
            const int row = r0 + fr;
            const EpiArgs a = load_ea(eap);
            float rstd = 1.f; if constexpr (MODE != 2) rstd = row_rstd(a.ssp, row);
            float ss = 0.f;
#pragma unroll
            for (int gq = 0; gq < 2; ++gq) ss += epi_apply<MODE, true>(a, row, (p0 >> 5) + gq, fq, acc[2 * gq], acc[2 * gq + 1], rstd);
            if constexpr (MODE == 2) { ss += __shfl_xor(ss, 16); ss += __shfl_xor(ss, 32); if (fq == 0) a.ssp_out[(size_t)row * 16 + cgp] = ss; }
        }
        __syncthreads();
    }
}

__device__ __forceinline__ void transpose_item(const float* W, int K, int Nsrc, int gu, const float* gamma, bf16_t* WT, LAS float* scr, int item, int npb, int lane) {
    const int kb = item / npb, nb = item % npb, k0 = 64 * kb, p0 = 32 * nb;
    const int cl = p0 + pg8::perm32(lane & 31);
    int src = cl; if (gu) src = ((cl >> 2) & 1) * DFF + 4 * (cl >> 3) + (cl & 3);
    const bool valid = src < Nsrc;
    const int srcc = valid ? src : 0; const float vmask = valid ? 1.f : 0.f;
    float wv[32];
#pragma unroll
    for (int i = 0; i < 32; ++i) wv[i] = W[(size_t)(k0 + 2 * i + (lane >> 5)) * Nsrc + srcc];
    if (gamma) {
#pragma unroll
        for (int i = 0; i < 32; ++i) wv[i] *= gamma[k0 + 2 * i + (lane >> 5)];
    }
#pragma unroll
    for (int i = 0; i < 32; ++i) scr[(2 * i + (lane >> 5)) * 33 + (lane & 31)] = wv[i] * vmask;
    asm volatile("s_waitcnt lgkmcnt(0)" ::: "memory");
    const int c = lane & 7;
#pragma unroll
    for (int j = 0; j < 4; ++j) { const int n = (lane >> 3) + 8 * j; const LAS float* s = scr + (8 * c) * 33 + n;
        u32x4 o; o.x = pk2(s[0 * 33], s[1 * 33]); o.y = pk2(s[2 * 33], s[3 * 33]); o.z = pk2(s[4 * 33], s[5 * 33]); o.w = pk2(s[6 * 33], s[7 * 33]);
        *(u32x4*)(WT + (size_t)(p0 + n) * K + k0 + 8 * c) = o; }
    asm volatile("s_waitcnt lgkmcnt(0)" ::: "memory");
}
__device__ __forceinline__ void convert_matrix(const float* W, int K, int Nsrc, int Npos, int gu, const float* gamma, bf16_t* WT, LAS float* scr, int gw, int ngw, int lane) {
    const int npb = Npos / 32, nitems = (K / 64) * npb;
    for (int it = gw; it < nitems; it += ngw) transpose_item(W, K, Nsrc, gu, gamma, WT, scr, it, npb, lane);
}
__device__ __forceinline__ void convert_mats(const Params& P, LAS unsigned char* lds, int m_lo, int m_hi, int gw, int ngw, int wid, int lane) {
    LAS float* scr = (LAS float*)(lds + wid * 8704);
    unsigned char* ws = P.ws;
    for (int mi = m_lo; mi < m_hi; ++mi) {
        int type, idx;
        if (mi < 4) { type = (mi == 0) ? 0 : (mi == 1) ? 1 : (mi == 2) ? 4 : 5; idx = 0; }
        else { const int r = mi - 4, grp = r >> 2, q = r & 3;
            if (q >= 2) { type = q + 2; idx = grp + 1; } else if (grp == 1) { type = q; idx = 1; } else { type = 2 + q; idx = grp >> 1; } }
        const float* W; const float* gamma = nullptr; bf16_t* WT; int K = 1024, Nsrc, Npos, gu = 0;
        if (type == 0) { W = P.in[8] + (size_t)idx * 1024 * ABIN; gamma = P.in[7] + idx * 1024; WT = (bf16_t*)(ws + WS_WIN + idx * SZ_WIN); Nsrc = ABIN; Npos = ABPAD; }
        else if (type == 1) { W = P.in[16] + (size_t)idx * 1024 * 1024; WT = (bf16_t*)(ws + WS_WOUT + idx * SZ_W1K); Nsrc = 1024; Npos = 1024; }
        else if (type == 2) { W = P.in[18] + (size_t)idx * 1024 * NQKV; gamma = P.in[17] + idx * 1024; WT = (bf16_t*)(ws + WS_WQKV + idx * SZ_WQKV); Nsrc = NQKV; Npos = NQKV; }
        else if (type == 3) { W = P.in[20] + (size_t)idx * 1024 * 1024; WT = (bf16_t*)(ws + WS_WCOUT + idx * SZ_W1K); Nsrc = 1024; Npos = 1024; }
        else if (type == 4) { W = P.in[22] + (size_t)idx * 1024 * NGU; gamma = P.in[21] + idx * 1024; WT = (bf16_t*)(ws + WS_WGU + idx * SZ_WGU); Nsrc = NGU; Npos = NGU; gu = 1; }
        else { W = P.in[23] + (size_t)idx * DFF * 1024; WT = (bf16_t*)(ws + WS_WDN + idx * SZ_WDN); K = DFF; Nsrc = 1024; Npos = 1024; }
        convert_matrix(W, K, Nsrc, Npos, gu, gamma, WT, scr, gw, ngw, lane);
    }
}
__device__ __forceinline__ void phase_prologue(const Params& P, LAS unsigned char* lds, int gw, int ngw, int wid, int lane) {
    convert_mats(P, lds, 0, 1, gw, ngw, wid, lane);
    unsigned char* ws = P.ws;
    bf16_t* Xb = (bf16_t*)(ws + WS_XB); float* ssp = (float*)(ws + WS_SSP);
    for (int row = gw; row < TR; row += ngw) {
        const float* xr = (row < TP) ? P.in[0] + (size_t)row * DM : P.in[1] + (size_t)(row - TP) * DM;
        f32x4 v[4]; float s = 0.f;
#pragma unroll
        for (int j = 0; j < 4; ++j) { v[j] = ((const f32x4*)xr)[lane + 64 * j]; s += (v[j][0] * v[j][0] + v[j][1] * v[j][1]) + (v[j][2] * v[j][2] + v[j][3] * v[j][3]); }
        s = wave_sum(s);
#pragma unroll
        for (int j = 0; j < 4; ++j) { u32x2 w; w.x = pk2(v[j][0], v[j][1]); w.y = pk2(v[j][2], v[j][3]); ((u32x2*)(Xb + (size_t)row * DM))[lane + 64 * j] = w; }
        if (lane < 16) ssp[(size_t)row * 16 + lane] = (lane == 0) ? s : 0.f;
    }
}
__device__ __forceinline__ void phase_final(const Params& P, int gw, int ngw, int lane) {
    const GAS float* ssp = (const GAS float*)(P.ws + WS_SSP); const float* g = P.in[24];
    f32x4 gv[4];
#pragma unroll
    for (int j = 0; j < 4; ++j) gv[j] = ((const f32x4*)g)[lane + 64 * j];
    for (int row = gw; row < TR; row += ngw) {
        const float rstd = row_rstd(ssp, row);
        f32x4* xr = (f32x4*)(P.out + (size_t)row * DM);
#pragma unroll
        for (int j = 0; j < 4; ++j) { f32x4 v = xr[lane + 64 * j]; xr[lane + 64 * j] = v * rstd * gv[j]; }
    }
}

constexpr int MX_CH = 32;
#define LDS_BARRIER() asm volatile("s_waitcnt lgkmcnt(0)\n\ts_barrier" ::: "memory")
__device__ __forceinline__ void delta_unit(const Params& P, LAS unsigned char* lds, int li, bool sample, int b, int h, int half, const int tid) {
    const int lane = tid & 63, wid = __builtin_amdgcn_readfirstlane(tid >> 6);
    const int L = sample ? SSEQ : SEQ, rowbase = sample ? TP + b * SSEQ : b * SEQ;
    const bf16_t* PROJ = (const bf16_t*)(P.ws + WS_R1); const float* GATES = (const float*)(P.ws + WS_GATES); bf16_t* MIX = (bf16_t*)(P.ws + WS_MIX);
    const int NC = (L + MX_CH - 1) / MX_CH;
    constexpr int SET = 4 * 8192 + 256;
    if (wid < 4) __builtin_amdgcn_s_setprio(2);
    const int e = 32 * half + (wid & 3) * 8 + (lane >> 3), dq = lane & 7;
    f32x2 S[4];
    float* sout = P.out + (sample ? O_DNS : O_DNP) + (size_t)((li * 8 + b) * 8 + h) * 4096;
    if (wid < 4) {
        if (sample) { const float* s0 = P.in[3] + (size_t)((li * 8 + b) * 8 + h) * 4096;
#pragma unroll
            for (int j = 0; j < 4; ++j) { S[j][0] = s0[(8 * dq + 2 * j) * 64 + e]; S[j][1] = s0[(8 * dq + 2 * j + 1) * 64 + e]; } }
        else {
#pragma unroll
            for (int j = 0; j < 4; ++j) S[j] = (f32x2){0.f, 0.f}; }
    }
    const int pw = wid - 4, c = lane;
    float cwq[4], cwk[4], cwv[4], alog = 0.f, dtb = 0.f;
    float rq[11], rk[11], rv[11], ga = 0.f, gb_ = 0.f;
    if (wid >= 4) {
        const float* cw = P.in[9] + (size_t)li * 4 * DNQKV;
#pragma unroll
        for (int t = 0; t < 4; ++t) { cwq[t] = cw[t * DNQKV + h * 64 + c]; cwk[t] = cw[t * DNQKV + 512 + h * 64 + c]; cwv[t] = cw[t * DNQKV + 1024 + h * 64 + c]; }
        alog = P.in[10][li * 8 + h]; dtb = P.in[11][li * 8 + h];
    }
#define DN_LOADS(jn) do { const int t0n_ = (jn) * MX_CH + pw * 8; if ((jn) < NC && t0n_ < L) { \
        _Pragma("unroll") for (int r = 0; r < 11; ++r) { const int t = t0n_ - 3 + r, tc = max(t, 0); const bf16_t* pr = PROJ + (size_t)(rowbase + tc) * ABIN + h * 64 + c; \
            const float m = (t >= 0) ? 1.f : 0.f; rq[r] = bf2f(pr[0]) * m; rk[r] = bf2f(pr[512]) * m; rv[r] = bf2f(pr[1024]) * m; } \
        { const float* gp = GATES + (size_t)(rowbase + t0n_ + (lane & 7)) * 32; ga = gp[h]; gb_ = gp[8 + h]; } \
        if (sample && t0n_ == 0) { _Pragma("unroll") for (int r = 0; r < 3; ++r) { const float* cb = P.in[2] + (size_t)((li * 8 + b) * 3 + r) * DNQKV + h * 64 + c; rq[r] = cb[0]; rk[r] = cb[512]; rv[r] = cb[1024]; } } } } while (0)
    if (wid >= 4) DN_LOADS(0);
    for (int j = 0; j < NC + 2; ++j) {
        if (wid >= 4) {
            if (j < NC) {
                LAS float* qs = (LAS float*)(lds + (j & 1) * SET); LAS float* ks = qs + 2048; LAS float* vs = qs + 4096; LAS float* sc = qs + 8192;
                const int t0 = j * MX_CH + pw * 8;
                if (t0 < L) {
#pragma unroll
                    for (int i = 0; i < 8; ++i) {
                        float q = cwq[0] * rq[i] + cwq[1] * rq[i + 1] + cwq[2] * rq[i + 2] + cwq[3] * rq[i + 3];
                        float k = cwk[0] * rk[i] + cwk[1] * rk[i + 1] + cwk[2] * rk[i + 2] + cwk[3] * rk[i + 3];
                        float v = cwv[0] * rv[i] + cwv[1] * rv[i + 1] + cwv[2] * rv[i + 2] + cwv[3] * rv[i + 3];
                        q = silu_f(q); k = silu_f(k); v = silu_f(v);
                        const float sq = wave_sum(q * q), sk = wave_sum(k * k);
                        const int tok = pw * 8 + i;
                        qs[tok * 64 + c] = q * rsqrtf(sq + EPS) * 0.125f; ks[tok * 64 + c] = k * rsqrtf(sk + EPS); vs[tok * 64 + c] = v;
                    }
                    if (lane < 8) { const float g = -__expf(alog) * softplus_f(ga + dtb); sc[(pw * 8 + lane) * 2] = __expf(g); sc[(pw * 8 + lane) * 2 + 1] = sigmoid_f(gb_); }
                }
            }
            DN_LOADS(j + 1);
            if (j >= 2) {
                LAS float* os = (LAS float*)(lds + (j & 1) * SET) + 6144;
                const int t0 = (j - 2) * MX_CH + pw * 8;
                if (t0 < L && (c >> 5) == half) {
#pragma unroll
                    for (int i = 0; i < 8; ++i) {
                        const int tok = pw * 8 + i; const size_t row = (size_t)(rowbase + t0 + i);
                        MIX[row * DM + h * 64 + c] = (bf16_t)f2bf(os[tok * 64 + c]);
                    }
                }
            }
        } else if (j >= 1 && j <= NC) {
            LAS float* qs = (LAS float*)(lds + ((j - 1) & 1) * SET); LAS float* ks = qs + 2048; LAS float* vs = qs + 4096; LAS float* os = qs + 6144; LAS float* sc = qs + 8192;
            const int ntok = min(MX_CH, L - (j - 1) * MX_CH);
            f32x4 kA0, kA1, qA0, qA1, kB0, kB1, qB0, qB1; float vA, vB; f32x2 gA, gB;
            kA0 = *(const LAS f32x4*)(ks + 8 * dq); kA1 = *(const LAS f32x4*)(ks + 8 * dq + 4); qA0 = *(const LAS f32x4*)(qs + 8 * dq); qA1 = *(const LAS f32x4*)(qs + 8 * dq + 4);
            vA = vs[e]; gA = *(const LAS f32x2*)(sc);
#define DN_STEP(TOK, K0, K1, Q0, Q1, VE, GB, NK0, NK1, NQ0, NQ1, NVE, NGB) do { \
                const int tn_ = min((TOK) + 1, ntok - 1); \
                NK0 = *(const LAS f32x4*)(ks + tn_ * 64 + 8 * dq); NK1 = *(const LAS f32x4*)(ks + tn_ * 64 + 8 * dq + 4); NQ0 = *(const LAS f32x4*)(qs + tn_ * 64 + 8 * dq); NQ1 = *(const LAS f32x4*)(qs + tn_ * 64 + 8 * dq + 4); \
                NVE = vs[tn_ * 64 + e]; NGB = *(const LAS f32x2*)(sc + tn_ * 2); \
                const float eg = GB[0], beta = GB[1]; \
                const f32x2 wa = (f32x2){K0[0], K0[1]} * S[0] + (f32x2){K0[2], K0[3]} * S[1]; \
                const f32x2 wb = (f32x2){K1[0], K1[1]} * S[2] + (f32x2){K1[2], K1[3]} * S[3]; \
                const f32x2 ws2 = wa + wb; \
                const float w = oct_sum(ws2[0] + ws2[1]); \
                const float dl = beta * (VE - eg * w); \
                const f32x2 eg2 = (f32x2){eg, eg}, dl2 = (f32x2){dl, dl}; \
                S[0] = S[0] * eg2 + (f32x2){K0[0], K0[1]} * dl2; S[1] = S[1] * eg2 + (f32x2){K0[2], K0[3]} * dl2; \
                S[2] = S[2] * eg2 + (f32x2){K1[0], K1[1]} * dl2; S[3] = S[3] * eg2 + (f32x2){K1[2], K1[3]} * dl2; \
                const f32x2 oa = (f32x2){Q0[0], Q0[1]} * S[0] + (f32x2){Q0[2], Q0[3]} * S[1]; \
                const f32x2 ob = (f32x2){Q1[0], Q1[1]} * S[2] + (f32x2){Q1[2], Q1[3]} * S[3]; \
                const f32x2 os2 = oa + ob; \
                os[(TOK) * 64 + e] = oct_sum(os2[0] + os2[1]); } while (0)
            for (int tok = 0; tok < ntok; tok += 2) {
                DN_STEP(tok, kA0, kA1, qA0, qA1, vA, gA, kB0, kB1, qB0, qB1, vB, gB);
                DN_STEP(tok + 1, kB0, kB1, qB0, qB1, vB, gB, kA0, kA1, qA0, qA1, vA, gA);
            }
#undef DN_STEP
        }
        LDS_BARRIER();
    }
#undef DN_LOADS
    if (wid < 4) {
#pragma unroll
        for (int j = 0; j < 4; ++j) { sout[(8 * dq + 2 * j) * 64 + e] = S[j][0]; sout[(8 * dq + 2 * j + 1) * 64 + e] = S[j][1]; }
    }
    __builtin_amdgcn_s_setprio(0);
}

__device__ __forceinline__ void gla_unit(const Params& P, LAS unsigned char* lds, int li, bool sample, int b, int h, const int tid) {
    const int lane = tid & 63, wid = __builtin_amdgcn_readfirstlane(tid >> 6);
    const int L = sample ? SSEQ : SEQ, rowbase = sample ? TP + b * SSEQ : b * SEQ;
    const bf16_t* PROJ = (const bf16_t*)(P.ws + WS_R1); const float* GATES = (const float*)(P.ws + WS_GATES); bf16_t* MIX = (bf16_t*)(P.ws + WS_MIX);
    const int NC = (L + MX_CH - 1) / MX_CH;
    constexpr int SET = 3 * 4096 + 2 * 8192;
    if (wid < 4) __builtin_amdgcn_s_setprio(2);
    const int e = (wid & 3) * 16 + (lane >> 2), dq = lane & 3;
    f32x2 S[4];
    float* sout = P.out + (sample ? O_GLAS : O_GLAP) + (size_t)((li * 8 + b) * 8 + h) * 2048;
    if (wid < 4) {
        if (sample) { const float* s0 = P.in[4] + (size_t)((li * 8 + b) * 8 + h) * 2048;
#pragma unroll
            for (int j = 0; j < 4; ++j) { S[j][0] = s0[(8 * dq + 2 * j) * 64 + e]; S[j][1] = s0[(8 * dq + 2 * j + 1) * 64 + e]; } }
        else {
#pragma unroll
            for (int j = 0; j < 4; ++j) S[j] = (f32x2){0.f, 0.f}; }
    }
    const int pw = wid - 4, c = lane, c32 = lane & 31;
    float w2[16], gkb = 0.f, onorm = 0.f;
    if (wid >= 4) {
#pragma unroll
        for (int r = 0; r < 16; ++r) w2[r] = P.in[13][(size_t)(li * 16 + r) * 256 + h * 32 + c32];
        gkb = P.in[14][li * 256 + h * 32 + c32]; onorm = P.in[15][li * 64 + c];
    }
    for (int j = 0; j < NC + 2; ++j) {
        if (wid >= 4) {
            if (j < NC) {
                LAS float* qs = (LAS float*)(lds + (j & 1) * SET); LAS float* ks = qs + 1024; LAS float* gs = qs + 2048; LAS float* vs = qs + 3072;
                const int t0 = j * MX_CH + pw * 8;
                if (t0 < L) {
                    const int g4 = (lane >> 5) * 4;
                    float rv[8], rq[4], rk[4]; f32x4 lrv[4][4];
#pragma unroll
                    for (int i = 0; i < 8; ++i) rv[i] = bf2f(PROJ[(size_t)(rowbase + t0 + i) * ABIN + 2576 + h * 64 + c]);
#pragma unroll
                    for (int i = 0; i < 4; ++i) { const size_t row = (size_t)(rowbase + t0 + g4 + i); const bf16_t* pr = PROJ + row * ABIN;
                        rq[i] = bf2f(pr[2064 + h * 32 + c32]); rk[i] = bf2f(pr[2320 + h * 32 + c32]);
#pragma unroll
                        for (int r = 0; r < 4; ++r) lrv[i][r] = *(const f32x4*)(GATES + row * 32 + 16 + 4 * r); }
#pragma unroll
                    for (int i = 0; i < 8; ++i) vs[(pw * 8 + i) * 64 + c] = rv[i];
#pragma unroll
                    for (int i = 0; i < 4; ++i) {
                        const int tok = pw * 8 + g4 + i;
                        float z = gkb;
#pragma unroll
                        for (int r = 0; r < 4; ++r) z += (lrv[i][r][0] * w2[4 * r] + lrv[i][r][1] * w2[4 * r + 1]) + (lrv[i][r][2] * w2[4 * r + 2] + lrv[i][r][3] * w2[4 * r + 3]);
                        const float ls = -softplus_f(-z);
                        qs[tok * 32 + c32] = rq[i] * 0.17677669529663687f; ks[tok * 32 + c32] = rk[i]; gs[tok * 32 + c32] = __expf(ls * (1.0f / 16.0f));
                    }
                }
            }
            if (j >= 2) {
                LAS float* os = (LAS float*)(lds + (j & 1) * SET) + 3072 + 2048;
                const int t0 = (j - 2) * MX_CH + pw * 8;
                if (t0 < L) {
#pragma unroll
                    for (int i = 0; i < 8; ++i) {
                        const int tok = pw * 8 + i; const size_t row = (size_t)(rowbase + t0 + i);
                        MIX[row * DM + 512 + h * 64 + c] = (bf16_t)f2bf(os[tok * 64 + c]);
                    }
                }
            }
        } else if (j >= 1 && j <= NC) {
            LAS float* qs = (LAS float*)(lds + ((j - 1) & 1) * SET); LAS float* ks = qs + 1024; LAS float* gs = qs + 2048; LAS float* vs = qs + 3072; LAS float* os = qs + 3072 + 2048;
            const int ntok = min(MX_CH, L - (j - 1) * MX_CH);
            f32x4 kk[2], qq[2], gg[2]; float ve;
#pragma unroll
            for (int i = 0; i < 2; ++i) { kk[i] = *(const LAS f32x4*)(ks + 8 * dq + 4 * i); qq[i] = *(const LAS f32x4*)(qs + 8 * dq + 4 * i); gg[i] = *(const LAS f32x4*)(gs + 8 * dq + 4 * i); }
            ve = vs[e];
            for (int tok = 0; tok < ntok; ++tok) {
                const int tn = min(tok + 1, ntok - 1);
                f32x4 kn[2], qn[2], gn[2];
#pragma unroll
                for (int i = 0; i < 2; ++i) { kn[i] = *(const LAS f32x4*)(ks + tn * 32 + 8 * dq + 4 * i); qn[i] = *(const LAS f32x4*)(qs + tn * 32 + 8 * dq + 4 * i); gn[i] = *(const LAS f32x4*)(gs + tn * 32 + 8 * dq + 4 * i); }
                const float vn = vs[tn * 64 + e];
                const f32x2 v2 = (f32x2){ve, ve};
                f32x2 oa[2];
#pragma unroll
                for (int i = 0; i < 2; ++i) {
                    S[2 * i] = S[2 * i] * (f32x2){gg[i][0], gg[i][1]} + (f32x2){kk[i][0], kk[i][1]} * v2; S[2 * i + 1] = S[2 * i + 1] * (f32x2){gg[i][2], gg[i][3]} + (f32x2){kk[i][2], kk[i][3]} * v2;
                    oa[i] = (f32x2){qq[i][0], qq[i][1]} * S[2 * i] + (f32x2){qq[i][2], qq[i][3]} * S[2 * i + 1];
                }
                const f32x2 os2 = oa[0] + oa[1];
                const float o = quad_sum(os2[0] + os2[1]);
                if (dq == 0) os[tok * 64 + e] = o;
#pragma unroll
                for (int i = 0; i < 2; ++i) { kk[i] = kn[i]; qq[i] = qn[i]; gg[i] = gn[i]; }
                ve = vn;
            }
        }
        __syncthreads();
    }
    if (wid < 4) {
#pragma unroll
        for (int j = 0; j < 4; ++j) { sout[(8 * dq + 2 * j) * 64 + e] = S[j][0]; sout[(8 * dq + 2 * j + 1) * 64 + e] = S[j][1]; }
    }
    __builtin_amdgcn_s_setprio(0);
}

__device__ __forceinline__ void phase_fixup(const Params& P, int li, int gw, int ngw, int lane) {
    bf16_t* MIX = (bf16_t*)(P.ws + WS_MIX); const bf16_t* PROJ = (const bf16_t*)(P.ws + WS_R1);
    const float* on = (lane < 32 ? P.in[12] : P.in[15]) + li * 64 + 16 * (lane & 3);
    float g[16];
#pragma unroll
    for (int j = 0; j < 16; ++j) g[j] = on[j];
    const int gcol = (lane < 32) ? 1552 + 16 * lane : 3104 + 16 * (lane - 32);
    for (int row = gw; row < TR; row += ngw) {
        u32x4* mp = (u32x4*)(MIX + (size_t)row * DM + 16 * lane);
        const u32x4* gp = (const u32x4*)(PROJ + (size_t)row * ABIN + gcol);
        const u32x4 m0 = mp[0], m1 = mp[1], g0 = gp[0], g1 = gp[1];
        float o[16], gt[16];
#pragma unroll
        for (int j = 0; j < 4; ++j) { o[2 * j] = __builtin_bit_cast(float, m0[j] << 16); o[2 * j + 1] = __builtin_bit_cast(float, m0[j] & 0xffff0000u); o[8 + 2 * j] = __builtin_bit_cast(float, m1[j] << 16); o[8 + 2 * j + 1] = __builtin_bit_cast(float, m1[j] & 0xffff0000u);
            gt[2 * j] = __builtin_bit_cast(float, g0[j] << 16); gt[2 * j + 1] = __builtin_bit_cast(float, g0[j] & 0xffff0000u); gt[8 + 2 * j] = __builtin_bit_cast(float, g1[j] << 16); gt[8 + 2 * j + 1] = __builtin_bit_cast(float, g1[j] & 0xffff0000u); }
        float ss = 0.f;
#pragma unroll
        for (int j = 0; j < 16; ++j) ss += o[j] * o[j];
        ss = quad_sum(ss);
        const float rstd = rsqrtf(ss * (1.0f / 64.0f) + EPS);
        float r[16];
#pragma unroll
        for (int j = 0; j < 16; ++j) r[j] = o[j] * rstd * g[j] * silu_f(gt[j]);
        u32x4 w0, w1;
#pragma unroll
        for (int j = 0; j < 4; ++j) { w0[j] = pk2(r[2 * j], r[2 * j + 1]); w1[j] = pk2(r[8 + 2 * j], r[8 + 2 * j + 1]); }
        mp[0] = w0; mp[1] = w1;
    }
}

constexpr int AT_KOFF = 0, AT_VOFF = 2 * 9216, AT_BIAS = 4 * 9216;
__device__ __forceinline__ int vpos(int kv) { return 16 * (kv >> 4) + 8 * ((kv >> 2) & 1) + 4 * ((kv >> 3) & 1) + (kv & 3); }
__device__ __forceinline__ void attn_build_bias(const Params& P, LAS unsigned char* lds, int li, int h, const int tid) {
    const float* tb = P.in[19] + (size_t)(li * 16 + h) * 257;
    LAS float* bt = (LAS float*)(lds + AT_BIAS);
    for (int i = tid; i < 4 * 2 * 64 * 32; i += 512) {
        const int r = i & 31, lane = (i >> 5) & 63, par = (i >> 11) & 1, dist = i >> 12, hi = lane >> 5, r32 = lane & 31;
        const int kv = ((r & 3) + 8 * ((r & 15) >> 2) + 4 * hi) + 32 * (r >> 4), rel = r32 + 32 * par - kv + 64 * dist;
        const float v = (dist == 3) ? tb[256] : tb[min(rel, 128) + 128];
        bt[(((dist * 2 + par) * 8 + (r >> 2)) * 64 + lane) * 4 + (r & 3)] = v * 8.0f;
    }
}
__device__ __forceinline__ void attn_tile(const LAS unsigned char* Kb, const LAS unsigned char* Vb, const LAS f32x4* bp, const bf16x8 (&qr)[4], f32x16 (&o)[2], float& m, float& l, int r32, int hi) {
    const float C2 = 0.125f * LOG2E;
    f32x16 p0, p1;
#pragma unroll
    for (int j = 0; j < 4; ++j) { const f32x4 t0 = bp[j * 64], t1 = bp[(4 + j) * 64];
        p0[4 * j] = t0[0]; p0[4 * j + 1] = t0[1]; p0[4 * j + 2] = t0[2]; p0[4 * j + 3] = t0[3]; p1[4 * j] = t1[0]; p1[4 * j + 1] = t1[1]; p1[4 * j + 2] = t1[2]; p1[4 * j + 3] = t1[3]; }
#pragma unroll
    for (int d0 = 0; d0 < 4; ++d0) {
        const bf16x8 a0 = *(const LAS bf16x8*)(Kb + r32 * 144 + d0 * 32 + hi * 16);
        const bf16x8 a1 = *(const LAS bf16x8*)(Kb + (32 + r32) * 144 + d0 * 32 + hi * 16);
        p0 = __builtin_amdgcn_mfma_f32_32x32x16_bf16(a0, qr[d0], p0, 0, 0, 0);
        p1 = __builtin_amdgcn_mfma_f32_32x32x16_bf16(a1, qr[d0], p1, 0, 0, 0);
    }
    float mx = fmaxf(p0[0], p1[0]);
#pragma unroll
    for (int r = 1; r < 16; ++r) mx = fmaxf(mx, fmaxf(p0[r], p1[r]));
    mx = fmaxf(mx, __shfl_xor(mx, 32)) * C2;
    if (__any(mx > m + 8.0f)) {
        const float mn = fmaxf(m, mx), scl = __builtin_amdgcn_exp2f(m - mn); m = mn; l *= scl;
#pragma unroll
        for (int r = 0; r < 16; ++r) { o[0][r] *= scl; o[1][r] *= scl; }
    }
    float ls = 0.f; const float nm = -m;
#pragma unroll
    for (int r = 0; r < 16; ++r) { p0[r] = __builtin_amdgcn_exp2f(p0[r] * C2 + nm); p1[r] = __builtin_amdgcn_exp2f(p1[r] * C2 + nm); ls += p0[r] + p1[r]; }
    l += ls;
    u32x4 pw[4];
#pragma unroll
    for (int s = 0; s < 2; ++s) {
        pw[s] = (u32x4){pk2(p0[8 * s], p0[8 * s + 1]), pk2(p0[8 * s + 2], p0[8 * s + 3]), pk2(p0[8 * s + 4], p0[8 * s + 5]), pk2(p0[8 * s + 6], p0[8 * s + 7])};
        pw[2 + s] = (u32x4){pk2(p1[8 * s], p1[8 * s + 1]), pk2(p1[8 * s + 2], p1[8 * s + 3]), pk2(p1[8 * s + 4], p1[8 * s + 5]), pk2(p1[8 * s + 6], p1[8 * s + 7])};
    }
#pragma unroll
    for (int dh = 0; dh < 2; ++dh)
#pragma unroll
        for (int ks = 0; ks < 4; ++ks) {
            const bf16x8 vf = *(const LAS bf16x8*)(Vb + (32 * dh + r32) * 144 + (16 * ks + 8 * hi) * 2);
            o[dh] = __builtin_amdgcn_mfma_f32_32x32x16_bf16(vf, __builtin_bit_cast(bf16x8, pw[ks]), o[dh], 0, 0, 0);
        }
}
__device__ __forceinline__ void attn_prompt_unit(const Params& P, LAS unsigned char* lds, int li, int b, int h, int g4, const int tid) {
    const int lane = tid & 63, wid = __builtin_amdgcn_readfirstlane(tid >> 6), r32 = lane & 31, hi = lane >> 5;
    const bf16_t* QKV = (const bf16_t*)(P.ws + WS_R1); bf16_t* MIX = (bf16_t*)(P.ws + WS_MIX);
    const int cw = 4 * g4 + (wid >> 1);
    const size_t qrow = (size_t)b * SEQ + 256 * g4 + 32 * wid + r32;
    bf16x8 qr[4];
#pragma unroll
    for (int d0 = 0; d0 < 4; ++d0) qr[d0] = *(const bf16x8*)(QKV + qrow * NQKV + h * 64 + d0 * 16 + hi * 8);
    const int kt_lo = max(0, 4 * g4 - 8), kt_hi = 4 * g4 + 3;
    const int srow = tid & 63, sch = tid >> 6;
    const bf16_t* kvsrc = QKV + ((size_t)b * SEQ + srow) * NQKV + 1024 + h * 64 + 8 * sch;
    const int vp = vpos(srow);
    bf16x8 kA, vA, kB, vB;
#define AT_LOAD(K_, V_, kt) do { const bf16_t* s_ = kvsrc + (size_t)(kt) * 64 * NQKV; K_ = *(const bf16x8*)s_; V_ = *(const bf16x8*)(s_ + 1024); } while (0)
#define AT_STORE(K_, V_, buf) do { *(LAS bf16x8*)(lds + AT_KOFF + (buf) * 9216 + srow * 144 + sch * 16) = K_; \
        _Pragma("unroll") for (int j_ = 0; j_ < 8; ++j_) *(LAS short*)(lds + AT_VOFF + (buf) * 9216 + (8 * sch + j_) * 144 + vp * 2) = V_[j_]; } while (0)
    AT_LOAD(kA, vA, kt_lo); AT_LOAD(kB, vB, kt_lo + 1);
    AT_STORE(kA, vA, 0);
    LDS_BARRIER();
    float m = -1e30f, l = 0.f; f32x16 o[2];
#pragma unroll
    for (int r = 0; r < 16; ++r) { o[0][r] = 0.f; o[1][r] = 0.f; }
    const LAS f32x4* btl = (const LAS f32x4*)(lds + AT_BIAS) + (wid & 1) * 512 + lane;
    for (int kt = kt_lo; kt <= kt_hi; kt += 2) {
        if (kt + 2 <= kt_hi) AT_LOAD(kA, vA, kt + 2);
        if (kt >= cw - 8 && kt <= cw) attn_tile(lds + AT_KOFF, lds + AT_VOFF, btl + min(cw - kt, 3) * 1024, qr, o, m, l, r32, hi);
        AT_STORE(kB, vB, 1);
        LDS_BARRIER();
        if (kt + 3 <= kt_hi) AT_LOAD(kB, vB, kt + 3);
        if (kt + 1 >= cw - 8 && kt + 1 <= cw) attn_tile(lds + AT_KOFF + 9216, lds + AT_VOFF + 9216, btl + min(cw - kt - 1, 3) * 1024, qr, o, m, l, r32, hi);
        if (kt + 2 <= kt_hi) AT_STORE(kA, vA, 0);
        LDS_BARRIER();
    }
#undef AT_LOAD
#undef AT_STORE
    l += __shfl_xor(l, 32);
    const float rl = 1.0f / l;
    bf16_t* op = MIX + qrow * DM + h * 64;
#pragma unroll
    for (int dh = 0; dh < 2; ++dh)
#pragma unroll
        for (int r4 = 0; r4 < 4; ++r4) {
            u32x2 w; w.x = pk2(o[dh][4 * r4] * rl, o[dh][4 * r4 + 1] * rl); w.y = pk2(o[dh][4 * r4 + 2] * rl, o[dh][4 * r4 + 3] * rl);
            *(u32x2*)(op + 32 * dh + 8 * r4 + 4 * hi) = w;
        }
}
__device__ __forceinline__ void attn_sample_unit(const Params& P, LAS unsigned char* lds, int li, int b, int h, const int tid) {
    const int lane = tid & 63, wid = tid >> 6;
    const bf16_t* QKV = (const bf16_t*)(P.ws + WS_R1); bf16_t* MIX = (bf16_t*)(P.ws + WS_MIX);
    LAS float* qs = (LAS float*)lds;
    LAS float* sc = qs + 1024;
    LAS float* tab = sc + 16 * 528;
    const size_t rb = (size_t)TP + b * SSEQ;
    for (int i = tid; i < 1024; i += 512) qs[i] = bf2f(QKV[(rb + (i >> 6)) * NQKV + h * 64 + (i & 63)]);
    if (tid < 257) tab[tid] = P.in[19][(size_t)(li * 16 + h) * 257 + tid];
    __syncthreads();
    const float* kc = P.in[5] + ((size_t)(li * 8 + b) * 512) * 1024 + h * 64;
    const float* vc = P.in[6] + ((size_t)(li * 8 + b) * 512) * 1024 + h * 64;
    for (int j = tid; j < 528; j += 512) {
        float kr[64];
        if (j < 512) {
#pragma unroll
            for (int d = 0; d < 16; ++d) { const f32x4 t = *(const f32x4*)(kc + (size_t)j * 1024 + 4 * d); kr[4 * d] = t[0]; kr[4 * d + 1] = t[1]; kr[4 * d + 2] = t[2]; kr[4 * d + 3] = t[3]; }
        } else {
#pragma unroll
            for (int d = 0; d < 64; ++d) kr[d] = bf2f(QKV[(rb + (j - 512)) * NQKV + 1024 + h * 64 + d]);
        }
        for (int q = 0; q < 16; ++q) {
            float s = 0.f;
#pragma unroll
            for (int d = 0; d < 64; ++d) s += qs[q * 64 + d] * kr[d];
            const int rel = (j < 512) ? (512 + q - j) : (q - (j - 512));
            sc[q * 528 + j] = s * 0.125f + tab[min(max(rel, -128), 128) + 128];
        }
    }
    __syncthreads();
    for (int q = 2 * wid; q < 2 * wid + 2; ++q) {
        float mx = -1e30f;
        for (int j = lane; j < 528; j += 64) mx = fmaxf(mx, sc[q * 528 + j]);
#pragma unroll
        for (int o = 1; o < 64; o <<= 1) mx = fmaxf(mx, __shfl_xor(mx, o));
        float sm = 0.f;
        for (int j = lane; j < 528; j += 64) { const float p = __expf(sc[q * 528 + j] - mx); sc[q * 528 + j] = p; sm += p; }
        sm = wave_sum(sm);
        const float inv = 1.0f / sm;
        for (int j = lane; j < 528; j += 64) sc[q * 528 + j] *= inv;
    }
    __syncthreads();
    {
        const int q = tid >> 5, d = 2 * (tid & 31);
        float a0 = 0.f, a1 = 0.f;
        for (int j = 0; j < 512; ++j) { const f32x2 v = *(const f32x2*)(vc + (size_t)j * 1024 + d); const float p = sc[q * 528 + j]; a0 += p * v[0]; a1 += p * v[1]; }
        for (int j = 0; j < 16; ++j) { const bf16_t* vp = QKV + (rb + j) * NQKV + 2048 + h * 64 + d; const float p = sc[q * 528 + 512 + j]; a0 += p * bf2f(vp[0]); a1 += p * bf2f(vp[1]); }
        *(unsigned*)(MIX + (rb + q) * DM + h * 64 + d) = pk2(a0, a1);
    }
    __syncthreads();
}

#define XB_TMO      128
#define XB_XCNT(j)  (256  + 64 * (j))
#define XB_XSUB(j)  (1280 + 64 * (j))
#define XB_XGEN(j)  (2304 + 64 * (j))
#define XB_TOP      3328
#define XB_TOPGEN   3392
#define XCD_BAR_WORDS 3456
#define XB_SPIN_CAP (1u << 20)
__device__ __forceinline__ unsigned xb_ld(unsigned* p)              { return __hip_atomic_load(p, __ATOMIC_RELAXED, __HIP_MEMORY_SCOPE_AGENT); }
__device__ __forceinline__ unsigned xb_add(unsigned* p, unsigned v) { return __hip_atomic_fetch_add(p, v, __ATOMIC_RELAXED, __HIP_MEMORY_SCOPE_AGENT); }
__device__ __forceinline__ unsigned xb_xcc_id() { return (unsigned)__builtin_amdgcn_s_getreg((3 << 11) | 20) & 0xFu; }
#define XB_SPIN(cond, bar) do { unsigned _sp = 0; while (cond) { __builtin_amdgcn_s_sleep(1); \
    if ((++_sp & 255u) == 0u) { if (xb_ld(&(bar)[XB_TMO])) break; if (_sp > XB_SPIN_CAP) { atomicAdd(&(bar)[XB_TMO], 1u); break; } } } } while (0)
struct XcdBarrier { unsigned* bar; unsigned x; volatile LAS unsigned* st; };
__device__ __forceinline__ XcdBarrier xcd_barrier_post(unsigned* bar, volatile LAS unsigned* st) {
    XcdBarrier b; b.bar = bar; b.x = xb_xcc_id(); b.st = st;
    if (threadIdx.x == 0) (void)xb_add(&bar[XB_XCNT(b.x)], 1u);
    return b;
}
__device__ __forceinline__ void xcd_barrier_complete(unsigned* bar, unsigned x, unsigned& nloc, unsigned& nx) {
    const unsigned G = gridDim.x * gridDim.y * gridDim.z;
    unsigned sum, cnt, mine, sp = 0u;
    for (;;) {
        sum = 0u; cnt = 0u; mine = 0u;
#pragma unroll
        for (unsigned j = 0; j < 16; ++j) { const unsigned c = xb_ld(&bar[XB_XCNT(j)]); sum += c; cnt += (c > 0u) ? 1u : 0u; mine = (j == x) ? c : mine; }
        if (sum == G) break;
        __builtin_amdgcn_s_sleep(1);
        if ((++sp & 255u) == 0u) { if (xb_ld(&bar[XB_TMO])) break; if (sp > XB_SPIN_CAP) { atomicAdd(&bar[XB_TMO], 1u); break; } }
    }
    nloc = mine > 0u ? mine : 1u; nx = cnt > 0u ? cnt : 1u;
}
__device__ __forceinline__ void xcd_barrier(const XcdBarrier& b) {
    asm volatile("s_waitcnt vmcnt(0)" ::: "memory");
    __syncthreads();
    if (threadIdx.x == 0) {
        unsigned* bar = b.bar;
        __builtin_amdgcn_s_waitcnt(0);
        unsigned nloc = b.st[0], nx = b.st[1];
        if (nloc == 0u) { xcd_barrier_complete(bar, b.x, nloc, nx); b.st[0] = nloc; b.st[1] = nx; }
        const unsigned old = xb_add(&bar[XB_XSUB(b.x)], 1u);
        const unsigned gen = old / nloc;
        if (old + 1u == (gen + 1u) * nloc) {
            __builtin_amdgcn_fence(__ATOMIC_RELEASE, "agent");
            asm volatile("s_waitcnt vmcnt(0)" ::: "memory");
            const unsigned og = xb_add(&bar[XB_TOP], 1u);
            const unsigned tg = og / nx;
            if (og + 1u == (tg + 1u) * nx) xb_add(&bar[XB_TOPGEN], 1u);
            else XB_SPIN(xb_ld(&bar[XB_TOPGEN]) == tg, bar);
            __builtin_amdgcn_fence(__ATOMIC_ACQUIRE, "agent");
            xb_add(&bar[XB_XGEN(b.x)], 1u);
            asm volatile("s_waitcnt vmcnt(0)" ::: "memory");
        } else {
            XB_SPIN(xb_ld(&bar[XB_XGEN(b.x)]) == gen, bar);
            __builtin_amdgcn_fence(__ATOMIC_ACQUIRE, "agent");
            asm volatile("s_waitcnt vmcnt(0)" ::: "memory");
        }
    }
    __syncthreads();
}

__global__ void __launch_bounds__(512, 2) hybrid_fwd(Params P) {
    extern __shared__ __attribute__((aligned(16))) unsigned char lds_raw[];
    LAS unsigned char* lds = (LAS unsigned char*)lds_raw;
    const int G = gridDim.x;
    volatile LAS unsigned* xst = (volatile LAS unsigned*)(lds + 131072 + 256);
    if (threadIdx.x < 2) xst[threadIdx.x] = 0u;
    __syncthreads();
    XcdBarrier xbar = xcd_barrier_post((unsigned*)(P.ws + WS_CTL), xst);
    int ph = P.ph_lo, rep = 0;
    while (ph < P.ph_hi) {
        int tid = threadIdx.x; asm volatile("" : "+v"(tid));
        int wg = blockIdx.x; asm volatile("" : "+s"(wg));
        const Params& Q = P;
        const int lane = tid & 63, wid = __builtin_amdgcn_readfirstlane(tid >> 6), gw = wg * 8 + wid, ngw = G * 8;
        unsigned char* ws = Q.ws;
        bf16_t* Xb = (bf16_t*)(ws + WS_XB); bf16_t* R1 = (bf16_t*)(ws + WS_R1); bf16_t* MIX = (bf16_t*)(ws + WS_MIX);
        float* GATES = (float*)(ws + WS_GATES); float* SSP = (float*)(ws + WS_SSP);
        int nrep = 1;
        if (ph == 0) nrep = REP_PRO; else if (ph != NPHASE - 1) { const int q_ = (ph - 1) % 11; if (q_ == 1) nrep = REP_MIX; else if (q_ == 7) nrep = REP_ATT; else if (q_ == 0 || q_ == 4 || q_ == 6 || q_ == 9) nrep = REP_PROJ; }
        if (ph == 0) phase_prologue(Q, lds, gw, ngw, wid, lane);
        else if (ph == NPHASE - 1) phase_final(Q, gw, ngw, lane);
        else {
            int layer, sub;
            { const int r_ = ph - 1, pair_ = r_ / 11, q_ = r_ % 11; if (q_ < 6) { layer = 2 * pair_; sub = (q_ < 2) ? q_ : (q_ == 2 ? 5 : q_ - 1); } else { layer = 2 * pair_ + 1; sub = q_ - 6; } }
            const int li = layer >> 1, odd = layer & 1;
            if (sub == 5) phase_fixup(Q, li, gw, ngw, lane);
            else if (sub == 1) {
                if (!odd) {
                    if (G == 256) {
                        if (wg < 128) delta_unit(Q, lds, li, false, wg >> 4, (wg >> 1) & 7, wg & 1, tid);
                        else if (wg < 192) { const int u = wg - 128; gla_unit(Q, lds, li, false, u >> 3, u & 7, tid); }
                        else { const int u = wg - 192; delta_unit(Q, lds, li, true, u >> 3, u & 7, 0, tid); delta_unit(Q, lds, li, true, u >> 3, u & 7, 1, tid); gla_unit(Q, lds, li, true, u >> 3, u & 7, tid);
                            if (layer == 0 && rep == 0) convert_mats(Q, lds, 1, 16, (wg - 192) * 8 + wid, 512, wid, lane); }
                    }
                } else {
                    attn_build_bias(Q, lds, li, (wg >> 1) & 15, tid);
                    for (int u = wg * 8; u < wg * 8 + 8; ++u) attn_prompt_unit(Q, lds, li, u >> 8, (u >> 4) & 15, u & 15, tid);
                    if (wg < 128) attn_sample_unit(Q, lds, li, wg >> 4, wg & 15, tid);
                }
            } else {
                pg8::Gemm g; int mode, Npos;
                g.M = TP;
                LAS unsigned long long* eap = (LAS unsigned long long*)(lds + EA_OFF);
#define EA_SET(i, p) eap[i] = (unsigned long long)(p)
                if (sub == 0) {
                    g.A = Xb; g.K = 1024;
                    if (!odd) { mode = 0; Npos = ABPAD; g.Bt = (const bf16_t*)(ws + WS_WIN + li * SZ_WIN);
                        if (tid == 0) { EA_SET(0, R1); EA_SET(1, SSP); EA_SET(2, GATES); EA_SET(3, Q.out + O_CONVP + (size_t)li * 8 * 3 * DNQKV); EA_SET(4, Q.out + O_CONVS + (size_t)li * 8 * 3 * DNQKV); } }
                    else { mode = 1; Npos = NQKV; g.Bt = (const bf16_t*)(ws + WS_WQKV + li * SZ_WQKV);
                        if (tid == 0) { EA_SET(0, R1); EA_SET(1, SSP); EA_SET(3, Q.out + O_CKP + (size_t)li * 8 * 512 * 1024); EA_SET(4, Q.out + O_CVP + (size_t)li * 8 * 512 * 1024); EA_SET(5, Q.out + O_CKS + (size_t)li * 8 * 16 * 1024); EA_SET(6, Q.out + O_CVS + (size_t)li * 8 * 16 * 1024); } }
                } else if (sub == 2) {
                    mode = 2; Npos = 1024; g.A = MIX; g.K = 1024; g.Bt = (const bf16_t*)(ws + (odd ? WS_WCOUT : WS_WOUT) + li * SZ_W1K);
                    if (tid == 0) { EA_SET(7, (layer == 0) ? Q.in[0] : Q.out); EA_SET(8, (layer == 0) ? Q.in[1] : Q.out + (size_t)TP * DM); EA_SET(9, Q.out); EA_SET(10, Xb); EA_SET(11, SSP); }
                } else if (sub == 3) {
                    mode = 3; Npos = NGU; g.A = Xb; g.K = 1024; g.Bt = (const bf16_t*)(ws + WS_WGU + layer * SZ_WGU);
                    if (tid == 0) { EA_SET(0, R1); EA_SET(1, SSP); }
                } else {
                    mode = 2; Npos = 1024; g.A = R1; g.K = DFF; g.Bt = (const bf16_t*)(ws + WS_WDN + layer * SZ_WDN);
                    if (tid == 0) { EA_SET(7, Q.out); EA_SET(8, Q.out + (size_t)TP * DM); EA_SET(9, Q.out); EA_SET(10, Xb); EA_SET(11, SSP); }
                }
#undef EA_SET
                g.N = Npos;
                __syncthreads();
                pg8::StaticOrder S; S.init(TP, Npos, G, wg);
                if (mode == 0) { small_gemm<0>(g.A, g.Bt, Npos, g.K, eap, lds, wg, G, wid, lane); Epi<0> E{eap}; pg8::gemm_phase<Epi<0>, true, true>(lds, g, S, E, tid); }
                else if (mode == 1) { small_gemm<1>(g.A, g.Bt, Npos, g.K, eap, lds, wg, G, wid, lane); Epi<1> E{eap}; pg8::gemm_phase<Epi<1>, true, true>(lds, g, S, E, tid); }
                else if (mode == 2) { small_gemm<2>(g.A, g.Bt, Npos, g.K, eap, lds, wg, G, wid, lane); Epi<2> E{eap}; pg8::gemm_phase<Epi<2>, true, true>(lds, g, S, E, tid); }
                else { small_gemm<3>(g.A, g.Bt, Npos, g.K, eap, lds, wg, G, wid, lane); Epi<3> E{eap}; pg8::gemm_phase<Epi<3>, true, true>(lds, g, S, E, tid); }
            }
        }
        if (++rep >= nrep) { rep = 0; ++ph; }
        if (ph < P.ph_hi) { if (ph == 1 && rep == 0) cg::this_grid().sync(); else xcd_barrier(xbar); }
    }
}

extern "C" void kernel_launch(void* const* d_in, const int* in_sizes, int n_in, void* d_out, int out_size, void* d_ws, size_t ws_size, hipStream_t stream) {
    static int grid = 0;
    if (grid == 0) {
        if (n_in != 25 || (size_t)out_size != O_END || ws_size < WS_END) { fprintf(stderr, "kernel_launch: unexpected sizes n_in %d out %d ws %zu (need %zu)\n", n_in, out_size, ws_size, (size_t)WS_END); grid = -1; return; }
        if (hipFuncSetAttribute((const void*)hybrid_fwd, hipFuncAttributeMaxDynamicSharedMemorySize, LDS_BYTES) != hipSuccess) { fprintf(stderr, "kernel_launch: hipFuncSetAttribute failed\n"); grid = -1; return; }
        int dev = 0, cus = 0, per_cu = 0;
        hipGetDevice(&dev); hipDeviceGetAttribute(&cus, hipDeviceAttributeMultiprocessorCount, dev);
        hipOccupancyMaxActiveBlocksPerMultiprocessor(&per_cu, (const void*)hybrid_fwd, 512, LDS_BYTES);
        (void)hipGetLastError();
        if (cus != 256 || per_cu < 1) fprintf(stderr, "kernel_launch: note: cus %d per_cu %d\n", cus, per_cu);
        grid = 256;
    }
    if (grid < 0) return;
    Params p{};
    for (int i = 0; i < 25; ++i) p.in[i] = (const float*)d_in[i];
    p.out = (float*)d_out; p.ws = (unsigned char*)d_ws;
#if MK_MULTI
    for (int ph = 0; ph < NPHASE; ++ph) { p.ph_lo = ph; p.ph_hi = ph + 1; hipLaunchKernelGGL(hybrid_fwd, dim3(grid), dim3(512), LDS_BYTES, stream, p); }
#else
    (void)hipMemsetAsync((char*)d_ws + WS_CTL, 0, CTL_BYTES, stream);
    p.ph_lo = 0; p.ph_hi = NPHASE;
    void* args[] = {&p};
    hipError_t e = hipLaunchCooperativeKernel((const void*)hybrid_fwd, dim3(grid), dim3(512), args, LDS_BYTES, stream);
    if (e != hipSuccess) fprintf(stderr, "cooperative launch failed: %s\n", hipGetErrorString(e));
#endif
}
```

```cpp
#include <hip/hip_runtime.h>
#include <hip/hip_cooperative_groups.h>
#include <cstdio>
#include <cstdint>
namespace cg = cooperative_groups;

#ifndef MK_MULTI
#define MK_MULTI 0
#endif

#ifndef REP_MIX
#define REP_MIX 1
#endif
#ifndef REP_ATT
#define REP_ATT 1
#endif
#ifndef REP_PRO
#define REP_PRO 1
#endif
#ifndef REP_PROJ
#define REP_PROJ 1
#endif
#define LAS __attribute__((address_space(3)))
#define GAS __attribute__((address_space(1)))
typedef unsigned short bf16_t;
typedef short bf16x8 __attribute__((ext_vector_type(8)));
typedef float f32x2 __attribute__((ext_vector_type(2)));
typedef float f32x4 __attribute__((ext_vector_type(4)));
typedef float f32x16 __attribute__((ext_vector_type(16)));
typedef unsigned u32x2 __attribute__((ext_vector_type(2)));
typedef unsigned u32x4 __attribute__((ext_vector_type(4)));

constexpr int DM = 1024, NB = 8, SEQ = 4096, SB = 8, SSEQ = 16, PAST = 2048;
constexpr int TP = NB * SEQ;
constexpr int TS = SB * SSEQ;
constexpr int TR = TP + TS;
constexpr int ABIN = 3616, ABPAD = 3840, DFF = 2816, NGU = 5632, NQKV = 3072, DNQKV = 1536;
constexpr float EPS = 1e-6f;
constexpr float LOG2E = 1.4426950408889634f;

constexpr size_t O_Y = 0;
constexpr size_t O_CONVP = (size_t)TR * DM;
constexpr size_t O_CONVS = O_CONVP + 2 * 8 * 3 * 1536;
constexpr size_t O_DNP = O_CONVS + 2 * 8 * 3 * 1536;
constexpr size_t O_DNS = O_DNP + 2 * 8 * 8 * 64 * 64;
constexpr size_t O_GLAP = O_DNS + 2 * 8 * 8 * 64 * 64;
constexpr size_t O_GLAS = O_GLAP + 2 * 8 * 8 * 32 * 64;
constexpr size_t O_CKP = O_GLAS + 2 * 8 * 8 * 32 * 64;
constexpr size_t O_CKS = O_CKP + (size_t)2 * 8 * 512 * 1024;
constexpr size_t O_CVP = O_CKS + 2 * 8 * 16 * 1024;
constexpr size_t O_CVS = O_CVP + (size_t)2 * 8 * 512 * 1024;
constexpr size_t O_END = O_CVS + 2 * 8 * 16 * 1024;

constexpr size_t SZ_WIN = (size_t)ABPAD * 1024 * 2, SZ_W1K = (size_t)1024 * 1024 * 2, SZ_WQKV = (size_t)NQKV * 1024 * 2, SZ_WGU = (size_t)NGU * 1024 * 2, SZ_WDN = (size_t)1024 * DFF * 2;
constexpr size_t WS_WIN = 0;
constexpr size_t WS_WOUT = WS_WIN + 2 * SZ_WIN;
constexpr size_t WS_WQKV = WS_WOUT + 2 * SZ_W1K;
constexpr size_t WS_WCOUT = WS_WQKV + 2 * SZ_WQKV;
constexpr size_t WS_WGU = WS_WCOUT + 2 * SZ_W1K;
constexpr size_t WS_WDN = WS_WGU + 4 * SZ_WGU;
constexpr size_t WS_XB = WS_WDN + 4 * SZ_WDN;
constexpr size_t WS_R1 = WS_XB + (size_t)TR * 1024 * 2;
constexpr size_t WS_MIX = WS_R1 + (size_t)TR * ABIN * 2;
constexpr size_t WS_GATES = WS_MIX + (size_t)TR * 1024 * 2;
constexpr size_t WS_SSP = WS_GATES + (size_t)TR * 32 * 4;
constexpr size_t WS_CTL = WS_SSP + (size_t)TR * 16 * 4;
constexpr size_t CTL_BYTES = 16384;
constexpr size_t WS_END = WS_CTL + CTL_BYTES;

constexpr int LDS_BYTES = 147456;
constexpr int NPHASE = 24;

struct Params { const float* in[25]; float* out; unsigned char* ws; int ph_lo, ph_hi; };

__device__ __forceinline__ unsigned f2bf(float f) { unsigned u = __builtin_bit_cast(unsigned, f); return (u + 0x7fffu + ((u >> 16) & 1u)) >> 16; }
typedef __bf16 hwbf16x2 __attribute__((ext_vector_type(2)));
__device__ __forceinline__ unsigned pk2(float lo, float hi) { const f32x2 v = {lo, hi}; return __builtin_bit_cast(unsigned, __builtin_convertvector(v, hwbf16x2)); }
__device__ __forceinline__ float bf2f(bf16_t b) { return __builtin_bit_cast(float, ((unsigned)b) << 16); }
template <int CTRL> __device__ __forceinline__ float dppf(float v) { return __builtin_bit_cast(float, __builtin_amdgcn_update_dpp(0, __builtin_bit_cast(int, v), CTRL, 0xF, 0xF, true)); }
__device__ __forceinline__ float quad_sum(float v) { v += dppf<0xB1>(v); v += dppf<0x4E>(v); return v; }
__device__ __forceinline__ float oct_sum(float v) { v = quad_sum(v); v += dppf<0x141>(v); return v; }
__device__ __forceinline__ float wave_sum(float v) {
    v = oct_sum(v); v += dppf<0x140>(v);
    const int i = __builtin_bit_cast(int, v);
    return (__builtin_bit_cast(float, __builtin_amdgcn_readlane(i, 0)) + __builtin_bit_cast(float, __builtin_amdgcn_readlane(i, 16))) +
           (__builtin_bit_cast(float, __builtin_amdgcn_readlane(i, 32)) + __builtin_bit_cast(float, __builtin_amdgcn_readlane(i, 48)));
}
__device__ __forceinline__ float fast_rcp(float x) { return __builtin_amdgcn_rcpf(x); }
__device__ __forceinline__ float silu_f(float x) { return x * fast_rcp(1.0f + __expf(-x)); }
__device__ __forceinline__ float sigmoid_f(float x) { return fast_rcp(1.0f + __expf(-x)); }
__device__ __forceinline__ float softplus_f(float x) { return fmaxf(x, 0.f) + __logf(1.0f + __expf(-fabsf(x))); }

namespace pg8 {
constexpr int BM = 256, BK = 64, HALF = 128, HTB = HALF * BK * 2, STAGE_BYTES = 8 * HTB, NXCD = 8, WGM = 8;
__host__ __device__ __forceinline__ int lds_byte(int r, int c) { const int st = (r >> 4) * 2 + (c >> 5), rr = r & 15, cc = c & 31, ob = rr * 64 + cc * 2; return st * 1024 + (ob ^ (((ob >> 9) & 1) << 5)); }
__host__ __device__ __forceinline__ void stage_rc(int b, int& R, int& C) { const int st = b / 1024, sb = b % 1024, swz = sb ^ (((sb >> 9) & 1) << 5); R = (st >> 1) * 16 + swz / 64; C = (st & 1) * 32 + (swz % 64) / 2; }
__host__ __device__ __forceinline__ int perm32(int rho) { const int n = rho >> 4, i = rho & 15; return 8 * (i >> 2) + 4 * n + (i & 3); }
struct Unit { int pm, pn; };
struct Gemm { const bf16_t* A; const bf16_t* Bt; int M, N, K; };
struct StaticOrder {
    int nM, nN, nwg, G, c;
    __host__ __device__ void init(int M, int N, int G_, int c_) { nM = M / BM; nN = N / BM; nwg = nM * nN; G = G_; c = c_; }
    __host__ __device__ bool next(int i, Unit& u) const {
        const long L = (long)i * G + c; if (L >= nwg) return false;
        int wgid = (int)L; { const int q = nwg / NXCD, r = nwg % NXCD, xcd = wgid % NXCD, off = wgid / NXCD; wgid = (xcd < r ? xcd * (q + 1) : r * (q + 1) + (xcd - r) * q) + off; }
        const int nig = WGM * nN, gid = wgid / nig, fm = gid * WGM, gsz = (nM - fm) < WGM ? (nM - fm) : WGM;
        u.pm = fm + ((wgid % nig) % gsz); u.pn = (wgid % nig) / gsz; return true;
    }
};

template <class Epi, bool ALIGN_EPI, bool SP2>
__device__ __forceinline__ void gemm_phase(LAS unsigned char* lds, const Gemm g, const StaticOrder& S, const Epi& E, const int tid) {
    const int wid = __builtin_amdgcn_readfirstlane(tid >> 6), lane = tid & 63, wr = wid >> 2, wc = wid & 3, fr = lane & 15, fq = lane >> 4;
    const int K = g.K, nt = K / BK;
    unsigned voffA[2], voffB[2];
#pragma unroll
    for (int i = 0; i < 2; ++i) { int R, C; stage_rc(tid * 16 + i * 8192, R, C); voffA[i] = (unsigned)(R * K + C) * 2u; voffB[i] = (unsigned)(R * K + C) * 2u; }
    const size_t kstep = (size_t)(BK * 2);
    const size_t hstep = (size_t)HALF * K * 2;
    const size_t tstep = 2 * hstep;
    const unsigned ldsw = (unsigned)wid * 1024u;
    const int aoff = lds_byte(wr * 64 + fr, fq * 8), boff = lds_byte(wc * 32 + fr, fq * 8);
#define PG8_SA(b, h) (((b) * 2 + (h)) * HTB)
#define PG8_SB(b, h) ((4 + (b) * 2 + (h)) * HTB)
#define PG8_STAGE(bufoff, gbase, voff) do { _Pragma("unroll") for (int _i = 0; _i < 2; ++_i) \
        __builtin_amdgcn_global_load_lds((const unsigned*)((const char*)(gbase) + (voff)[_i]), (LAS unsigned*)(lds + (bufoff) + ldsw + _i * 8192), 16, 0, 0); } while (0)
#define PG8_LDA(dst, b, h) do { _Pragma("unroll") for (int m = 0; m < 4; ++m) _Pragma("unroll") for (int k = 0; k < 2; ++k) dst[m][k] = *(const LAS bf16x8*)(lds + PG8_SA(b, h) + aoff + m * 2048 + k * 1024); } while (0)
#define PG8_LDB(dst, b, h) do { _Pragma("unroll") for (int n = 0; n < 2; ++n) _Pragma("unroll") for (int k = 0; k < 2; ++k) dst[n][k] = *(const LAS bf16x8*)(lds + PG8_SB(b, h) + boff + n * 2048 + k * 1024); } while (0)
#define PG8_MMA(ai, bj, At, Bt) do { __builtin_amdgcn_s_setprio(1); _Pragma("unroll") for (int m = 0; m < 4; ++m) _Pragma("unroll") for (int n = 0; n < 2; ++n) _Pragma("unroll") for (int k = 0; k < 2; ++k) \
        acc[ai][bj][m][n] = __builtin_amdgcn_mfma_f32_16x16x32_bf16(Bt[n][k], At[m][k], acc[ai][bj][m][n], 0, 0, 0); __builtin_amdgcn_s_setprio(0); } while (0)
#define PG8_WAIT_V(n) asm volatile("s_waitcnt vmcnt(" #n ")" ::: "memory")
#define PG8_WAIT_L(n) asm volatile("s_waitcnt lgkmcnt(" #n ")" ::: "memory")
#define PG8_BAR __builtin_amdgcn_s_barrier()
#define PG8_SCHED __builtin_amdgcn_sched_barrier(0)
    Unit cur, nxt; int ui = 0;
    if (!S.next(0, cur)) return;
    f32x4 acc[2][2][4][2];
#pragma unroll
    for (int a = 0; a < 2; ++a)
#pragma unroll
        for (int b = 0; b < 2; ++b)
#pragma unroll
            for (int m = 0; m < 4; ++m)
#pragma unroll
                for (int n = 0; n < 2; ++n) acc[a][b][m][n] = (f32x4){0.f, 0.f, 0.f, 0.f};
    bf16x8 At[4][2], B0[2][2], B1[2][2];
    const char* cA = (const char*)g.A + (size_t)cur.pm * tstep; const char* cB = (const char*)g.Bt + (size_t)cur.pn * tstep;
    if constexpr (SP2) {
        PG8_STAGE(PG8_SB(0, 0), cB, voffB); PG8_STAGE(PG8_SB(0, 1), cB + hstep, voffB); PG8_STAGE(PG8_SA(0, 0), cA, voffA); PG8_STAGE(PG8_SA(0, 1), cA + hstep, voffA);
        if (wr == 1) PG8_BAR;
        PG8_WAIT_V(2); PG8_BAR;
        PG8_STAGE(PG8_SB(1, 0), cB + kstep, voffB); PG8_STAGE(PG8_SA(1, 0), cA + kstep, voffA); PG8_STAGE(PG8_SB(1, 1), cB + hstep + kstep, voffB);
        PG8_WAIT_V(6); PG8_BAR;
    } else {
        PG8_STAGE(PG8_SB(0, 0), cB, voffB); PG8_STAGE(PG8_SA(0, 0), cA, voffA); PG8_STAGE(PG8_SB(0, 1), cB + hstep, voffB); PG8_STAGE(PG8_SA(0, 1), cA + hstep, voffA);
        if (wr == 1) PG8_BAR;
        PG8_WAIT_V(4); PG8_BAR;
        PG8_STAGE(PG8_SB(1, 0), cB + kstep, voffB); PG8_STAGE(PG8_SA(1, 0), cA + kstep, voffA); PG8_STAGE(PG8_SB(1, 1), cB + hstep + kstep, voffB);
        PG8_WAIT_V(6); PG8_BAR;
    }
    for (;;) {
        const bool has_next = S.next(ui + 1, nxt);
        const char* nA = has_next ? (const char*)g.A + (size_t)nxt.pm * tstep : cA; const char* nB = has_next ? (const char*)g.Bt + (size_t)nxt.pn * tstep : cB;
        for (int t = 0; t < nt; t += 2) {
            const bool last = (t == nt - 2);
            const char* a1 = cA + (size_t)(t + 1) * kstep;
            const char* a2 = last ? nA : cA + (size_t)(t + 2) * kstep; const char* b2 = last ? nB : cB + (size_t)(t + 2) * kstep;
            const char* a3 = a2 + kstep; const char* b3 = b2 + kstep;
            if constexpr (SP2) {
            PG8_LDB(B0, 0, 0); PG8_LDB(B1, 0, 1); PG8_SCHED; PG8_LDA(At, 0, 0); PG8_STAGE(PG8_SA(1, 1), a1 + hstep, voffA);
            PG8_WAIT_V(8); PG8_WAIT_L(0); PG8_BAR; PG8_MMA(0, 0, At, B0); PG8_MMA(0, 1, At, B1); PG8_BAR; PG8_SCHED;
            PG8_LDA(At, 0, 1); PG8_STAGE(PG8_SB(0, 0), b2, voffB); PG8_STAGE(PG8_SB(0, 1), b2 + hstep, voffB); PG8_STAGE(PG8_SA(0, 0), a2, voffA);
            PG8_WAIT_V(8); PG8_WAIT_L(0); PG8_BAR; PG8_MMA(1, 0, At, B0); PG8_MMA(1, 1, At, B1); PG8_BAR; PG8_SCHED;
            PG8_LDB(B0, 1, 0); PG8_LDB(B1, 1, 1); PG8_SCHED; PG8_LDA(At, 1, 0); PG8_STAGE(PG8_SA(0, 1), a2 + hstep, voffA);
            PG8_WAIT_V(8); PG8_WAIT_L(0); PG8_BAR; PG8_MMA(0, 0, At, B0); PG8_MMA(0, 1, At, B1); PG8_BAR; PG8_SCHED;
            PG8_LDA(At, 1, 1); PG8_STAGE(PG8_SB(1, 0), b3, voffB); PG8_STAGE(PG8_SB(1, 1), b3 + hstep, voffB); PG8_STAGE(PG8_SA(1, 0), a3, voffA);
            PG8_WAIT_V(8); PG8_WAIT_L(0); PG8_BAR; PG8_MMA(1, 0, At, B0); PG8_MMA(1, 1, At, B1); PG8_BAR; PG8_SCHED;
            } else {
            PG8_LDB(B0, 0, 0); PG8_SCHED; PG8_LDA(At, 0, 0); PG8_STAGE(PG8_SA(1, 1), a1 + hstep, voffA);
            PG8_WAIT_L(8); PG8_BAR; PG8_WAIT_L(0); PG8_MMA(0, 0, At, B0); PG8_BAR; PG8_SCHED;
            PG8_LDB(B1, 0, 1); PG8_STAGE(PG8_SB(0, 0), b2, voffB);
            PG8_BAR; PG8_WAIT_L(0); PG8_MMA(0, 1, At, B1); PG8_BAR;
            PG8_LDA(At, 0, 1); PG8_STAGE(PG8_SA(0, 0), a2, voffA);
            PG8_BAR; PG8_WAIT_L(0); PG8_MMA(1, 0, At, B0); PG8_BAR; PG8_SCHED;
            PG8_STAGE(PG8_SB(0, 1), b2 + hstep, voffB);
            PG8_WAIT_V(6); PG8_BAR; PG8_MMA(1, 1, At, B1); PG8_BAR;
            PG8_LDB(B0, 1, 0); PG8_SCHED; PG8_LDA(At, 1, 0); PG8_STAGE(PG8_SA(0, 1), a2 + hstep, voffA);
            PG8_WAIT_L(8); PG8_BAR; PG8_WAIT_L(0); PG8_MMA(0, 0, At, B0); PG8_BAR; PG8_SCHED;
            PG8_LDB(B1, 1, 1); PG8_STAGE(PG8_SB(1, 0), b3, voffB);
            PG8_BAR; PG8_WAIT_L(0); PG8_MMA(0, 1, At, B1); PG8_BAR;
            PG8_LDA(At, 1, 1); PG8_STAGE(PG8_SA(1, 0), a3, voffA);
            PG8_BAR; PG8_WAIT_L(0); PG8_MMA(1, 0, At, B0); PG8_BAR; PG8_SCHED;
            PG8_STAGE(PG8_SB(1, 1), b3 + hstep, voffB);
            PG8_WAIT_V(6); PG8_BAR; PG8_MMA(1, 1, At, B1); PG8_BAR;
            }
        }
        if constexpr (ALIGN_EPI) { if (wr == 0) PG8_BAR; }
        E(acc, cur, wr, wc, fr, fq);
        if (!has_next) break;
#pragma unroll
        for (int a = 0; a < 2; ++a)
#pragma unroll
            for (int b = 0; b < 2; ++b)
#pragma unroll
                for (int m = 0; m < 4; ++m)
#pragma unroll
                    for (int n = 0; n < 2; ++n) acc[a][b][m][n] = (f32x4){0.f, 0.f, 0.f, 0.f};
        cur = nxt; cA = nA; cB = nB; ++ui;
        if constexpr (ALIGN_EPI) { if (wr == 1) PG8_BAR; }
    }
    PG8_WAIT_V(0);
    if constexpr (!ALIGN_EPI) { if (wr == 0) PG8_BAR; }
    PG8_BAR;
#undef PG8_SA
#undef PG8_SB
#undef PG8_STAGE
#undef PG8_LDA
#undef PG8_LDB
#undef PG8_MMA
#undef PG8_WAIT_V
#undef PG8_WAIT_L
#undef PG8_BAR
#undef PG8_SCHED
}
}

struct EpiArgs {
    GAS bf16_t* out; const GAS float* ssp; GAS float* gates; GAS float* o0; GAS float* o1; GAS float* o2; GAS float* o3;
    const GAS float* base_p; const GAS float* base_s; GAS float* X; GAS bf16_t* Xb; GAS float* ssp_out;
};
__device__ __forceinline__ float row_rstd(const GAS float* ssp, int row) {
    const GAS f32x4* p = (const GAS f32x4*)(ssp + (size_t)row * 16);
    const f32x4 a = p[0], b = p[1], c = p[2], d = p[3];
    const float s = ((a[0] + a[1]) + (a[2] + a[3])) + ((b[0] + b[1]) + (b[2] + b[3])) + ((c[0] + c[1]) + (c[2] + c[3])) + ((d[0] + d[1]) + (d[2] + d[3]));
    return rsqrtf(s * (1.0f / 1024.0f) + EPS);
}
template <int MODE, bool SMALL>
__device__ __forceinline__ float epi_apply(const EpiArgs& a, int row, int g32, int fq, f32x4 v0, f32x4 v1, float rstd) {
    const int c0 = 32 * g32 + 8 * fq;
    if constexpr (MODE == 0) {
        if (g32 >= ABIN / 32) return 0.f;
        v0 *= rstd; v1 *= rstd;
        u32x4 w; w.x = pk2(v0[0], v0[1]); w.y = pk2(v0[2], v0[3]); w.z = pk2(v1[0], v1[1]); w.w = pk2(v1[2], v1[3]);
        *(GAS u32x4*)(a.out + (size_t)row * ABIN + c0) = w;
        if (g32 == 48 && fq < 2) { GAS float* gp = a.gates + (size_t)row * 32 + 8 * fq; *(GAS f32x4*)gp = v0; *(GAS f32x4*)(gp + 4) = v1; }
        if (g32 == 96 && fq >= 2) { GAS float* gp = a.gates + (size_t)row * 32 + 16 + 8 * (fq - 2); *(GAS f32x4*)gp = v0; *(GAS f32x4*)(gp + 4) = v1; }
        if (c0 < DNQKV) {
            if constexpr (!SMALL) { const int t = row & (SEQ - 1), b = row >> 12; if (t >= SEQ - 3) { GAS float* d = a.o0 + (size_t)(b * 3 + (t - (SEQ - 3))) * DNQKV + c0; *(GAS f32x4*)d = v0; *(GAS f32x4*)(d + 4) = v1; } }
            else { const int r = row - TP, t = r & 15, b = r >> 4; if (t >= SSEQ - 3) { GAS float* d = a.o1 + (size_t)(b * 3 + (t - (SSEQ - 3))) * DNQKV + c0; *(GAS f32x4*)d = v0; *(GAS f32x4*)(d + 4) = v1; } }
        }
        return 0.f;
    } else if constexpr (MODE == 1) {
        v0 *= rstd; v1 *= rstd;
        u32x4 w; w.x = pk2(v0[0], v0[1]); w.y = pk2(v0[2], v0[3]); w.z = pk2(v1[0], v1[1]); w.w = pk2(v1[2], v1[3]);
        *(GAS u32x4*)(a.out + (size_t)row * NQKV + c0) = w;
        if (c0 >= 1024) {
            const int isv = c0 >= 2048, cc = c0 - 1024 - 1024 * isv;
            if constexpr (!SMALL) { const int t = row & (SEQ - 1), b = row >> 12; if (t >= SEQ - 512) { GAS float* d = a.o0 + (size_t)isv * (O_CVP - O_CKP) + (size_t)(b * 512 + (t - (SEQ - 512))) * 1024 + cc; *(GAS f32x4*)d = v0; *(GAS f32x4*)(d + 4) = v1; } }
            else { const int r = row - TP; GAS float* d = a.o2 + (size_t)isv * (O_CVS - O_CKS) + (size_t)r * 1024 + cc; *(GAS f32x4*)d = v0; *(GAS f32x4*)(d + 4) = v1; }
        }
        return 0.f;
    } else if constexpr (MODE == 2) {
        GAS u32x4* xp = (GAS u32x4*)(a.Xb + (size_t)row * DM + c0);
        const u32x4 bw = *xp;
        f32x4 x0, x1;
        x0[0] = __builtin_bit_cast(float, bw[0] << 16) + v0[0]; x0[1] = __builtin_bit_cast(float, bw[0] & 0xffff0000u) + v0[1]; x0[2] = __builtin_bit_cast(float, bw[1] << 16) + v0[2]; x0[3] = __builtin_bit_cast(float, bw[1] & 0xffff0000u) + v0[3];
        x1[0] = __builtin_bit_cast(float, bw[2] << 16) + v1[0]; x1[1] = __builtin_bit_cast(float, bw[2] & 0xffff0000u) + v1[1]; x1[2] = __builtin_bit_cast(float, bw[3] << 16) + v1[2]; x1[3] = __builtin_bit_cast(float, bw[3] & 0xffff0000u) + v1[3];
        u32x4 w; w.x = pk2(x0[0], x0[1]); w.y = pk2(x0[2], x0[3]); w.z = pk2(x1[0], x1[1]); w.w = pk2(x1[2], x1[3]);
        *xp = w;
        return ((x0[0] * x0[0] + x0[1] * x0[1]) + (x0[2] * x0[2] + x0[3] * x0[3])) + ((x1[0] * x1[0] + x1[1] * x1[1]) + (x1[2] * x1[2] + x1[3] * x1[3]));
    } else {
        v0 *= rstd; v1 *= rstd;
        float h[4];
#pragma unroll
        for (int j = 0; j < 4; ++j) h[j] = silu_f(v0[j]) * v1[j];
        u32x2 w; w.x = pk2(h[0], h[1]); w.y = pk2(h[2], h[3]);
        *(GAS u32x2*)(a.out + (size_t)row * DFF + 16 * g32 + 4 * fq) = w;
        return 0.f;
    }
}
constexpr int EA_OFF = 131072 + 512;
__device__ __forceinline__ EpiArgs load_ea(const LAS unsigned long long* ap) {
    EpiArgs a;
    a.out = (GAS bf16_t*)ap[0]; a.ssp = (const GAS float*)ap[1]; a.gates = (GAS float*)ap[2]; a.o0 = (GAS float*)ap[3]; a.o1 = (GAS float*)ap[4]; a.o2 = (GAS float*)ap[5]; a.o3 = (GAS float*)ap[6];
    a.base_p = (const GAS float*)ap[7]; a.base_s = (const GAS float*)ap[8]; a.X = (GAS float*)ap[9]; a.Xb = (GAS bf16_t*)ap[10]; a.ssp_out = (GAS float*)ap[11];
    return a;
}
template <int MODE> struct Epi {
    const LAS unsigned long long* ap;
    __device__ __forceinline__ void operator()(const f32x4 (&acc)[2][2][4][2], const pg8::Unit& u, int wr, int wc, int fr, int fq) const {
        const EpiArgs a = load_ea(ap);
        if constexpr (MODE != 2) {
            f32x4 pq[2][4]; float rs[2][4];
#pragma unroll
            for (int ai = 0; ai < 2; ++ai)
#pragma unroll
                for (int m = 0; m < 4; ++m) { const int row = u.pm * 256 + ai * 128 + wr * 64 + m * 16 + fr; pq[ai][m] = *(const GAS f32x4*)(a.ssp + (size_t)row * 16 + 4 * fq); }
#pragma unroll
            for (int ai = 0; ai < 2; ++ai)
#pragma unroll
                for (int m = 0; m < 4; ++m) { float sp = (pq[ai][m][0] + pq[ai][m][1]) + (pq[ai][m][2] + pq[ai][m][3]); sp += __shfl_xor(sp, 16); sp += __shfl_xor(sp, 32); rs[ai][m] = rsqrtf(sp * (1.0f / 1024.0f) + EPS); }
#pragma unroll
            for (int ai = 0; ai < 2; ++ai)
#pragma unroll
                for (int m = 0; m < 4; ++m) {
                    const int row = u.pm * 256 + ai * 128 + wr * 64 + m * 16 + fr;
#pragma unroll
                    for (int bj = 0; bj < 2; ++bj) { const int g32 = (u.pn * 256 + bj * 128 + wc * 32) >> 5; (void)epi_apply<MODE, false>(a, row, g32, fq, acc[ai][bj][m][0], acc[ai][bj][m][1], rs[ai][m]); }
                }
        } else {
#pragma unroll
            for (int ai = 0; ai < 2; ++ai) {
                u32x4 bs[4][2];
#pragma unroll
                for (int m = 0; m < 4; ++m)
#pragma unroll
                    for (int bj = 0; bj < 2; ++bj) { const int row = u.pm * 256 + ai * 128 + wr * 64 + m * 16 + fr, c0 = u.pn * 256 + bj * 128 + wc * 32 + 8 * fq;
                        bs[m][bj] = *(const GAS u32x4*)(a.Xb + (size_t)row * DM + c0); }
#pragma unroll
                for (int m = 0; m < 4; ++m) {
                    const int row = u.pm * 256 + ai * 128 + wr * 64 + m * 16 + fr; float ss = 0.f;
#pragma unroll
                    for (int bj = 0; bj < 2; ++bj) { const int c0 = u.pn * 256 + bj * 128 + wc * 32 + 8 * fq; const u32x4 bw = bs[m][bj];
                        f32x4 x0, x1;
                        x0[0] = __builtin_bit_cast(float, bw[0] << 16); x0[1] = __builtin_bit_cast(float, bw[0] & 0xffff0000u); x0[2] = __builtin_bit_cast(float, bw[1] << 16); x0[3] = __builtin_bit_cast(float, bw[1] & 0xffff0000u);
                        x1[0] = __builtin_bit_cast(float, bw[2] << 16); x1[1] = __builtin_bit_cast(float, bw[2] & 0xffff0000u); x1[2] = __builtin_bit_cast(float, bw[3] << 16); x1[3] = __builtin_bit_cast(float, bw[3] & 0xffff0000u);
                        x0 += acc[ai][bj][m][0]; x1 += acc[ai][bj][m][1];
                        u32x4 w; w.x = pk2(x0[0], x0[1]); w.y = pk2(x0[2], x0[3]); w.z = pk2(x1[0], x1[1]); w.w = pk2(x1[2], x1[3]);
                        *(GAS u32x4*)(a.Xb + (size_t)row * DM + c0) = w;
                        ss += ((x0[0] * x0[0] + x0[1] * x0[1]) + (x0[2] * x0[2] + x0[3] * x0[3])) + ((x1[0] * x1[0] + x1[1] * x1[1]) + (x1[2] * x1[2] + x1[3] * x1[3])); }
                    ss += __shfl_xor(ss, 16); ss += __shfl_xor(ss, 32); if (fq == 0) a.ssp_out[(size_t)row * 16 + u.pn * 4 + wc] = ss;
                }
            }
        }
    }
};

template <int MODE>
__device__ __forceinline__ void small_gemm(const bf16_t* A, const bf16_t* Bt, int Npos, int K, const LAS unsigned long long* eap, LAS unsigned char* lds, int wg, int G, int wid, int lane) {
    const int fr = lane & 15, fq = lane >> 4, ncg = (MODE == 0 ? (ABIN + 63) / 64 : Npos / 64), nunits = (TS / 16) * ncg, KW = K / 8;
    LAS f32x4* part = (LAS f32x4*)lds;
    for (int u = wg; u < nunits; u += G) {
        const int rb = u % (TS / 16), cgp = u / (TS / 16), r0 = TP + rb * 16, p0 = cgp * 64;
        f32x4 acc[4];
#pragma unroll
        for (int f = 0; f < 4; ++f) acc[f] = (f32x4){0.f, 0.f, 0.f, 0.f};
        const bf16_t* ap = A + (size_t)(r0 + fr) * K + wid * KW + 8 * fq;
        const bf16_t* bp = Bt + (size_t)(p0 + fr) * K + wid * KW + 8 * fq;
        for (int k0 = 0; k0 < KW; k0 += 32) {
            const bf16x8 av = *(const bf16x8*)(ap + k0);
            bf16x8 wv[4];
#pragma unroll
            for (int f = 0; f < 4; ++f) wv[f] = *(const bf16x8*)(bp + (size_t)(16 * f) * K + k0);
#pragma unroll
            for (int f = 0; f < 4; ++f) acc[f] = __builtin_amdgcn_mfma_f32_16x16x32_bf16(wv[f], av, acc[f], 0, 0, 0);
        }
#pragma unroll
        for (int f = 0; f < 4; ++f) part[(wid * 4 + f) * 64 + lane] = acc[f];
        __syncthreads();
        if (wid == 0) {
#pragma unroll
            for (int w = 1; w < 8; ++w)
#pragma unroll
                for (int f = 0; f < 4; ++f) acc[f] += part[(w * 4 + f) * 64 + lane];
            const int row = r0 + fr;
            const EpiArgs a = load_ea(eap);
            float rstd = 1.f; if constexpr (MODE != 2) rstd = row_rstd(a.ssp, row);
            float ss = 0.f;
#pragma unroll
            for (int gq = 0; gq < 2; ++gq) ss += epi_apply<MODE, true>(a, row, (p0 >> 5) + gq, fq, acc[2 * gq], acc[2 * gq + 1], rstd);
            if constexpr (MODE == 2) { ss += __shfl_xor(ss, 16); ss += __shfl_xor(ss, 32); if (fq == 0) a.ssp_out[(size_t)row * 16 + cgp] = ss; }
        }
        __syncthreads();
    }
}

__device__ __forceinline__ void transpose_item(const float* W, int K, int Nsrc, int gu, const float* gamma, bf16_t* WT, LAS float* scr, int item, int npb, int lane) {
    const int kb = item / npb, nb = item % npb, k0 = 64 * kb, p0 = 32 * nb;
    const int cl = p0 + pg8::perm32(lane & 31);
    int src = cl; if (gu) src = ((cl >> 2) & 1) * DFF + 4 * (cl >> 3) + (cl & 3);
    const bool valid = src < Nsrc;
    const int srcc = valid ? src : 0; const float vmask = valid ? 1.f : 0.f;
    float wv[32];
#pragma unroll
    for (int i = 0; i < 32; ++i) wv[i] = W[(size_t)(k0 + 2 * i + (lane >> 5)) * Nsrc + srcc];
    if (gamma) {
#pragma unroll
        for (int i = 0; i < 32; ++i) wv[i] *= gamma[k0 + 2 * i + (lane >> 5)];
    }
#pragma unroll
    for (int i = 0; i < 32; ++i) scr[(2 * i + (lane >> 5)) * 33 + (lane & 31)] = wv[i] * vmask;
    asm volatile("s_waitcnt lgkmcnt(0)" ::: "memory");
    const int c = lane & 7;
#pragma unroll
    for (int j = 0; j < 4; ++j) { const int n = (lane >> 3) + 8 * j; const LAS float* s = scr + (8 * c) * 33 + n;
        u32x4 o; o.x = pk2(s[0 * 33], s[1 * 33]); o.y = pk2(s[2 * 33], s[3 * 33]); o.z = pk2(s[4 * 33], s[5 * 33]); o.w = pk2(s[6 * 33], s[7 * 33]);
        *(u32x4*)(WT + (size_t)(p0 + n) * K + k0 + 8 * c) = o; }
    asm volatile("s_waitcnt lgkmcnt(0)" ::: "memory");
}
__device__ __forceinline__ void convert_matrix(const float* W, int K, int Nsrc, int Npos, int gu, const float* gamma, bf16_t* WT, LAS float* scr, int gw, int ngw, int lane) {
    const int npb = Npos / 32, nitems = (K / 64) * npb;
    for (int it = gw; it < nitems; it += ngw) transpose_item(W, K, Nsrc, gu, gamma, WT, scr, it, npb, lane);
}
__device__ __forceinline__ void convert_mats(const Params& P, LAS unsigned char* lds, int m_lo, int m_hi, int gw, int ngw, int wid, int lane) {
    LAS float* scr = (LAS float*)(lds + wid * 8704);
    unsigned char* ws = P.ws;
    for (int mi = m_lo; mi < m_hi; ++mi) {
        int type, idx;
        if (mi < 4) { type = (mi == 0) ? 0 : (mi == 1) ? 1 : (mi == 2) ? 4 : 5; idx = 0; }
        else { const int r = mi - 4, grp = r >> 2, q = r & 3;
            if (q >= 2) { type = q + 2; idx = grp + 1; } else if (grp == 1) { type = q; idx = 1; } else { type = 2 + q; idx = grp >> 1; } }
        const float* W; const float* gamma = nullptr; bf16_t* WT; int K = 1024, Nsrc, Npos, gu = 0;
        if (type == 0) { W = P.in[8] + (size_t)idx * 1024 * ABIN; gamma = P.in[7] + idx * 1024; WT = (bf16_t*)(ws + WS_WIN + idx * SZ_WIN); Nsrc = ABIN; Npos = ABPAD; }
        else if (type == 1) { W = P.in[16] + (size_t)idx * 1024 * 1024; WT = (bf16_t*)(ws + WS_WOUT + idx * SZ_W1K); Nsrc = 1024; Npos = 1024; }
        else if (type == 2) { W = P.in[18] + (size_t)idx * 1024 * NQKV; gamma = P.in[17] + idx * 1024; WT = (bf16_t*)(ws + WS_WQKV + idx * SZ_WQKV); Nsrc = NQKV; Npos = NQKV; }
        else if (type == 3) { W = P.in[20] + (size_t)idx * 1024 * 1024; WT = (bf16_t*)(ws + WS_WCOUT + idx * SZ_W1K); Nsrc = 1024; Npos = 1024; }
        else if (type == 4) { W = P.in[22] + (size_t)idx * 1024 * NGU; gamma = P.in[21] + idx * 1024; WT = (bf16_t*)(ws + WS_WGU + idx * SZ_WGU); Nsrc = NGU; Npos = NGU; gu = 1; }
        else { W = P.in[23] + (size_t)idx * DFF * 1024; WT = (bf16_t*)(ws + WS_WDN + idx * SZ_WDN); K = DFF; Nsrc = 1024; Npos = 1024; }
        convert_matrix(W, K, Nsrc, Npos, gu, gamma, WT, scr, gw, ngw, lane);
    }
}
__device__ __forceinline__ void phase_prologue(const Params& P, LAS unsigned char* lds, int gw, int ngw, int wid, int lane) {
    convert_mats(P, lds, 0, 1, gw, ngw, wid, lane);
    unsigned char* ws = P.ws;
    bf16_t* Xb = (bf16_t*)(ws + WS_XB); float* ssp = (float*)(ws + WS_SSP);
    for (int row = gw; row < TR; row += ngw) {
        const float* xr = (row < TP) ? P.in[0] + (size_t)row * DM : P.in[1] + (size_t)(row - TP) * DM;
        f32x4 v[4]; float s = 0.f;
#pragma unroll
        for (int j = 0; j < 4; ++j) { v[j] = ((const f32x4*)xr)[lane + 64 * j]; s += (v[j][0] * v[j][0] + v[j][1] * v[j][1]) + (v[j][2] * v[j][2] + v[j][3] * v[j][3]); }
        s = wave_sum(s);
#pragma unroll
        for (int j = 0; j < 4; ++j) { u32x2 w; w.x = pk2(v[j][0], v[j][1]); w.y = pk2(v[j][2], v[j][3]); ((u32x2*)(Xb + (size_t)row * DM))[lane + 64 * j] = w; }
        if (lane < 16) ssp[(size_t)row * 16 + lane] = (lane == 0) ? s : 0.f;
    }
}
__device__ __forceinline__ void phase_final(const Params& P, int gw, int ngw, int lane) {
    const GAS float* ssp = (const GAS float*)(P.ws + WS_SSP); const float* g = P.in[24]; const bf16_t* Xb = (const bf16_t*)(P.ws + WS_XB);
    f32x4 gv[4];
#pragma unroll
    for (int j = 0; j < 4; ++j) gv[j] = ((const f32x4*)g)[lane + 64 * j];
    for (int row = gw; row < TR; row += ngw) {
        const float rstd = row_rstd(ssp, row);
        f32x4* yr = (f32x4*)(P.out + (size_t)row * DM);
#pragma unroll
        for (int j = 0; j < 4; ++j) { const u32x2 w = ((const u32x2*)(Xb + (size_t)row * DM))[lane + 64 * j];
            f32x4 v; v[0] = __builtin_bit_cast(float, w[0] << 16); v[1] = __builtin_bit_cast(float, w[0] & 0xffff0000u); v[2] = __builtin_bit_cast(float, w[1] << 16); v[3] = __builtin_bit_cast(float, w[1] & 0xffff0000u);
            yr[lane + 64 * j] = v * rstd * gv[j]; }
    }
}

constexpr int MX_CH = 32;
#define LDS_BARRIER() asm volatile("s_waitcnt lgkmcnt(0)\n\ts_barrier" ::: "memory")
__device__ __forceinline__ void delta_unit(const Params& P, LAS unsigned char* lds, int li, bool sample, int b, int h, int half, const int tid) {
    const int lane = tid & 63, wid = __builtin_amdgcn_readfirstlane(tid >> 6);
    const int L = sample ? SSEQ : SEQ, rowbase = sample ? TP + b * SSEQ : b * SEQ;
    const bf16_t* PROJ = (const bf16_t*)(P.ws + WS_R1); const float* GATES = (const float*)(P.ws + WS_GATES); bf16_t* MIX = (bf16_t*)(P.ws + WS_MIX);
    const int NC = (L + MX_CH - 1) / MX_CH;
    constexpr int SET = 4 * 8192 + 256;
    if (wid < 4) __builtin_amdgcn_s_setprio(2);
    const int e = 32 * half + (wid & 3) * 8 + (lane >> 3), dq = lane & 7;
    f32x2 S[4];
    float* sout = P.out + (sample ? O_DNS : O_DNP) + (size_t)((li * 8 + b) * 8 + h) * 4096;
    if (wid < 4) {
        if (sample) { const float* s0 = P.in[3] + (size_t)((li * 8 + b) * 8 + h) * 4096;
#pragma unroll
            for (int j = 0; j < 4; ++j) { S[j][0] = s0[(8 * dq + 2 * j) * 64 + e]; S[j][1] = s0[(8 * dq + 2 * j + 1) * 64 + e]; } }
        else {
#pragma unroll
            for (int j = 0; j < 4; ++j) S[j] = (f32x2){0.f, 0.f}; }
    }
    const int pw = wid - 4, c = lane;
    float cwq[4], cwk[4], cwv[4], alog = 0.f, dtb = 0.f;
    float rq[11], rk[11], rv[11], ga = 0.f, gb_ = 0.f;
    if (wid >= 4) {
        const float* cw = P.in[9] + (size_t)li * 4 * DNQKV;
#pragma unroll
        for (int t = 0; t < 4; ++t) { cwq[t] = cw[t * DNQKV + h * 64 + c]; cwk[t] = cw[t * DNQKV + 512 + h * 64 + c]; cwv[t] = cw[t * DNQKV + 1024 + h * 64 + c]; }
        alog = P.in[10][li * 8 + h]; dtb = P.in[11][li * 8 + h];
    }
#define DN_LOADS(jn) do { const int t0n_ = (jn) * MX_CH + pw * 8; if ((jn) < NC && t0n_ < L) { \
        _Pragma("unroll") for (int r = 0; r < 11; ++r) { const int t = t0n_ - 3 + r, tc = max(t, 0); const bf16_t* pr = PROJ + (size_t)(rowbase + tc) * ABIN + h * 64 + c; \
            const float m = (t >= 0) ? 1.f : 0.f; rq[r] = bf2f(pr[0]) * m; rk[r] = bf2f(pr[512]) * m; rv[r] = bf2f(pr[1024]) * m; } \
        { const float* gp = GATES + (size_t)(rowbase + t0n_ + (lane & 7)) * 32; ga = gp[h]; gb_ = gp[8 + h]; } \
        if (sample && t0n_ == 0) { _Pragma("unroll") for (int r = 0; r < 3; ++r) { const float* cb = P.in[2] + (size_t)((li * 8 + b) * 3 + r) * DNQKV + h * 64 + c; rq[r] = cb[0]; rk[r] = cb[512]; rv[r] = cb[1024]; } } } } while (0)
    if (wid >= 4) DN_LOADS(0);
    for (int j = 0; j < NC + 2; ++j) {
        if (wid >= 4) {
            if (j < NC) {
                LAS float* qs = (LAS float*)(lds + (j & 1) * SET); LAS float* ks = qs + 2048; LAS float* vs = qs + 4096; LAS float* sc = qs + 8192;
                const int t0 = j * MX_CH + pw * 8;
                if (t0 < L) {
#pragma unroll
                    for (int i = 0; i < 8; ++i) {
                        float q = cwq[0] * rq[i] + cwq[1] * rq[i + 1] + cwq[2] * rq[i + 2] + cwq[3] * rq[i + 3];
                        float k = cwk[0] * rk[i] + cwk[1] * rk[i + 1] + cwk[2] * rk[i + 2] + cwk[3] * rk[i + 3];
                        float v = cwv[0] * rv[i] + cwv[1] * rv[i + 1] + cwv[2] * rv[i + 2] + cwv[3] * rv[i + 3];
                        q = silu_f(q); k = silu_f(k); v = silu_f(v);
                        const float sq = wave_sum(q * q), sk = wave_sum(k * k);
                        const int tok = pw * 8 + i;
                        qs[tok * 64 + c] = q * rsqrtf(sq + EPS) * 0.125f; ks[tok * 64 + c] = k * rsqrtf(sk + EPS); vs[tok * 64 + c] = v;
                    }
                    if (lane < 8) { const float g = -__expf(alog) * softplus_f(ga + dtb); sc[(pw * 8 + lane) * 2] = __expf(g); sc[(pw * 8 + lane) * 2 + 1] = sigmoid_f(gb_); }
                }
            }
            DN_LOADS(j + 1);
            if (j >= 2) {
                LAS float* os = (LAS float*)(lds + (j & 1) * SET) + 6144;
                const int t0 = (j - 2) * MX_CH + pw * 8;
                if (t0 < L && (c >> 5) == half) {
#pragma unroll
                    for (int i = 0; i < 8; ++i) {
                        const int tok = pw * 8 + i; const size_t row = (size_t)(rowbase + t0 + i);
                        MIX[row * DM + h * 64 + c] = (bf16_t)f2bf(os[tok * 64 + c]);
                    }
                }
            }
        } else if (j >= 1 && j <= NC) {
            LAS float* qs = (LAS float*)(lds + ((j - 1) & 1) * SET); LAS float* ks = qs + 2048; LAS float* vs = qs + 4096; LAS float* os = qs + 6144; LAS float* sc = qs + 8192;
            const int ntok = min(MX_CH, L - (j - 1) * MX_CH);
            f32x4 kA0, kA1, qA0, qA1, kB0, kB1, qB0, qB1; float vA, vB; f32x2 gA, gB;
            kA0 = *(const LAS f32x4*)(ks + 8 * dq); kA1 = *(const LAS f32x4*)(ks + 8 * dq + 4); qA0 = *(const LAS f32x4*)(qs + 8 * dq); qA1 = *(const LAS f32x4*)(qs + 8 * dq + 4);
            vA = vs[e]; gA = *(const LAS f32x2*)(sc);
#define DN_STEP(TOK, K0, K1, Q0, Q1, VE, GB, NK0, NK1, NQ0, NQ1, NVE, NGB) do { \
                const int tn_ = min((TOK) + 1, ntok - 1); \
                NK0 = *(const LAS f32x4*)(ks + tn_ * 64 + 8 * dq); NK1 = *(const LAS f32x4*)(ks + tn_ * 64 + 8 * dq + 4); NQ0 = *(const LAS f32x4*)(qs + tn_ * 64 + 8 * dq); NQ1 = *(const LAS f32x4*)(qs + tn_ * 64 + 8 * dq + 4); \
                NVE = vs[tn_ * 64 + e]; NGB = *(const LAS f32x2*)(sc + tn_ * 2); \
                const float eg = GB[0], beta = GB[1]; \
                const f32x2 wa = (f32x2){K0[0], K0[1]} * S[0] + (f32x2){K0[2], K0[3]} * S[1]; \
                const f32x2 wb = (f32x2){K1[0], K1[1]} * S[2] + (f32x2){K1[2], K1[3]} * S[3]; \
                const f32x2 ws2 = wa + wb; \
                const float w = oct_sum(ws2[0] + ws2[1]); \
                const float dl = beta * (VE - eg * w); \
                const f32x2 eg2 = (f32x2){eg, eg}, dl2 = (f32x2){dl, dl}; \
                S[0] = S[0] * eg2 + (f32x2){K0[0], K0[1]} * dl2; S[1] = S[1] * eg2 + (f32x2){K0[2], K0[3]} * dl2; \
                S[2] = S[2] * eg2 + (f32x2){K1[0], K1[1]} * dl2; S[3] = S[3] * eg2 + (f32x2){K1[2], K1[3]} * dl2; \
                const f32x2 oa = (f32x2){Q0[0], Q0[1]} * S[0] + (f32x2){Q0[2], Q0[3]} * S[1]; \
                const f32x2 ob = (f32x2){Q1[0], Q1[1]} * S[2] + (f32x2){Q1[2], Q1[3]} * S[3]; \
                const f32x2 os2 = oa + ob; \
                os[(TOK) * 64 + e] = oct_sum(os2[0] + os2[1]); } while (0)
            for (int tok = 0; tok < ntok; tok += 2) {
                DN_STEP(tok, kA0, kA1, qA0, qA1, vA, gA, kB0, kB1, qB0, qB1, vB, gB);
                DN_STEP(tok + 1, kB0, kB1, qB0, qB1, vB, gB, kA0, kA1, qA0, qA1, vA, gA);
            }
#undef DN_STEP
        }
        LDS_BARRIER();
    }
#undef DN_LOADS
    if (wid < 4) {
#pragma unroll
        for (int j = 0; j < 4; ++j) { sout[(8 * dq + 2 * j) * 64 + e] = S[j][0]; sout[(8 * dq + 2 * j + 1) * 64 + e] = S[j][1]; }
    }
    __builtin_amdgcn_s_setprio(0);
}

__device__ __forceinline__ void gla_unit(const Params& P, LAS unsigned char* lds, int li, bool sample, int b, int h, const int tid) {
    const int lane = tid & 63, wid = __builtin_amdgcn_readfirstlane(tid >> 6);
    const int L = sample ? SSEQ : SEQ, rowbase = sample ? TP + b * SSEQ : b * SEQ;
    const bf16_t* PROJ = (const bf16_t*)(P.ws + WS_R1); const float* GATES = (const float*)(P.ws + WS_GATES); bf16_t* MIX = (bf16_t*)(P.ws + WS_MIX);
    const int NC = (L + MX_CH - 1) / MX_CH;
    constexpr int SET = 3 * 4096 + 2 * 8192;
    if (wid < 4) __builtin_amdgcn_s_setprio(2);
    const int e = (wid & 3) * 16 + (lane >> 2), dq = lane & 3;
    f32x2 S[4];
    float* sout = P.out + (sample ? O_GLAS : O_GLAP) + (size_t)((li * 8 + b) * 8 + h) * 2048;
    if (wid < 4) {
        if (sample) { const float* s0 = P.in[4] + (size_t)((li * 8 + b) * 8 + h) * 2048;
#pragma unroll
            for (int j = 0; j < 4; ++j) { S[j][0] = s0[(8 * dq + 2 * j) * 64 + e]; S[j][1] = s0[(8 * dq + 2 * j + 1) * 64 + e]; } }
        else {
#pragma unroll
            for (int j = 0; j < 4; ++j) S[j] = (f32x2){0.f, 0.f}; }
    }
    const int pw = wid - 4, c = lane, c32 = lane & 31;
    float w2[16], gkb = 0.f, onorm = 0.f;
    if (wid >= 4) {
#pragma unroll
        for (int r = 0; r < 16; ++r) w2[r] = P.in[13][(size_t)(li * 16 + r) * 256 + h * 32 + c32];
        gkb = P.in[14][li * 256 + h * 32 + c32]; onorm = P.in[15][li * 64 + c];
    }
    for (int j = 0; j < NC + 2; ++j) {
        if (wid >= 4) {
            if (j < NC) {
                LAS float* qs = (LAS float*)(lds + (j & 1) * SET); LAS float* ks = qs + 1024; LAS float* gs = qs + 2048; LAS float* vs = qs + 3072;
                const int t0 = j * MX_CH + pw * 8;
                if (t0 < L) {
                    const int g4 = (lane >> 5) * 4;
                    float rv[8], rq[4], rk[4]; f32x4 lrv[4][4];
#pragma unroll
                    for (int i = 0; i < 8; ++i) rv[i] = bf2f(PROJ[(size_t)(rowbase + t0 + i) * ABIN + 2576 + h * 64 + c]);
#pragma unroll
                    for (int i = 0; i < 4; ++i) { const size_t row = (size_t)(rowbase + t0 + g4 + i); const bf16_t* pr = PROJ + row * ABIN;
                        rq[i] = bf2f(pr[2064 + h * 32 + c32]); rk[i] = bf2f(pr[2320 + h * 32 + c32]);
#pragma unroll
                        for (int r = 0; r < 4; ++r) lrv[i][r] = *(const f32x4*)(GATES + row * 32 + 16 + 4 * r); }
#pragma unroll
                    for (int i = 0; i < 8; ++i) vs[(pw * 8 + i) * 64 + c] = rv[i];
#pragma unroll
                    for (int i = 0; i < 4; ++i) {
                        const int tok = pw * 8 + g4 + i;
                        float z = gkb;
#pragma unroll
                        for (int r = 0; r < 4; ++r) z += (lrv[i][r][0] * w2[4 * r] + lrv[i][r][1] * w2[4 * r + 1]) + (lrv[i][r][2] * w2[4 * r + 2] + lrv[i][r][3] * w2[4 * r + 3]);
                        const float ls = -softplus_f(-z);
                        qs[tok * 32 + c32] = rq[i] * 0.17677669529663687f; ks[tok * 32 + c32] = rk[i]; gs[tok * 32 + c32] = __expf(ls * (1.0f / 16.0f));
                    }
                }
            }
            if (j >= 2) {
                LAS float* os = (LAS float*)(lds + (j & 1) * SET) + 3072 + 2048;
                const int t0 = (j - 2) * MX_CH + pw * 8;
                if (t0 < L) {
#pragma unroll
                    for (int i = 0; i < 8; ++i) {
                        const int tok = pw * 8 + i; const size_t row = (size_t)(rowbase + t0 + i);
                        MIX[row * DM + 512 + h * 64 + c] = (bf16_t)f2bf(os[tok * 64 + c]);
                    }
                }
            }
        } else if (j >= 1 && j <= NC) {
            LAS float* qs = (LAS float*)(lds + ((j - 1) & 1) * SET); LAS float* ks = qs + 1024; LAS float* gs = qs + 2048; LAS float* vs = qs + 3072; LAS float* os = qs + 3072 + 2048;
            const int ntok = min(MX_CH, L - (j - 1) * MX_CH);
            f32x4 kk[2], qq[2], gg[2]; float ve;
#pragma unroll
            for (int i = 0; i < 2; ++i) { kk[i] = *(const LAS f32x4*)(ks + 8 * dq + 4 * i); qq[i] = *(const LAS f32x4*)(qs + 8 * dq + 4 * i); gg[i] = *(const LAS f32x4*)(gs + 8 * dq + 4 * i); }
            ve = vs[e];
            for (int tok = 0; tok < ntok; ++tok) {
                const int tn = min(tok + 1, ntok - 1);
                f32x4 kn[2], qn[2], gn[2];
#pragma unroll
                for (int i = 0; i < 2; ++i) { kn[i] = *(const LAS f32x4*)(ks + tn * 32 + 8 * dq + 4 * i); qn[i] = *(const LAS f32x4*)(qs + tn * 32 + 8 * dq + 4 * i); gn[i] = *(const LAS f32x4*)(gs + tn * 32 + 8 * dq + 4 * i); }
                const float vn = vs[tn * 64 + e];
                const f32x2 v2 = (f32x2){ve, ve};
                f32x2 oa[2];
#pragma unroll
                for (int i = 0; i < 2; ++i) {
                    S[2 * i] = S[2 * i] * (f32x2){gg[i][0], gg[i][1]} + (f32x2){kk[i][0], kk[i][1]} * v2; S[2 * i + 1] = S[2 * i + 1] * (f32x2){gg[i][2], gg[i][3]} + (f32x2){kk[i][2], kk[i][3]} * v2;
                    oa[i] = (f32x2){qq[i][0], qq[i][1]} * S[2 * i] + (f32x2){qq[i][2], qq[i][3]} * S[2 * i + 1];
                }
                const f32x2 os2 = oa[0] + oa[1];
                const float o = quad_sum(os2[0] + os2[1]);
                if (dq == 0) os[tok * 64 + e] = o;
#pragma unroll
                for (int i = 0; i < 2; ++i) { kk[i] = kn[i]; qq[i] = qn[i]; gg[i] = gn[i]; }
                ve = vn;
            }
        }
        __syncthreads();
    }
    if (wid < 4) {
#pragma unroll
        for (int j = 0; j < 4; ++j) { sout[(8 * dq + 2 * j) * 64 + e] = S[j][0]; sout[(8 * dq + 2 * j + 1) * 64 + e] = S[j][1]; }
    }
    __builtin_amdgcn_s_setprio(0);
}

__device__ __forceinline__ void phase_fixup(const Params& P, int li, int gw, int ngw, int lane) {
    bf16_t* MIX = (bf16_t*)(P.ws + WS_MIX); const bf16_t* PROJ = (const bf16_t*)(P.ws + WS_R1);
    const float* on = (lane < 32 ? P.in[12] : P.in[15]) + li * 64 + 16 * (lane & 3);
    float g[16];
#pragma unroll
    for (int j = 0; j < 16; ++j) g[j] = on[j];
    const int gcol = (lane < 32) ? 1552 + 16 * lane : 3104 + 16 * (lane - 32);
    for (int row = gw; row < TR; row += ngw) {
        u32x4* mp = (u32x4*)(MIX + (size_t)row * DM + 16 * lane);
        const u32x4* gp = (const u32x4*)(PROJ + (size_t)row * ABIN + gcol);
        const u32x4 m0 = mp[0], m1 = mp[1], g0 = gp[0], g1 = gp[1];
        float o[16], gt[16];
#pragma unroll
        for (int j = 0; j < 4; ++j) { o[2 * j] = __builtin_bit_cast(float, m0[j] << 16); o[2 * j + 1] = __builtin_bit_cast(float, m0[j] & 0xffff0000u); o[8 + 2 * j] = __builtin_bit_cast(float, m1[j] << 16); o[8 + 2 * j + 1] = __builtin_bit_cast(float, m1[j] & 0xffff0000u);
            gt[2 * j] = __builtin_bit_cast(float, g0[j] << 16); gt[2 * j + 1] = __builtin_bit_cast(float, g0[j] & 0xffff0000u); gt[8 + 2 * j] = __builtin_bit_cast(float, g1[j] << 16); gt[8 + 2 * j + 1] = __builtin_bit_cast(float, g1[j] & 0xffff0000u); }
        float ss = 0.f;
#pragma unroll
        for (int j = 0; j < 16; ++j) ss += o[j] * o[j];
        ss = quad_sum(ss);
        const float rstd = rsqrtf(ss * (1.0f / 64.0f) + EPS);
        float r[16];
#pragma unroll
        for (int j = 0; j < 16; ++j) r[j] = o[j] * rstd * g[j] * silu_f(gt[j]);
        u32x4 w0, w1;
#pragma unroll
        for (int j = 0; j < 4; ++j) { w0[j] = pk2(r[2 * j], r[2 * j + 1]); w1[j] = pk2(r[8 + 2 * j], r[8 + 2 * j + 1]); }
        mp[0] = w0; mp[1] = w1;
    }
}

constexpr int AT_KOFF = 0, AT_VOFF = 2 * 9216, AT_BIAS = 4 * 9216;
__device__ __forceinline__ int vpos(int kv) { return 16 * (kv >> 4) + 8 * ((kv >> 2) & 1) + 4 * ((kv >> 3) & 1) + (kv & 3); }
__device__ __forceinline__ void attn_build_bias(const Params& P, LAS unsigned char* lds, int li, int h, const int tid) {
    const float* tb = P.in[19] + (size_t)(li * 16 + h) * 257;
    LAS float* bt = (LAS float*)(lds + AT_BIAS);
    for (int i = tid; i < 4 * 2 * 64 * 32; i += 512) {
        const int r = i & 31, lane = (i >> 5) & 63, par = (i >> 11) & 1, dist = i >> 12, hi = lane >> 5, r32 = lane & 31;
        const int kv = ((r & 3) + 8 * ((r & 15) >> 2) + 4 * hi) + 32 * (r >> 4), rel = r32 + 32 * par - kv + 64 * dist;
        const float v = (dist == 3) ? tb[256] : tb[min(rel, 128) + 128];
        bt[(((dist * 2 + par) * 8 + (r >> 2)) * 64 + lane) * 4 + (r & 3)] = v * 8.0f;
    }
}
__device__ __forceinline__ void attn_tile(const LAS unsigned char* Kb, const LAS unsigned char* Vb, const LAS f32x4* bp, const bf16x8 (&qr)[4], f32x16 (&o)[2], float& m, float& l, int r32, int hi) {
    const float C2 = 0.125f * LOG2E;
    f32x16 p0, p1;
#pragma unroll
    for (int j = 0; j < 4; ++j) { const f32x4 t0 = bp[j * 64], t1 = bp[(4 + j) * 64];
        p0[4 * j] = t0[0]; p0[4 * j + 1] = t0[1]; p0[4 * j + 2] = t0[2]; p0[4 * j + 3] = t0[3]; p1[4 * j] = t1[0]; p1[4 * j + 1] = t1[1]; p1[4 * j + 2] = t1[2]; p1[4 * j + 3] = t1[3]; }
#pragma unroll
    for (int d0 = 0; d0 < 4; ++d0) {
        const bf16x8 a0 = *(const LAS bf16x8*)(Kb + r32 * 144 + d0 * 32 + hi * 16);
        const bf16x8 a1 = *(const LAS bf16x8*)(Kb + (32 + r32) * 144 + d0 * 32 + hi * 16);
        p0 = __builtin_amdgcn_mfma_f32_32x32x16_bf16(a0, qr[d0], p0, 0, 0, 0);
        p1 = __builtin_amdgcn_mfma_f32_32x32x16_bf16(a1, qr[d0], p1, 0, 0, 0);
    }
    float mx = fmaxf(p0[0], p1[0]);
#pragma unroll
    for (int r = 1; r < 16; ++r) mx = fmaxf(mx, fmaxf(p0[r], p1[r]));
    mx = fmaxf(mx, __shfl_xor(mx, 32)) * C2;
    if (__any(mx > m + 8.0f)) {
        const float mn = fmaxf(m, mx), scl = __builtin_amdgcn_exp2f(m - mn); m = mn; l *= scl;
#pragma unroll
        for (int r = 0; r < 16; ++r) { o[0][r] *= scl; o[1][r] *= scl; }
    }
    float ls = 0.f; const float nm = -m;
#pragma unroll
    for (int r = 0; r < 16; ++r) { p0[r] = __builtin_amdgcn_exp2f(p0[r] * C2 + nm); p1[r] = __builtin_amdgcn_exp2f(p1[r] * C2 + nm); ls += p0[r] + p1[r]; }
    l += ls;
    u32x4 pw[4];
#pragma unroll
    for (int s = 0; s < 2; ++s) {
        pw[s] = (u32x4){pk2(p0[8 * s], p0[8 * s + 1]), pk2(p0[8 * s + 2], p0[8 * s + 3]), pk2(p0[8 * s + 4], p0[8 * s + 5]), pk2(p0[8 * s + 6], p0[8 * s + 7])};
        pw[2 + s] = (u32x4){pk2(p1[8 * s], p1[8 * s + 1]), pk2(p1[8 * s + 2], p1[8 * s + 3]), pk2(p1[8 * s + 4], p1[8 * s + 5]), pk2(p1[8 * s + 6], p1[8 * s + 7])};
    }
#pragma unroll
    for (int dh = 0; dh < 2; ++dh)
#pragma unroll
        for (int ks = 0; ks < 4; ++ks) {
            const bf16x8 vf = *(const LAS bf16x8*)(Vb + (32 * dh + r32) * 144 + (16 * ks + 8 * hi) * 2);
            o[dh] = __builtin_amdgcn_mfma_f32_32x32x16_bf16(vf, __builtin_bit_cast(bf16x8, pw[ks]), o[dh], 0, 0, 0);
        }
}
__device__ __forceinline__ void attn_prompt_unit(const Params& P, LAS unsigned char* lds, int li, int b, int h, int g4, const int tid) {
    const int lane = tid & 63, wid = __builtin_amdgcn_readfirstlane(tid >> 6), r32 = lane & 31, hi = lane >> 5;
    const bf16_t* QKV = (const bf16_t*)(P.ws + WS_R1); bf16_t* MIX = (bf16_t*)(P.ws + WS_MIX);
    const int cw = 4 * g4 + (wid >> 1);
    const size_t qrow = (size_t)b * SEQ + 256 * g4 + 32 * wid + r32;
    bf16x8 qr[4];
#pragma unroll
    for (int d0 = 0; d0 < 4; ++d0) qr[d0] = *(const bf16x8*)(QKV + qrow * NQKV + h * 64 + d0 * 16 + hi * 8);
    const int kt_lo = max(0, 4 * g4 - 8), kt_hi = 4 * g4 + 3;
    const int srow = tid & 63, sch = tid >> 6;
    const bf16_t* kvsrc = QKV + ((size_t)b * SEQ + srow) * NQKV + 1024 + h * 64 + 8 * sch;
    const int vp = vpos(srow);
    bf16x8 kA, vA, kB, vB;
#define AT_LOAD(K_, V_, kt) do { const bf16_t* s_ = kvsrc + (size_t)(kt) * 64 * NQKV; K_ = *(const bf16x8*)s_; V_ = *(const bf16x8*)(s_ + 1024); } while (0)
#define AT_STORE(K_, V_, buf) do { *(LAS bf16x8*)(lds + AT_KOFF + (buf) * 9216 + srow * 144 + sch * 16) = K_; \
        _Pragma("unroll") for (int j_ = 0; j_ < 8; ++j_) *(LAS short*)(lds + AT_VOFF + (buf) * 9216 + (8 * sch + j_) * 144 + vp * 2) = V_[j_]; } while (0)
    AT_LOAD(kA, vA, kt_lo); AT_LOAD(kB, vB, kt_lo + 1);
    AT_STORE(kA, vA, 0);
    LDS_BARRIER();
    float m = -1e30f, l = 0.f; f32x16 o[2];
#pragma unroll
    for (int r = 0; r < 16; ++r) { o[0][r] = 0.f; o[1][r] = 0.f; }
    const LAS f32x4* btl = (const LAS f32x4*)(lds + AT_BIAS) + (wid & 1) * 512 + lane;
    for (int kt = kt_lo; kt <= kt_hi; kt += 2) {
        if (kt + 2 <= kt_hi) AT_LOAD(kA, vA, kt + 2);
        if (kt >= cw - 8 && kt <= cw) attn_tile(lds + AT_KOFF, lds + AT_VOFF, btl + min(cw - kt, 3) * 1024, qr, o, m, l, r32, hi);
        AT_STORE(kB, vB, 1);
        LDS_BARRIER();
        if (kt + 3 <= kt_hi) AT_LOAD(kB, vB, kt + 3);
        if (kt + 1 >= cw - 8 && kt + 1 <= cw) attn_tile(lds + AT_KOFF + 9216, lds + AT_VOFF + 9216, btl + min(cw - kt - 1, 3) * 1024, qr, o, m, l, r32, hi);
        if (kt + 2 <= kt_hi) AT_STORE(kA, vA, 0);
        LDS_BARRIER();
    }
#undef AT_LOAD
#undef AT_STORE
    l += __shfl_xor(l, 32);
    const float rl = 1.0f / l;
    bf16_t* op = MIX + qrow * DM + h * 64;
#pragma unroll
    for (int dh = 0; dh < 2; ++dh)
#pragma unroll
        for (int r4 = 0; r4 < 4; ++r4) {
            u32x2 w; w.x = pk2(o[dh][4 * r4] * rl, o[dh][4 * r4 + 1] * rl); w.y = pk2(o[dh][4 * r4 + 2] * rl, o[dh][4 * r4 + 3] * rl);
            *(u32x2*)(op + 32 * dh + 8 * r4 + 4 * hi) = w;
        }
}
__device__ __forceinline__ void attn_sample_unit(const Params& P, LAS unsigned char* lds, int li, int b, int h, const int tid) {
    const int lane = tid & 63, wid = tid >> 6;
    const bf16_t* QKV = (const bf16_t*)(P.ws + WS_R1); bf16_t* MIX = (bf16_t*)(P.ws + WS_MIX);
    LAS float* qs = (LAS float*)lds;
    LAS float* sc = qs + 1024;
    LAS float* tab = sc + 16 * 528;
    const size_t rb = (size_t)TP + b * SSEQ;
    for (int i = tid; i < 1024; i += 512) qs[i] = bf2f(QKV[(rb + (i >> 6)) * NQKV + h * 64 + (i & 63)]);
    if (tid < 257) tab[tid] = P.in[19][(size_t)(li * 16 + h) * 257 + tid];
    __syncthreads();
    const float* kc = P.in[5] + ((size_t)(li * 8 + b) * 512) * 1024 + h * 64;
    const float* vc = P.in[6] + ((size_t)(li * 8 + b) * 512) * 1024 + h * 64;
    for (int j = tid; j < 528; j += 512) {
        float kr[64];
        if (j < 512) {
#pragma unroll
            for (int d = 0; d < 16; ++d) { const f32x4 t = *(const f32x4*)(kc + (size_t)j * 1024 + 4 * d); kr[4 * d] = t[0]; kr[4 * d + 1] = t[1]; kr[4 * d + 2] = t[2]; kr[4 * d + 3] = t[3]; }
        } else {
#pragma unroll
            for (int d = 0; d < 64; ++d) kr[d] = bf2f(QKV[(rb + (j - 512)) * NQKV + 1024 + h * 64 + d]);
        }
        for (int q = 0; q < 16; ++q) {
            float s = 0.f;
#pragma unroll
            for (int d = 0; d < 64; ++d) s += qs[q * 64 + d] * kr[d];
            const int rel = (j < 512) ? (512 + q - j) : (q - (j - 512));
            sc[q * 528 + j] = s * 0.125f + tab[min(max(rel, -128), 128) + 128];
        }
    }
    __syncthreads();
    for (int q = 2 * wid; q < 2 * wid + 2; ++q) {
        float mx = -1e30f;
        for (int j = lane; j < 528; j += 64) mx = fmaxf(mx, sc[q * 528 + j]);
#pragma unroll
        for (int o = 1; o < 64; o <<= 1) mx = fmaxf(mx, __shfl_xor(mx, o));
        float sm = 0.f;
        for (int j = lane; j < 528; j += 64) { const float p = __expf(sc[q * 528 + j] - mx); sc[q * 528 + j] = p; sm += p; }
        sm = wave_sum(sm);
        const float inv = 1.0f / sm;
        for (int j = lane; j < 528; j += 64) sc[q * 528 + j] *= inv;
    }
    __syncthreads();
    {
        const int q = tid >> 5, d = 2 * (tid & 31);
        float a0 = 0.f, a1 = 0.f;
        for (int j = 0; j < 512; ++j) { const f32x2 v = *(const f32x2*)(vc + (size_t)j * 1024 + d); const float p = sc[q * 528 + j]; a0 += p * v[0]; a1 += p * v[1]; }
        for (int j = 0; j < 16; ++j) { const bf16_t* vp = QKV + (rb + j) * NQKV + 2048 + h * 64 + d; const float p = sc[q * 528 + 512 + j]; a0 += p * bf2f(vp[0]); a1 += p * bf2f(vp[1]); }
        *(unsigned*)(MIX + (rb + q) * DM + h * 64 + d) = pk2(a0, a1);
    }
    __syncthreads();
}

#define XB_TMO      128
#define XB_XCNT(j)  (256  + 64 * (j))
#define XB_XSUB(j)  (1280 + 64 * (j))
#define XB_XGEN(j)  (2304 + 64 * (j))
#define XB_TOP      3328
#define XB_TOPGEN   3392
#define XCD_BAR_WORDS 3456
#define XB_SPIN_CAP (1u << 20)
__device__ __forceinline__ unsigned xb_ld(unsigned* p)              { return __hip_atomic_load(p, __ATOMIC_RELAXED, __HIP_MEMORY_SCOPE_AGENT); }
__device__ __forceinline__ unsigned xb_add(unsigned* p, unsigned v) { return __hip_atomic_fetch_add(p, v, __ATOMIC_RELAXED, __HIP_MEMORY_SCOPE_AGENT); }
__device__ __forceinline__ unsigned xb_xcc_id() { return (unsigned)__builtin_amdgcn_s_getreg((3 << 11) | 20) & 0xFu; }
#define XB_SPIN(cond, bar) do { unsigned _sp = 0; while (cond) { __builtin_amdgcn_s_sleep(1); \
    if ((++_sp & 255u) == 0u) { if (xb_ld(&(bar)[XB_TMO])) break; if (_sp > XB_SPIN_CAP) { atomicAdd(&(bar)[XB_TMO], 1u); break; } } } } while (0)
struct XcdBarrier { unsigned* bar; unsigned x; volatile LAS unsigned* st; };
__device__ __forceinline__ XcdBarrier xcd_barrier_post(unsigned* bar, volatile LAS unsigned* st) {
    XcdBarrier b; b.bar = bar; b.x = xb_xcc_id(); b.st = st;
    if (threadIdx.x == 0) (void)xb_add(&bar[XB_XCNT(b.x)], 1u);
    return b;
}
__device__ __forceinline__ void xcd_barrier_complete(unsigned* bar, unsigned x, unsigned& nloc, unsigned& nx) {
    const unsigned G = gridDim.x * gridDim.y * gridDim.z;
    unsigned sum, cnt, mine, sp = 0u;
    for (;;) {
        sum = 0u; cnt = 0u; mine = 0u;
#pragma unroll
        for (unsigned j = 0; j < 16; ++j) { const unsigned c = xb_ld(&bar[XB_XCNT(j)]); sum += c; cnt += (c > 0u) ? 1u : 0u; mine = (j == x) ? c : mine; }
        if (sum == G) break;
        __builtin_amdgcn_s_sleep(1);
        if ((++sp & 255u) == 0u) { if (xb_ld(&bar[XB_TMO])) break; if (sp > XB_SPIN_CAP) { atomicAdd(&bar[XB_TMO], 1u); break; } }
    }
    nloc = mine > 0u ? mine : 1u; nx = cnt > 0u ? cnt : 1u;
}
__device__ __forceinline__ void xcd_barrier(const XcdBarrier& b) {
    asm volatile("s_waitcnt vmcnt(0)" ::: "memory");
    __syncthreads();
    if (threadIdx.x == 0) {
        unsigned* bar = b.bar;
        __builtin_amdgcn_s_waitcnt(0);
        unsigned nloc = b.st[0], nx = b.st[1];
        if (nloc == 0u) { xcd_barrier_complete(bar, b.x, nloc, nx); b.st[0] = nloc; b.st[1] = nx; }
        const unsigned old = xb_add(&bar[XB_XSUB(b.x)], 1u);
        const unsigned gen = old / nloc;
        if (old + 1u == (gen + 1u) * nloc) {
            __builtin_amdgcn_fence(__ATOMIC_RELEASE, "agent");
            asm volatile("s_waitcnt vmcnt(0)" ::: "memory");
            const unsigned og = xb_add(&bar[XB_TOP], 1u);
            const unsigned tg = og / nx;
            if (og + 1u == (tg + 1u) * nx) xb_add(&bar[XB_TOPGEN], 1u);
            else XB_SPIN(xb_ld(&bar[XB_TOPGEN]) == tg, bar);
            __builtin_amdgcn_fence(__ATOMIC_ACQUIRE, "agent");
            xb_add(&bar[XB_XGEN(b.x)], 1u);
            asm volatile("s_waitcnt vmcnt(0)" ::: "memory");
        } else {
            XB_SPIN(xb_ld(&bar[XB_XGEN(b.x)]) == gen, bar);
            __builtin_amdgcn_fence(__ATOMIC_ACQUIRE, "agent");
            asm volatile("s_waitcnt vmcnt(0)" ::: "memory");
        }
    }
    __syncthreads();
}

__global__ void __launch_bounds__(512, 2) hybrid_fwd(Params P) {
    extern __shared__ __attribute__((aligned(16))) unsigned char lds_raw[];
    LAS unsigned char* lds = (LAS unsigned char*)lds_raw;
    const int G = gridDim.x;
    volatile LAS unsigned* xst = (volatile LAS unsigned*)(lds + 131072 + 256);
    if (threadIdx.x < 2) xst[threadIdx.x] = 0u;
    __syncthreads();
    XcdBarrier xbar = xcd_barrier_post((unsigned*)(P.ws + WS_CTL), xst);
    int ph = P.ph_lo, rep = 0;
    while (ph < P.ph_hi) {
        int tid = threadIdx.x; asm volatile("" : "+v"(tid));
        int wg = blockIdx.x; asm volatile("" : "+s"(wg));
        const Params& Q = P;
        const int lane = tid & 63, wid = __builtin_amdgcn_readfirstlane(tid >> 6), gw = wg * 8 + wid, ngw = G * 8;
        unsigned char* ws = Q.ws;
        bf16_t* Xb = (bf16_t*)(ws + WS_XB); bf16_t* R1 = (bf16_t*)(ws + WS_R1); bf16_t* MIX = (bf16_t*)(ws + WS_MIX);
        float* GATES = (float*)(ws + WS_GATES); float* SSP = (float*)(ws + WS_SSP);
        int nrep = 1;
        if (ph == 0) nrep = REP_PRO; else if (ph != NPHASE - 1) { const int q_ = (ph - 1) % 11; if (q_ == 1) nrep = REP_MIX; else if (q_ == 7) nrep = REP_ATT; else if (q_ == 0 || q_ == 4 || q_ == 6 || q_ == 9) nrep = REP_PROJ; }
        if (ph == 0) phase_prologue(Q, lds, gw, ngw, wid, lane);
        else if (ph == NPHASE - 1) phase_final(Q, gw, ngw, lane);
        else {
            int layer, sub;
            { const int r_ = ph - 1, pair_ = r_ / 11, q_ = r_ % 11; if (q_ < 6) { layer = 2 * pair_; sub = (q_ < 2) ? q_ : (q_ == 2 ? 5 : q_ - 1); } else { layer = 2 * pair_ + 1; sub = q_ - 6; } }
            const int li = layer >> 1, odd = layer & 1;
            if (sub == 5) phase_fixup(Q, li, gw, ngw, lane);
            else if (sub == 1) {
                if (!odd) {
                    if (G == 256) {
                        if (wg < 128) delta_unit(Q, lds, li, false, wg >> 4, (wg >> 1) & 7, wg & 1, tid);
                        else if (wg < 192) { const int u = wg - 128; gla_unit(Q, lds, li, false, u >> 3, u & 7, tid); }
                        else { const int u = wg - 192; delta_unit(Q, lds, li, true, u >> 3, u & 7, 0, tid); delta_unit(Q, lds, li, true, u >> 3, u & 7, 1, tid); gla_unit(Q, lds, li, true, u >> 3, u & 7, tid);
                            if (layer == 0 && rep == 0) convert_mats(Q, lds, 1, 16, (wg - 192) * 8 + wid, 512, wid, lane); }
                    }
                } else {
                    attn_build_bias(Q, lds, li, (wg >> 1) & 15, tid);
                    for (int u = wg * 8; u < wg * 8 + 8; ++u) attn_prompt_unit(Q, lds, li, u >> 8, (u >> 4) & 15, u & 15, tid);
                    if (wg < 128) attn_sample_unit(Q, lds, li, wg >> 4, wg & 15, tid);
                }
            } else {
                pg8::Gemm g; int mode, Npos;
                g.M = TP;
                LAS unsigned long long* eap = (LAS unsigned long long*)(lds + EA_OFF);
#define EA_SET(i, p) eap[i] = (unsigned long long)(p)
                if (sub == 0) {
                    g.A = Xb; g.K = 1024;
                    if (!odd) { mode = 0; Npos = ABPAD; g.Bt = (const bf16_t*)(ws + WS_WIN + li * SZ_WIN);
                        if (tid == 0) { EA_SET(0, R1); EA_SET(1, SSP); EA_SET(2, GATES); EA_SET(3, Q.out + O_CONVP + (size_t)li * 8 * 3 * DNQKV); EA_SET(4, Q.out + O_CONVS + (size_t)li * 8 * 3 * DNQKV); } }
                    else { mode = 1; Npos = NQKV; g.Bt = (const bf16_t*)(ws + WS_WQKV + li * SZ_WQKV);
                        if (tid == 0) { EA_SET(0, R1); EA_SET(1, SSP); EA_SET(3, Q.out + O_CKP + (size_t)li * 8 * 512 * 1024); EA_SET(4, Q.out + O_CVP + (size_t)li * 8 * 512 * 1024); EA_SET(5, Q.out + O_CKS + (size_t)li * 8 * 16 * 1024); EA_SET(6, Q.out + O_CVS + (size_t)li * 8 * 16 * 1024); } }
                } else if (sub == 2) {
                    mode = 2; Npos = 1024; g.A = MIX; g.K = 1024; g.Bt = (const bf16_t*)(ws + (odd ? WS_WCOUT : WS_WOUT) + li * SZ_W1K);
                    if (tid == 0) { EA_SET(7, (layer == 0) ? Q.in[0] : Q.out); EA_SET(8, (layer == 0) ? Q.in[1] : Q.out + (size_t)TP * DM); EA_SET(9, Q.out); EA_SET(10, Xb); EA_SET(11, SSP); }
                } else if (sub == 3) {
                    mode = 3; Npos = NGU; g.A = Xb; g.K = 1024; g.Bt = (const bf16_t*)(ws + WS_WGU + layer * SZ_WGU);
                    if (tid == 0) { EA_SET(0, R1); EA_SET(1, SSP); }
                } else {
                    mode = 2; Npos = 1024; g.A = R1; g.K = DFF; g.Bt = (const bf16_t*)(ws + WS_WDN + layer * SZ_WDN);
                    if (tid == 0) { EA_SET(7, Q.out); EA_SET(8, Q.out + (size_t)TP * DM); EA_SET(9, Q.out); EA_SET(10, Xb); EA_SET(11, SSP); }
                }
#undef EA_SET
                g.N = Npos;
                __syncthreads();
                pg8::StaticOrder S; S.init(TP, Npos, G, wg);
                if (mode == 0) { small_gemm<0>(g.A, g.Bt, Npos, g.K, eap, lds, wg, G, wid, lane); Epi<0> E{eap}; pg8::gemm_phase<Epi<0>, true, true>(lds, g, S, E, tid); }
                else if (mode == 1) { small_gemm<1>(g.A, g.Bt, Npos, g.K, eap, lds, wg, G, wid, lane); Epi<1> E{eap}; pg8::gemm_phase<Epi<1>, true, true>(lds, g, S, E, tid); }
                else if (mode == 2) { small_gemm<2>(g.A, g.Bt, Npos, g.K, eap, lds, wg, G, wid, lane); Epi<2> E{eap}; pg8::gemm_phase<Epi<2>, true, true>(lds, g, S, E, tid); }
                else { small_gemm<3>(g.A, g.Bt, Npos, g.K, eap, lds, wg, G, wid, lane); Epi<3> E{eap}; pg8::gemm_phase<Epi<3>, true, true>(lds, g, S, E, tid); }
            }
        }
        if (++rep >= nrep) { rep = 0; ++ph; }
        if (ph < P.ph_hi) { if (ph == 1 && rep == 0) cg::this_grid().sync(); else xcd_barrier(xbar); }
    }
}

extern "C" void kernel_launch(void* const* d_in, const int* in_sizes, int n_in, void* d_out, int out_size, void* d_ws, size_t ws_size, hipStream_t stream) {
    static int grid = 0;
    if (grid == 0) {
        if (n_in != 25 || (size_t)out_size != O_END || ws_size < WS_END) { fprintf(stderr, "kernel_launch: unexpected sizes n_in %d out %d ws %zu (need %zu)\n", n_in, out_size, ws_size, (size_t)WS_END); grid = -1; return; }
        if (hipFuncSetAttribute((const void*)hybrid_fwd, hipFuncAttributeMaxDynamicSharedMemorySize, LDS_BYTES) != hipSuccess) { fprintf(stderr, "kernel_launch: hipFuncSetAttribute failed\n"); grid = -1; return; }
        int dev = 0, cus = 0, per_cu = 0;
        hipGetDevice(&dev); hipDeviceGetAttribute(&cus, hipDeviceAttributeMultiprocessorCount, dev);
        hipOccupancyMaxActiveBlocksPerMultiprocessor(&per_cu, (const void*)hybrid_fwd, 512, LDS_BYTES);
        (void)hipGetLastError();
        if (cus != 256 || per_cu < 1) fprintf(stderr, "kernel_launch: note: cus %d per_cu %d\n", cus, per_cu);
        grid = 256;
    }
    if (grid < 0) return;
    Params p{};
    for (int i = 0; i < 25; ++i) p.in[i] = (const float*)d_in[i];
    p.out = (float*)d_out; p.ws = (unsigned char*)d_ws;
#if MK_MULTI
    for (int ph = 0; ph < NPHASE; ++ph) { p.ph_lo = ph; p.ph_hi = ph + 1; hipLaunchKernelGGL(hybrid_fwd, dim3(grid), dim3(512), LDS_BYTES, stream, p); }
#else
    (void)hipMemsetAsync((char*)d_ws + WS_CTL, 0, CTL_BYTES, stream);
    p.ph_lo = 0; p.ph_hi = NPHASE;
    void* args[] = {&p};
    hipError_t e = hipLaunchCooperativeKernel((const void*)hybrid_fwd, dim3(grid), dim3(512), args, LDS_BYTES, stream);
    if (e != hipSuccess) fprintf(stderr, "cooperative launch failed: %s\n", hipGetErrorString(e));
#endif
}
```

```cpp
#include <hip/hip_runtime.h>
#include <hip/hip_cooperative_groups.h>
#include <cstdio>
#include <cstdint>
namespace cg = cooperative_groups;

#ifndef MK_MULTI
#define MK_MULTI 0
#endif

#ifndef REP_MIX
#define REP_MIX 1
#endif
#ifndef REP_ATT
#define REP_ATT 1
#endif
#ifndef REP_PRO
#define REP_PRO 1
#endif
#ifndef REP_PROJ
#define REP_PROJ 1
#endif
#define LAS __attribute__((address_space(3)))
#define GAS __attribute__((address_space(1)))
typedef unsigned short bf16_t;
typedef short bf16x8 __attribute__((ext_vector_type(8)));
typedef float f32x2 __attribute__((ext_vector_type(2)));
typedef float f32x4 __attribute__((ext_vector_type(4)));
typedef float f32x16 __attribute__((ext_vector_type(16)));
typedef unsigned u32x2 __attribute__((ext_vector_type(2)));
typedef unsigned u32x4 __attribute__((ext_vector_type(4)));

constexpr int DM = 1024, NB = 8, SEQ = 4096, SB = 8, SSEQ = 16, PAST = 2048;
constexpr int TP = NB * SEQ;
constexpr int TS = SB * SSEQ;
constexpr int TR = TP + TS;
constexpr int ABIN = 3616, ABPAD = 3840, DFF = 2816, NGU = 5632, NQKV = 3072, DNQKV = 1536;
constexpr float EPS = 1e-6f;
constexpr float LOG2E = 1.4426950408889634f;

constexpr size_t O_Y = 0;
constexpr size_t O_CONVP = (size_t)TR * DM;
constexpr size_t O_CONVS = O_CONVP + 2 * 8 * 3 * 1536;
constexpr size_t O_DNP = O_CONVS + 2 * 8 * 3 * 1536;
constexpr size_t O_DNS = O_DNP + 2 * 8 * 8 * 64 * 64;
constexpr size_t O_GLAP = O_DNS + 2 * 8 * 8 * 64 * 64;
constexpr size_t O_GLAS = O_GLAP + 2 * 8 * 8 * 32 * 64;
constexpr size_t O_CKP = O_GLAS + 2 * 8 * 8 * 32 * 64;
constexpr size_t O_CKS = O_CKP + (size_t)2 * 8 * 512 * 1024;
constexpr size_t O_CVP = O_CKS + 2 * 8 * 16 * 1024;
constexpr size_t O_CVS = O_CVP + (size_t)2 * 8 * 512 * 1024;
constexpr size_t O_END = O_CVS + 2 * 8 * 16 * 1024;

constexpr size_t SZ_WIN = (size_t)ABPAD * 1024 * 2, SZ_W1K = (size_t)1024 * 1024 * 2, SZ_WQKV = (size_t)NQKV * 1024 * 2, SZ_WGU = (size_t)NGU * 1024 * 2, SZ_WDN = (size_t)1024 * DFF * 2;
constexpr size_t WS_WIN = 0;
constexpr size_t WS_WOUT = WS_WIN + 2 * SZ_WIN;
constexpr size_t WS_WQKV = WS_WOUT + 2 * SZ_W1K;
constexpr size_t WS_WCOUT = WS_WQKV + 2 * SZ_WQKV;
constexpr size_t WS_WGU = WS_WCOUT + 2 * SZ_W1K;
constexpr size_t WS_WDN = WS_WGU + 4 * SZ_WGU;
constexpr size_t WS_XB = WS_WDN + 4 * SZ_WDN;
constexpr size_t WS_R1 = WS_XB + (size_t)TR * 1024 * 2;
constexpr size_t WS_MIX = WS_R1 + (size_t)TR * ABIN * 2;
constexpr size_t WS_GATES = WS_MIX + (size_t)TR * 1024 * 2;
constexpr size_t WS_SSP = WS_GATES + (size_t)TR * 32 * 4;
constexpr size_t WS_CTL = WS_SSP + (size_t)TR * 16 * 4;
constexpr size_t CTL_BYTES = 16384;
constexpr size_t WS_END = WS_CTL + CTL_BYTES;

constexpr int LDS_BYTES = 147456;
constexpr int NPHASE = 24;

struct Params { const float* in[25]; float* out; unsigned char* ws; int ph_lo, ph_hi; };

__device__ __forceinline__ unsigned f2bf(float f) { unsigned u = __builtin_bit_cast(unsigned, f); return (u + 0x7fffu + ((u >> 16) & 1u)) >> 16; }
typedef __bf16 hwbf16x2 __attribute__((ext_vector_type(2)));
__device__ __forceinline__ unsigned pk2(float lo, float hi) { const f32x2 v = {lo, hi}; return __builtin_bit_cast(unsigned, __builtin_convertvector(v, hwbf16x2)); }
__device__ __forceinline__ float bf2f(bf16_t b) { return __builtin_bit_cast(float, ((unsigned)b) << 16); }
template <int CTRL> __device__ __forceinline__ float dppf(float v) { return __builtin_bit_cast(float, __builtin_amdgcn_update_dpp(0, __builtin_bit_cast(int, v), CTRL, 0xF, 0xF, true)); }
__device__ __forceinline__ float quad_sum(float v) { v += dppf<0xB1>(v); v += dppf<0x4E>(v); return v; }
__device__ __forceinline__ float oct_sum(float v) { v = quad_sum(v); v += dppf<0x141>(v); return v; }
__device__ __forceinline__ float wave_sum(float v) {
    v = oct_sum(v); v += dppf<0x140>(v);
    const int i = __builtin_bit_cast(int, v);
    return (__builtin_bit_cast(float, __builtin_amdgcn_readlane(i, 0)) + __builtin_bit_cast(float, __builtin_amdgcn_readlane(i, 16))) +
           (__builtin_bit_cast(float, __builtin_amdgcn_readlane(i, 32)) + __builtin_bit_cast(float, __builtin_amdgcn_readlane(i, 48)));
}
__device__ __forceinline__ float fast_rcp(float x) { return __builtin_amdgcn_rcpf(x); }
__device__ __forceinline__ float silu_f(float x) { return x * fast_rcp(1.0f + __expf(-x)); }
__device__ __forceinline__ float sigmoid_f(float x) { return fast_rcp(1.0f + __expf(-x)); }
__device__ __forceinline__ float softplus_f(float x) { return fmaxf(x, 0.f) + __logf(1.0f + __expf(-fabsf(x))); }

namespace pg8 {
constexpr int BM = 256, BK = 64, HALF = 128, HTB = HALF * BK * 2, STAGE_BYTES = 8 * HTB, NXCD = 8, WGM = 8;
__host__ __device__ __forceinline__ int lds_byte(int r, int c) { const int st = (r >> 4) * 2 + (c >> 5), rr = r & 15, cc = c & 31, ob = rr * 64 + cc * 2; return st * 1024 + (ob ^ (((ob >> 9) & 1) << 5)); }
__host__ __device__ __forceinline__ void stage_rc(int b, int& R, int& C) { const int st = b / 1024, sb = b % 1024, swz = sb ^ (((sb >> 9) & 1) << 5); R = (st >> 1) * 16 + swz / 64; C = (st & 1) * 32 + (swz % 64) / 2; }
__host__ __device__ __forceinline__ int perm32(int rho) { const int n = rho >> 4, i = rho & 15; return 8 * (i >> 2) + 4 * n + (i & 3); }
struct Unit { int pm, pn; };
struct Gemm { const bf16_t* A; const bf16_t* Bt; int M, N, K; };
struct StaticOrder {
    int nM, nN, nwg, G, c;
    __host__ __device__ void init(int M, int N, int G_, int c_) { nM = M / BM; nN = N / BM; nwg = nM * nN; G = G_; c = c_; }
    __host__ __device__ bool next(int i, Unit& u) const {
        const long L = (long)i * G + c; if (L >= nwg) return false;
        int wgid = (int)L; { const int q = nwg / NXCD, r = nwg % NXCD, xcd = wgid % NXCD, off = wgid / NXCD; wgid = (xcd < r ? xcd * (q + 1) : r * (q + 1) + (xcd - r) * q) + off; }
        const int nig = WGM * nN, gid = wgid / nig, fm = gid * WGM, gsz = (nM - fm) < WGM ? (nM - fm) : WGM;
        u.pm = fm + ((wgid % nig) % gsz); u.pn = (wgid % nig) / gsz; return true;
    }
};

template <class Epi, bool ALIGN_EPI, bool SP2>
__device__ __forceinline__ void gemm_phase(LAS unsigned char* lds, const Gemm g, const StaticOrder& S, const Epi& E, const int tid) {
    const int wid = __builtin_amdgcn_readfirstlane(tid >> 6), lane = tid & 63, wr = wid >> 2, wc = wid & 3, fr = lane & 15, fq = lane >> 4;
    const int K = g.K, nt = K / BK;
    unsigned voffA[2], voffB[2];
#pragma unroll
    for (int i = 0; i < 2; ++i) { int R, C; stage_rc(tid * 16 + i * 8192, R, C); voffA[i] = (unsigned)(R * K + C) * 2u; voffB[i] = (unsigned)(R * K + C) * 2u; }
    const size_t kstep = (size_t)(BK * 2);
    const size_t hstep = (size_t)HALF * K * 2;
    const size_t tstep = 2 * hstep;
    const unsigned ldsw = (unsigned)wid * 1024u;
    const int aoff = lds_byte(wr * 64 + fr, fq * 8), boff = lds_byte(wc * 32 + fr, fq * 8);
#define PG8_SA(b, h) (((b) * 2 + (h)) * HTB)
#define PG8_SB(b, h) ((4 + (b) * 2 + (h)) * HTB)
#define PG8_STAGE(bufoff, gbase, voff) do { _Pragma("unroll") for (int _i = 0; _i < 2; ++_i) \
        __builtin_amdgcn_global_load_lds((const unsigned*)((const char*)(gbase) + (voff)[_i]), (LAS unsigned*)(lds + (bufoff) + ldsw + _i * 8192), 16, 0, 0); } while (0)
#define PG8_LDA(dst, b, h) do { _Pragma("unroll") for (int m = 0; m < 4; ++m) _Pragma("unroll") for (int k = 0; k < 2; ++k) dst[m][k] = *(const LAS bf16x8*)(lds + PG8_SA(b, h) + aoff + m * 2048 + k * 1024); } while (0)
#define PG8_LDB(dst, b, h) do { _Pragma("unroll") for (int n = 0; n < 2; ++n) _Pragma("unroll") for (int k = 0; k < 2; ++k) dst[n][k] = *(const LAS bf16x8*)(lds + PG8_SB(b, h) + boff + n * 2048 + k * 1024); } while (0)
#define PG8_MMA(ai, bj, At, Bt) do { __builtin_amdgcn_s_setprio(1); _Pragma("unroll") for (int m = 0; m < 4; ++m) _Pragma("unroll") for (int n = 0; n < 2; ++n) _Pragma("unroll") for (int k = 0; k < 2; ++k) \
        acc[ai][bj][m][n] = __builtin_amdgcn_mfma_f32_16x16x32_bf16(Bt[n][k], At[m][k], acc[ai][bj][m][n], 0, 0, 0); __builtin_amdgcn_s_setprio(0); } while (0)
#define PG8_WAIT_V(n) asm volatile("s_waitcnt vmcnt(" #n ")" ::: "memory")
#define PG8_WAIT_L(n) asm volatile("s_waitcnt lgkmcnt(" #n ")" ::: "memory")
#define PG8_BAR __builtin_amdgcn_s_barrier()
#define PG8_SCHED __builtin_amdgcn_sched_barrier(0)
    Unit cur, nxt; int ui = 0;
    if (!S.next(0, cur)) return;
    f32x4 acc[2][2][4][2];
#pragma unroll
    for (int a = 0; a < 2; ++a)
#pragma unroll
        for (int b = 0; b < 2; ++b)
#pragma unroll
            for (int m = 0; m < 4; ++m)
#pragma unroll
                for (int n = 0; n < 2; ++n) acc[a][b][m][n] = (f32x4){0.f, 0.f, 0.f, 0.f};
    bf16x8 At[4][2], B0[2][2], B1[2][2];
    const char* cA = (const char*)g.A + (size_t)cur.pm * tstep; const char* cB = (const char*)g.Bt + (size_t)cur.pn * tstep;
    if constexpr (SP2) {
        PG8_STAGE(PG8_SB(0, 0), cB, voffB); PG8_STAGE(PG8_SB(0, 1), cB + hstep, voffB); PG8_STAGE(PG8_SA(0, 0), cA, voffA); PG8_STAGE(PG8_SA(0, 1), cA + hstep, voffA);
        if (wr == 1) PG8_BAR;
        PG8_WAIT_V(2); PG8_BAR;
        PG8_STAGE(PG8_SB(1, 0), cB + kstep, voffB); PG8_STAGE(PG8_SA(1, 0), cA + kstep, voffA); PG8_STAGE(PG8_SB(1, 1), cB + hstep + kstep, voffB);
        PG8_WAIT_V(6); PG8_BAR;
    } else {
        PG8_STAGE(PG8_SB(0, 0), cB, voffB); PG8_STAGE(PG8_SA(0, 0), cA, voffA); PG8_STAGE(PG8_SB(0, 1), cB + hstep, voffB); PG8_STAGE(PG8_SA(0, 1), cA + hstep, voffA);
        if (wr == 1) PG8_BAR;
        PG8_WAIT_V(4); PG8_BAR;
        PG8_STAGE(PG8_SB(1, 0), cB + kstep, voffB); PG8_STAGE(PG8_SA(1, 0), cA + kstep, voffA); PG8_STAGE(PG8_SB(1, 1), cB + hstep + kstep, voffB);
        PG8_WAIT_V(6); PG8_BAR;
    }
    for (;;) {
        const bool has_next = S.next(ui + 1, nxt);
        const char* nA = has_next ? (const char*)g.A + (size_t)nxt.pm * tstep : cA; const char* nB = has_next ? (const char*)g.Bt + (size_t)nxt.pn * tstep : cB;
        for (int t = 0; t < nt; t += 2) {
            const bool last = (t == nt - 2);
            const char* a1 = cA + (size_t)(t + 1) * kstep;
            const char* a2 = last ? nA : cA + (size_t)(t + 2) * kstep; const char* b2 = last ? nB : cB + (size_t)(t + 2) * kstep;
            const char* a3 = a2 + kstep; const char* b3 = b2 + kstep;
            if constexpr (SP2) {
            PG8_LDB(B0, 0, 0); PG8_LDB(B1, 0, 1); PG8_SCHED; PG8_LDA(At, 0, 0); PG8_STAGE(PG8_SA(1, 1), a1 + hstep, voffA);
            PG8_WAIT_V(8); PG8_WAIT_L(0); PG8_BAR; PG8_MMA(0, 0, At, B0); PG8_MMA(0, 1, At, B1); PG8_BAR; PG8_SCHED;
            PG8_LDA(At, 0, 1); PG8_STAGE(PG8_SB(0, 0), b2, voffB); PG8_STAGE(PG8_SB(0, 1), b2 + hstep, voffB); PG8_STAGE(PG8_SA(0, 0), a2, voffA);
            PG8_WAIT_V(8); PG8_WAIT_L(0); PG8_BAR; PG8_MMA(1, 0, At, B0); PG8_MMA(1, 1, At, B1); PG8_BAR; PG8_SCHED;
            PG8_LDB(B0, 1, 0); PG8_LDB(B1, 1, 1); PG8_SCHED; PG8_LDA(At, 1, 0); PG8_STAGE(PG8_SA(0, 1), a2 + hstep, voffA);
            PG8_WAIT_V(8); PG8_WAIT_L(0); PG8_BAR; PG8_MMA(0, 0, At, B0); PG8_MMA(0, 1, At, B1); PG8_BAR; PG8_SCHED;
            PG8_LDA(At, 1, 1); PG8_STAGE(PG8_SB(1, 0), b3, voffB); PG8_STAGE(PG8_SB(1, 1), b3 + hstep, voffB); PG8_STAGE(PG8_SA(1, 0), a3, voffA);
            PG8_WAIT_V(8); PG8_WAIT_L(0); PG8_BAR; PG8_MMA(1, 0, At, B0); PG8_MMA(1, 1, At, B1); PG8_BAR; PG8_SCHED;
            } else {
            PG8_LDB(B0, 0, 0); PG8_SCHED; PG8_LDA(At, 0, 0); PG8_STAGE(PG8_SA(1, 1), a1 + hstep, voffA);
            PG8_WAIT_L(8); PG8_BAR; PG8_WAIT_L(0); PG8_MMA(0, 0, At, B0); PG8_BAR; PG8_SCHED;
            PG8_LDB(B1, 0, 1); PG8_STAGE(PG8_SB(0, 0), b2, voffB);
            PG8_BAR; PG8_WAIT_L(0); PG8_MMA(0, 1, At, B1); PG8_BAR;
            PG8_LDA(At, 0, 1); PG8_STAGE(PG8_SA(0, 0), a2, voffA);
            PG8_BAR; PG8_WAIT_L(0); PG8_MMA(1, 0, At, B0); PG8_BAR; PG8_SCHED;
            PG8_STAGE(PG8_SB(0, 1), b2 + hstep, voffB);
            PG8_WAIT_V(6); PG8_BAR; PG8_MMA(1, 1, At, B1); PG8_BAR;
            PG8_LDB(B0, 1, 0); PG8_SCHED; PG8_LDA(At, 1, 0); PG8_STAGE(PG8_SA(0, 1), a2 + hstep, voffA);
            PG8_WAIT_L(8); PG8_BAR; PG8_WAIT_L(0); PG8_MMA(0, 0, At, B0); PG8_BAR; PG8_SCHED;
            PG8_LDB(B1, 1, 1); PG8_STAGE(PG8_SB(1, 0), b3, voffB);
            PG8_BAR; PG8_WAIT_L(0); PG8_MMA(0, 1, At, B1); PG8_BAR;
            PG8_LDA(At, 1, 1); PG8_STAGE(PG8_SA(1, 0), a3, voffA);
            PG8_BAR; PG8_WAIT_L(0); PG8_MMA(1, 0, At, B0); PG8_BAR; PG8_SCHED;
            PG8_STAGE(PG8_SB(1, 1), b3 + hstep, voffB);
            PG8_WAIT_V(6); PG8_BAR; PG8_MMA(1, 1, At, B1); PG8_BAR;
            }
        }
        if constexpr (ALIGN_EPI) { if (wr == 0) PG8_BAR; }
        E(acc, cur, wr, wc, fr, fq);
        if (!has_next) break;
#pragma unroll
        for (int a = 0; a < 2; ++a)
#pragma unroll
            for (int b = 0; b < 2; ++b)
#pragma unroll
                for (int m = 0; m < 4; ++m)
#pragma unroll
                    for (int n = 0; n < 2; ++n) acc[a][b][m][n] = (f32x4){0.f, 0.f, 0.f, 0.f};
        cur = nxt; cA = nA; cB = nB; ++ui;
        if constexpr (ALIGN_EPI) { if (wr == 1) PG8_BAR; }
    }
    PG8_WAIT_V(0);
    if constexpr (!ALIGN_EPI) { if (wr == 0) PG8_BAR; }
    PG8_BAR;
#undef PG8_SA
#undef PG8_SB
#undef PG8_STAGE
#undef PG8_LDA
#undef PG8_LDB
#undef PG8_MMA
#undef PG8_WAIT_V
#undef PG8_WAIT_L
#undef PG8_BAR
#undef PG8_SCHED
}
}

struct EpiArgs {
    GAS bf16_t* out; const GAS float* ssp; GAS float* gates; GAS float* o0; GAS float* o1; GAS float* o2; GAS float* o3;
    const GAS float* base_p; const GAS float* base_s; GAS float* X; GAS bf16_t* Xb; GAS float* ssp_out;
};
__device__ __forceinline__ float row_rstd(const GAS float* ssp, int row) {
    const GAS f32x4* p = (const GAS f32x4*)(ssp + (size_t)row * 16);
    const f32x4 a = p[0], b = p[1], c = p[2], d = p[3];
    const float s = ((a[0] + a[1]) + (a[2] + a[3])) + ((b[0] + b[1]) + (b[2] + b[3])) + ((c[0] + c[1]) + (c[2] + c[3])) + ((d[0] + d[1]) + (d[2] + d[3]));
    return rsqrtf(s * (1.0f / 1024.0f) + EPS);
}
template <int MODE, bool SMALL>
__device__ __forceinline__ float epi_apply(const EpiArgs& a, int row, int g32, int fq, f32x4 v0, f32x4 v1, float rstd) {
    const int c0 = 32 * g32 + 8 * fq;
    if constexpr (MODE == 0) {
        if (g32 >= ABIN / 32) return 0.f;
        v0 *= rstd; v1 *= rstd;
        u32x4 w; w.x = pk2(v0[0], v0[1]); w.y = pk2(v0[2], v0[3]); w.z = pk2(v1[0], v1[1]); w.w = pk2(v1[2], v1[3]);
        *(GAS u32x4*)(a.out + (size_t)row * ABIN + c0) = w;
        if (g32 == 48 && fq < 2) { GAS float* gp = a.gates + (size_t)row * 32 + 8 * fq; *(GAS f32x4*)gp = v0; *(GAS f32x4*)(gp + 4) = v1; }
        if (g32 == 96 && fq >= 2) { GAS float* gp = a.gates + (size_t)row * 32 + 16 + 8 * (fq - 2); *(GAS f32x4*)gp = v0; *(GAS f32x4*)(gp + 4) = v1; }
        if (c0 < DNQKV) {
            if constexpr (!SMALL) { const int t = row & (SEQ - 1), b = row >> 12; if (t >= SEQ - 3) { GAS float* d = a.o0 + (size_t)(b * 3 + (t - (SEQ - 3))) * DNQKV + c0; *(GAS f32x4*)d = v0; *(GAS f32x4*)(d + 4) = v1; } }
            else { const int r = row - TP, t = r & 15, b = r >> 4; if (t >= SSEQ - 3) { GAS float* d = a.o1 + (size_t)(b * 3 + (t - (SSEQ - 3))) * DNQKV + c0; *(GAS f32x4*)d = v0; *(GAS f32x4*)(d + 4) = v1; } }
        }
        return 0.f;
    } else if constexpr (MODE == 1) {
        v0 *= rstd; v1 *= rstd;
        u32x4 w; w.x = pk2(v0[0], v0[1]); w.y = pk2(v0[2], v0[3]); w.z = pk2(v1[0], v1[1]); w.w = pk2(v1[2], v1[3]);
        *(GAS u32x4*)(a.out + (size_t)row * NQKV + c0) = w;
        if (c0 >= 1024) {
            const int isv = c0 >= 2048, cc = c0 - 1024 - 1024 * isv;
            if constexpr (!SMALL) { const int t = row & (SEQ - 1), b = row >> 12; if (t >= SEQ - 512) { GAS float* d = a.o0 + (size_t)isv * (O_CVP - O_CKP) + (size_t)(b * 512 + (t - (SEQ - 512))) * 1024 + cc; __builtin_nontemporal_store(v0, (GAS f32x4*)d); __builtin_nontemporal_store(v1, (GAS f32x4*)(d + 4)); } }
            else { const int r = row - TP; GAS float* d = a.o2 + (size_t)isv * (O_CVS - O_CKS) + (size_t)r * 1024 + cc; *(GAS f32x4*)d = v0; *(GAS f32x4*)(d + 4) = v1; }
        }
        return 0.f;
    } else if constexpr (MODE == 2) {
        GAS u32x4* xp = (GAS u32x4*)(a.Xb + (size_t)row * DM + c0);
        const u32x4 bw = *xp;
        f32x4 x0, x1;
        x0[0] = __builtin_bit_cast(float, bw[0] << 16) + v0[0]; x0[1] = __builtin_bit_cast(float, bw[0] & 0xffff0000u) + v0[1]; x0[2] = __builtin_bit_cast(float, bw[1] << 16) + v0[2]; x0[3] = __builtin_bit_cast(float, bw[1] & 0xffff0000u) + v0[3];
        x1[0] = __builtin_bit_cast(float, bw[2] << 16) + v1[0]; x1[1] = __builtin_bit_cast(float, bw[2] & 0xffff0000u) + v1[1]; x1[2] = __builtin_bit_cast(float, bw[3] << 16) + v1[2]; x1[3] = __builtin_bit_cast(float, bw[3] & 0xffff0000u) + v1[3];
        u32x4 w; w.x = pk2(x0[0], x0[1]); w.y = pk2(x0[2], x0[3]); w.z = pk2(x1[0], x1[1]); w.w = pk2(x1[2], x1[3]);
        *xp = w;
        return ((x0[0] * x0[0] + x0[1] * x0[1]) + (x0[2] * x0[2] + x0[3] * x0[3])) + ((x1[0] * x1[0] + x1[1] * x1[1]) + (x1[2] * x1[2] + x1[3] * x1[3]));
    } else {
        v0 *= rstd; v1 *= rstd;
        float h[4];
#pragma unroll
        for (int j = 0; j < 4; ++j) h[j] = silu_f(v0[j]) * v1[j];
        u32x2 w; w.x = pk2(h[0], h[1]); w.y = pk2(h[2], h[3]);
        *(GAS u32x2*)(a.out + (size_t)row * DFF + 16 * g32 + 4 * fq) = w;
        return 0.f;
    }
}
constexpr int EA_OFF = 131072 + 512;
__device__ __forceinline__ EpiArgs load_ea(const LAS unsigned long long* ap) {
    EpiArgs a;
    a.out = (GAS bf16_t*)ap[0]; a.ssp = (const GAS float*)ap[1]; a.gates = (GAS float*)ap[2]; a.o0 = (GAS float*)ap[3]; a.o1 = (GAS float*)ap[4]; a.o2 = (GAS float*)ap[5]; a.o3 = (GAS float*)ap[6];
    a.base_p = (const GAS float*)ap[7]; a.base_s = (const GAS float*)ap[8]; a.X = (GAS float*)ap[9]; a.Xb = (GAS bf16_t*)ap[10]; a.ssp_out = (GAS float*)ap[11];
    return a;
}
template <int MODE> struct Epi {
    const LAS unsigned long long* ap;
    __device__ __forceinline__ void operator()(const f32x4 (&acc)[2][2][4][2], const pg8::Unit& u, int wr, int wc, int fr, int fq) const {
        const EpiArgs a = load_ea(ap);
        if constexpr (MODE != 2) {
            f32x4 pq[2][4]; float rs[2][4];
#pragma unroll
            for (int ai = 0; ai < 2; ++ai)
#pragma unroll
                for (int m = 0; m < 4; ++m) { const int row = u.pm * 256 + ai * 128 + wr * 64 + m * 16 + fr; pq[ai][m] = *(const GAS f32x4*)(a.ssp + (size_t)row * 16 + 4 * fq); }
#pragma unroll
            for (int ai = 0; ai < 2; ++ai)
#pragma unroll
                for (int m = 0; m < 4; ++m) { float sp = (pq[ai][m][0] + pq[ai][m][1]) + (pq[ai][m][2] + pq[ai][m][3]); sp += __shfl_xor(sp, 16); sp += __shfl_xor(sp, 32); rs[ai][m] = rsqrtf(sp * (1.0f / 1024.0f) + EPS); }
#pragma unroll
            for (int ai = 0; ai < 2; ++ai)
#pragma unroll
                for (int m = 0; m < 4; ++m) {
                    const int row = u.pm * 256 + ai * 128 + wr * 64 + m * 16 + fr;
#pragma unroll
                    for (int bj = 0; bj < 2; ++bj) { const int g32 = (u.pn * 256 + bj * 128 + wc * 32) >> 5; (void)epi_apply<MODE, false>(a, row, g32, fq, acc[ai][bj][m][0], acc[ai][bj][m][1], rs[ai][m]); }
                }
        } else {
#pragma unroll
            for (int ai = 0; ai < 2; ++ai) {
                u32x4 bs[4][2];
#pragma unroll
                for (int m = 0; m < 4; ++m)
#pragma unroll
                    for (int bj = 0; bj < 2; ++bj) { const int row = u.pm * 256 + ai * 128 + wr * 64 + m * 16 + fr, c0 = u.pn * 256 + bj * 128 + wc * 32 + 8 * fq;
                        bs[m][bj] = *(const GAS u32x4*)(a.Xb + (size_t)row * DM + c0); }
#pragma unroll
                for (int m = 0; m < 4; ++m) {
                    const int row = u.pm * 256 + ai * 128 + wr * 64 + m * 16 + fr; float ss = 0.f;
#pragma unroll
                    for (int bj = 0; bj < 2; ++bj) { const int c0 = u.pn * 256 + bj * 128 + wc * 32 + 8 * fq; const u32x4 bw = bs[m][bj];
                        f32x4 x0, x1;
                        x0[0] = __builtin_bit_cast(float, bw[0] << 16); x0[1] = __builtin_bit_cast(float, bw[0] & 0xffff0000u); x0[2] = __builtin_bit_cast(float, bw[1] << 16); x0[3] = __builtin_bit_cast(float, bw[1] & 0xffff0000u);
                        x1[0] = __builtin_bit_cast(float, bw[2] << 16); x1[1] = __builtin_bit_cast(float, bw[2] & 0xffff0000u); x1[2] = __builtin_bit_cast(float, bw[3] << 16); x1[3] = __builtin_bit_cast(float, bw[3] & 0xffff0000u);
                        x0 += acc[ai][bj][m][0]; x1 += acc[ai][bj][m][1];
                        u32x4 w; w.x = pk2(x0[0], x0[1]); w.y = pk2(x0[2], x0[3]); w.z = pk2(x1[0], x1[1]); w.w = pk2(x1[2], x1[3]);
                        *(GAS u32x4*)(a.Xb + (size_t)row * DM + c0) = w;
                        ss += ((x0[0] * x0[0] + x0[1] * x0[1]) + (x0[2] * x0[2] + x0[3] * x0[3])) + ((x1[0] * x1[0] + x1[1] * x1[1]) + (x1[2] * x1[2] + x1[3] * x1[3])); }
                    ss += __shfl_xor(ss, 16); ss += __shfl_xor(ss, 32); if (fq == 0) a.ssp_out[(size_t)row * 16 + u.pn * 4 + wc] = ss;
                }
            }
        }
    }
};

template <int MODE>
__device__ __forceinline__ void small_gemm(const bf16_t* A, const bf16_t* Bt, int Npos, int K, const LAS unsigned long long* eap, LAS unsigned char* lds, int wg, int G, int wid, int lane) {
    const int fr = lane & 15, fq = lane >> 4, ncg = (MODE == 0 ? (ABIN + 63) / 64 : Npos / 64), nunits = (TS / 16) * ncg, KW = K / 8;
    LAS f32x4* part = (LAS f32x4*)lds;
    for (int u = wg; u < nunits; u += G) {
        const int rb = u % (TS / 16), cgp = u / (TS / 16), r0 = TP + rb * 16, p0 = cgp * 64;
        f32x4 acc[4];
#pragma unroll
        for (int f = 0; f < 4; ++f) acc[f] = (f32x4){0.f, 0.f, 0.f, 0.f};
        const bf16_t* ap = A + (size_t)(r0 + fr) * K + wid * KW + 8 * fq;
        const bf16_t* bp = Bt + (size_t)(p0 + fr) * K + wid * KW + 8 * fq;
        for (int k0 = 0; k0 < KW; k0 += 32) {
            const bf16x8 av = *(const bf16x8*)(ap + k0);
            bf16x8 wv[4];
#pragma unroll
            for (int f = 0; f < 4; ++f) wv[f] = *(const bf16x8*)(bp + (size_t)(16 * f) * K + k0);
#pragma unroll
            for (int f = 0; f < 4; ++f) acc[f] = __builtin_amdgcn_mfma_f32_16x16x32_bf16(wv[f], av, acc[f], 0, 0, 0);
        }
#pragma unroll
        for (int f = 0; f < 4; ++f) part[(wid * 4 + f) * 64 + lane] = acc[f];
        __syncthreads();
        if (wid == 0) {
#pragma unroll
            for (int w = 1; w < 8; ++w)
#pragma unroll
                for (int f = 0; f < 4; ++f) acc[f] += part[(w * 4 + f) * 64 + lane];
            const int row = r0 + fr;
            const EpiArgs a = load_ea(eap);
            float rstd = 1.f; if constexpr (MODE != 2) rstd = row_rstd(a.ssp, row);
            float ss = 0.f;
#pragma unroll
            for (int gq = 0; gq < 2; ++gq) ss += epi_apply<MODE, true>(a, row, (p0 >> 5) + gq, fq, acc[2 * gq], acc[2 * gq + 1], rstd);
            if constexpr (MODE == 2) { ss += __shfl_xor(ss, 16); ss += __shfl_xor(ss, 32); if (fq == 0) a.ssp_out[(size_t)row * 16 + cgp] = ss; }
        }
        __syncthreads();
    }
}

__device__ __forceinline__ void transpose_item(const float* W, int K, int Nsrc, int gu, const float* gamma, bf16_t* WT, LAS float* scr, int item, int npb, int lane) {
    const int kb = item / npb, nb = item % npb, k0 = 64 * kb, p0 = 32 * nb;
    const int cl = p0 + pg8::perm32(lane & 31);
    int src = cl; if (gu) src = ((cl >> 2) & 1) * DFF + 4 * (cl >> 3) + (cl & 3);
    const bool valid = src < Nsrc;
    const int srcc = valid ? src : 0; const float vmask = valid ? 1.f : 0.f;
    float wv[32];
#pragma unroll
    for (int i = 0; i < 32; ++i) wv[i] = W[(size_t)(k0 + 2 * i + (lane >> 5)) * Nsrc + srcc];
    if (gamma) {
#pragma unroll
        for (int i = 0; i < 32; ++i) wv[i] *= gamma[k0 + 2 * i + (lane >> 5)];
    }
#pragma unroll
    for (int i = 0; i < 32; ++i) scr[(2 * i + (lane >> 5)) * 33 + (lane & 31)] = wv[i] * vmask;
    asm volatile("s_waitcnt lgkmcnt(0)" ::: "memory");
    const int c = lane & 7;
#pragma unroll
    for (int j = 0; j < 4; ++j) { const int n = (lane >> 3) + 8 * j; const LAS float* s = scr + (8 * c) * 33 + n;
        u32x4 o; o.x = pk2(s[0 * 33], s[1 * 33]); o.y = pk2(s[2 * 33], s[3 * 33]); o.z = pk2(s[4 * 33], s[5 * 33]); o.w = pk2(s[6 * 33], s[7 * 33]);
        *(u32x4*)(WT + (size_t)(p0 + n) * K + k0 + 8 * c) = o; }
    asm volatile("s_waitcnt lgkmcnt(0)" ::: "memory");
}
__device__ __forceinline__ void convert_matrix(const float* W, int K, int Nsrc, int Npos, int gu, const float* gamma, bf16_t* WT, LAS float* scr, int gw, int ngw, int lane) {
    const int npb = Npos / 32, nitems = (K / 64) * npb;
    for (int it = gw; it < nitems; it += ngw) transpose_item(W, K, Nsrc, gu, gamma, WT, scr, it, npb, lane);
}
__device__ __forceinline__ void convert_mats(const Params& P, LAS unsigned char* lds, int m_lo, int m_hi, int gw, int ngw, int wid, int lane) {
    LAS float* scr = (LAS float*)(lds + wid * 8704);
    unsigned char* ws = P.ws;
    for (int mi = m_lo; mi < m_hi; ++mi) {
        int type, idx;
        if (mi < 4) { type = (mi == 0) ? 0 : (mi == 1) ? 1 : (mi == 2) ? 4 : 5; idx = 0; }
        else { const int r = mi - 4, grp = r >> 2, q = r & 3;
            if (q >= 2) { type = q + 2; idx = grp + 1; } else if (grp == 1) { type = q; idx = 1; } else { type = 2 + q; idx = grp >> 1; } }
        const float* W; const float* gamma = nullptr; bf16_t* WT; int K = 1024, Nsrc, Npos, gu = 0;
        if (type == 0) { W = P.in[8] + (size_t)idx * 1024 * ABIN; gamma = P.in[7] + idx * 1024; WT = (bf16_t*)(ws + WS_WIN + idx * SZ_WIN); Nsrc = ABIN; Npos = ABPAD; }
        else if (type == 1) { W = P.in[16] + (size_t)idx * 1024 * 1024; WT = (bf16_t*)(ws + WS_WOUT + idx * SZ_W1K); Nsrc = 1024; Npos = 1024; }
        else if (type == 2) { W = P.in[18] + (size_t)idx * 1024 * NQKV; gamma = P.in[17] + idx * 1024; WT = (bf16_t*)(ws + WS_WQKV + idx * SZ_WQKV); Nsrc = NQKV; Npos = NQKV; }
        else if (type == 3) { W = P.in[20] + (size_t)idx * 1024 * 1024; WT = (bf16_t*)(ws + WS_WCOUT + idx * SZ_W1K); Nsrc = 1024; Npos = 1024; }
        else if (type == 4) { W = P.in[22] + (size_t)idx * 1024 * NGU; gamma = P.in[21] + idx * 1024; WT = (bf16_t*)(ws + WS_WGU + idx * SZ_WGU); Nsrc = NGU; Npos = NGU; gu = 1; }
        else { W = P.in[23] + (size_t)idx * DFF * 1024; WT = (bf16_t*)(ws + WS_WDN + idx * SZ_WDN); K = DFF; Nsrc = 1024; Npos = 1024; }
        convert_matrix(W, K, Nsrc, Npos, gu, gamma, WT, scr, gw, ngw, lane);
    }
}
__device__ __forceinline__ void phase_prologue(const Params& P, LAS unsigned char* lds, int gw, int ngw, int wid, int lane) {
    convert_mats(P, lds, 0, 1, gw, ngw, wid, lane);
    unsigned char* ws = P.ws;
    bf16_t* Xb = (bf16_t*)(ws + WS_XB); float* ssp = (float*)(ws + WS_SSP);
    for (int row = gw; row < TR; row += ngw) {
        const float* xr = (row < TP) ? P.in[0] + (size_t)row * DM : P.in[1] + (size_t)(row - TP) * DM;
        f32x4 v[4]; float s = 0.f;
#pragma unroll
        for (int j = 0; j < 4; ++j) { v[j] = ((const f32x4*)xr)[lane + 64 * j]; s += (v[j][0] * v[j][0] + v[j][1] * v[j][1]) + (v[j][2] * v[j][2] + v[j][3] * v[j][3]); }
        s = wave_sum(s);
#pragma unroll
        for (int j = 0; j < 4; ++j) { u32x2 w; w.x = pk2(v[j][0], v[j][1]); w.y = pk2(v[j][2], v[j][3]); ((u32x2*)(Xb + (size_t)row * DM))[lane + 64 * j] = w; }
        if (lane < 16) ssp[(size_t)row * 16 + lane] = (lane == 0) ? s : 0.f;
    }
}
__device__ __forceinline__ void phase_final(const Params& P, int gw, int ngw, int lane) {
    const GAS float* ssp = (const GAS float*)(P.ws + WS_SSP); const float* g = P.in[24]; const bf16_t* Xb = (const bf16_t*)(P.ws + WS_XB);
    f32x4 gv[4];
#pragma unroll
    for (int j = 0; j < 4; ++j) gv[j] = ((const f32x4*)g)[lane + 64 * j];
    for (int row = gw; row < TR; row += ngw) {
        const float rstd = row_rstd(ssp, row);
        f32x4* yr = (f32x4*)(P.out + (size_t)row * DM);
#pragma unroll
        for (int j = 0; j < 4; ++j) { const u32x2 w = ((const u32x2*)(Xb + (size_t)row * DM))[lane + 64 * j];
            f32x4 v; v[0] = __builtin_bit_cast(float, w[0] << 16); v[1] = __builtin_bit_cast(float, w[0] & 0xffff0000u); v[2] = __builtin_bit_cast(float, w[1] << 16); v[3] = __builtin_bit_cast(float, w[1] & 0xffff0000u);
            __builtin_nontemporal_store(v * rstd * gv[j], yr + lane + 64 * j); }
    }
}

constexpr int MX_CH = 32;
#define LDS_BARRIER() asm volatile("s_waitcnt lgkmcnt(0)\n\ts_barrier" ::: "memory")
__device__ __forceinline__ void delta_unit(const Params& P, LAS unsigned char* lds, int li, bool sample, int b, int h, int half, const int tid) {
    const int lane = tid & 63, wid = __builtin_amdgcn_readfirstlane(tid >> 6);
    const int L = sample ? SSEQ : SEQ, rowbase = sample ? TP + b * SSEQ : b * SEQ;
    const bf16_t* PROJ = (const bf16_t*)(P.ws + WS_R1); const float* GATES = (const float*)(P.ws + WS_GATES); bf16_t* MIX = (bf16_t*)(P.ws + WS_MIX);
    const int NC = (L + MX_CH - 1) / MX_CH;
    constexpr int SET = 4 * 8192 + 256;
    if (wid < 4) __builtin_amdgcn_s_setprio(2);
    const int e = 32 * half + (wid & 3) * 8 + (lane >> 3), dq = lane & 7;
    f32x2 S[4];
    float* sout = P.out + (sample ? O_DNS : O_DNP) + (size_t)((li * 8 + b) * 8 + h) * 4096;
    if (wid < 4) {
        if (sample) { const float* s0 = P.in[3] + (size_t)((li * 8 + b) * 8 + h) * 4096;
#pragma unroll
            for (int j = 0; j < 4; ++j) { S[j][0] = s0[(8 * dq + 2 * j) * 64 + e]; S[j][1] = s0[(8 * dq + 2 * j + 1) * 64 + e]; } }
        else {
#pragma unroll
            for (int j = 0; j < 4; ++j) S[j] = (f32x2){0.f, 0.f}; }
    }
    const int pw = wid - 4, c = lane;
    float cwq[4], cwk[4], cwv[4], alog = 0.f, dtb = 0.f;
    float rq[11], rk[11], rv[11], ga = 0.f, gb_ = 0.f;
    if (wid >= 4) {
        const float* cw = P.in[9] + (size_t)li * 4 * DNQKV;
#pragma unroll
        for (int t = 0; t < 4; ++t) { cwq[t] = cw[t * DNQKV + h * 64 + c]; cwk[t] = cw[t * DNQKV + 512 + h * 64 + c]; cwv[t] = cw[t * DNQKV + 1024 + h * 64 + c]; }
        alog = P.in[10][li * 8 + h]; dtb = P.in[11][li * 8 + h];
    }
#define DN_LOADS(jn) do { const int t0n_ = (jn) * MX_CH + pw * 8; if ((jn) < NC && t0n_ < L) { \
        _Pragma("unroll") for (int r = 0; r < 11; ++r) { const int t = t0n_ - 3 + r, tc = max(t, 0); const bf16_t* pr = PROJ + (size_t)(rowbase + tc) * ABIN + h * 64 + c; \
            const float m = (t >= 0) ? 1.f : 0.f; rq[r] = bf2f(pr[0]) * m; rk[r] = bf2f(pr[512]) * m; rv[r] = bf2f(pr[1024]) * m; } \
        { const float* gp = GATES + (size_t)(rowbase + t0n_ + (lane & 7)) * 32; ga = gp[h]; gb_ = gp[8 + h]; } \
        if (sample && t0n_ == 0) { _Pragma("unroll") for (int r = 0; r < 3; ++r) { const float* cb = P.in[2] + (size_t)((li * 8 + b) * 3 + r) * DNQKV + h * 64 + c; rq[r] = cb[0]; rk[r] = cb[512]; rv[r] = cb[1024]; } } } } while (0)
    if (wid >= 4) DN_LOADS(0);
    for (int j = 0; j < NC + 2; ++j) {
        if (wid >= 4) {
            if (j < NC) {
                LAS float* qs = (LAS float*)(lds + (j & 1) * SET); LAS float* ks = qs + 2048; LAS float* vs = qs + 4096; LAS float* sc = qs + 8192;
                const int t0 = j * MX_CH + pw * 8;
                if (t0 < L) {
#pragma unroll
                    for (int i = 0; i < 8; ++i) {
                        float q = cwq[0] * rq[i] + cwq[1] * rq[i + 1] + cwq[2] * rq[i + 2] + cwq[3] * rq[i + 3];
                        float k = cwk[0] * rk[i] + cwk[1] * rk[i + 1] + cwk[2] * rk[i + 2] + cwk[3] * rk[i + 3];
                        float v = cwv[0] * rv[i] + cwv[1] * rv[i + 1] + cwv[2] * rv[i + 2] + cwv[3] * rv[i + 3];
                        q = silu_f(q); k = silu_f(k); v = silu_f(v);
                        const float sq = wave_sum(q * q), sk = wave_sum(k * k);
                        const int tok = pw * 8 + i;
                        qs[tok * 64 + c] = q * rsqrtf(sq + EPS) * 0.125f; ks[tok * 64 + c] = k * rsqrtf(sk + EPS); vs[tok * 64 + c] = v;
                    }
                    if (lane < 8) { const float g = -__expf(alog) * softplus_f(ga + dtb); sc[(pw * 8 + lane) * 2] = __expf(g); sc[(pw * 8 + lane) * 2 + 1] = sigmoid_f(gb_); }
                }
            }
            DN_LOADS(j + 1);
            if (j >= 2) {
                LAS float* os = (LAS float*)(lds + (j & 1) * SET) + 6144;
                const int t0 = (j - 2) * MX_CH + pw * 8;
                if (t0 < L && (c >> 5) == half) {
#pragma unroll
                    for (int i = 0; i < 8; ++i) {
                        const int tok = pw * 8 + i; const size_t row = (size_t)(rowbase + t0 + i);
                        MIX[row * DM + h * 64 + c] = (bf16_t)f2bf(os[tok * 64 + c]);
                    }
                }
            }
        } else if (j >= 1 && j <= NC) {
            LAS float* qs = (LAS float*)(lds + ((j - 1) & 1) * SET); LAS float* ks = qs + 2048; LAS float* vs = qs + 4096; LAS float* os = qs + 6144; LAS float* sc = qs + 8192;
            const int ntok = min(MX_CH, L - (j - 1) * MX_CH);
            f32x4 kA0, kA1, qA0, qA1, kB0, kB1, qB0, qB1; float vA, vB; f32x2 gA, gB;
            kA0 = *(const LAS f32x4*)(ks + 8 * dq); kA1 = *(const LAS f32x4*)(ks + 8 * dq + 4); qA0 = *(const LAS f32x4*)(qs + 8 * dq); qA1 = *(const LAS f32x4*)(qs + 8 * dq + 4);
            vA = vs[e]; gA = *(const LAS f32x2*)(sc);
#define DN_STEP(TOK, K0, K1, Q0, Q1, VE, GB, NK0, NK1, NQ0, NQ1, NVE, NGB) do { \
                const int tn_ = min((TOK) + 1, ntok - 1); \
                NK0 = *(const LAS f32x4*)(ks + tn_ * 64 + 8 * dq); NK1 = *(const LAS f32x4*)(ks + tn_ * 64 + 8 * dq + 4); NQ0 = *(const LAS f32x4*)(qs + tn_ * 64 + 8 * dq); NQ1 = *(const LAS f32x4*)(qs + tn_ * 64 + 8 * dq + 4); \
                NVE = vs[tn_ * 64 + e]; NGB = *(const LAS f32x2*)(sc + tn_ * 2); \
                const float eg = GB[0], beta = GB[1]; \
                const f32x2 wa = (f32x2){K0[0], K0[1]} * S[0] + (f32x2){K0[2], K0[3]} * S[1]; \
                const f32x2 wb = (f32x2){K1[0], K1[1]} * S[2] + (f32x2){K1[2], K1[3]} * S[3]; \
                const f32x2 ws2 = wa + wb; \
                const float w = oct_sum(ws2[0] + ws2[1]); \
                const float dl = beta * (VE - eg * w); \
                const f32x2 eg2 = (f32x2){eg, eg}, dl2 = (f32x2){dl, dl}; \
                S[0] = S[0] * eg2 + (f32x2){K0[0], K0[1]} * dl2; S[1] = S[1] * eg2 + (f32x2){K0[2], K0[3]} * dl2; \
                S[2] = S[2] * eg2 + (f32x2){K1[0], K1[1]} * dl2; S[3] = S[3] * eg2 + (f32x2){K1[2], K1[3]} * dl2; \
                const f32x2 oa = (f32x2){Q0[0], Q0[1]} * S[0] + (f32x2){Q0[2], Q0[3]} * S[1]; \
                const f32x2 ob = (f32x2){Q1[0], Q1[1]} * S[2] + (f32x2){Q1[2], Q1[3]} * S[3]; \
                const f32x2 os2 = oa + ob; \
                os[(TOK) * 64 + e] = oct_sum(os2[0] + os2[1]); } while (0)
            for (int tok = 0; tok < ntok; tok += 2) {
                DN_STEP(tok, kA0, kA1, qA0, qA1, vA, gA, kB0, kB1, qB0, qB1, vB, gB);
                DN_STEP(tok + 1, kB0, kB1, qB0, qB1, vB, gB, kA0, kA1, qA0, qA1, vA, gA);
            }
#undef DN_STEP
        }
        LDS_BARRIER();
    }
#undef DN_LOADS
    if (wid < 4) {
#pragma unroll
        for (int j = 0; j < 4; ++j) { sout[(8 * dq + 2 * j) * 64 + e] = S[j][0]; sout[(8 * dq + 2 * j + 1) * 64 + e] = S[j][1]; }
    }
    __builtin_amdgcn_s_setprio(0);
}

__device__ __forceinline__ void gla_unit(const Params& P, LAS unsigned char* lds, int li, bool sample, int b, int h, const int tid) {
    const int lane = tid & 63, wid = __builtin_amdgcn_readfirstlane(tid >> 6);
    const int L = sample ? SSEQ : SEQ, rowbase = sample ? TP + b * SSEQ : b * SEQ;
    const bf16_t* PROJ = (const bf16_t*)(P.ws + WS_R1); const float* GATES = (const float*)(P.ws + WS_GATES); bf16_t* MIX = (bf16_t*)(P.ws + WS_MIX);
    const int NC = (L + MX_CH - 1) / MX_CH;
    constexpr int SET = 3 * 4096 + 2 * 8192;
    if (wid < 4) __builtin_amdgcn_s_setprio(2);
    const int e = (wid & 3) * 16 + (lane >> 2), dq = lane & 3;
    f32x2 S[4];
    float* sout = P.out + (sample ? O_GLAS : O_GLAP) + (size_t)((li * 8 + b) * 8 + h) * 2048;
    if (wid < 4) {
        if (sample) { const float* s0 = P.in[4] + (size_t)((li * 8 + b) * 8 + h) * 2048;
#pragma unroll
            for (int j = 0; j < 4; ++j) { S[j][0] = s0[(8 * dq + 2 * j) * 64 + e]; S[j][1] = s0[(8 * dq + 2 * j + 1) * 64 + e]; } }
        else {
#pragma unroll
            for (int j = 0; j < 4; ++j) S[j] = (f32x2){0.f, 0.f}; }
    }
    const int pw = wid - 4, c = lane, c32 = lane & 31;
    float w2[16], gkb = 0.f, onorm = 0.f;
    if (wid >= 4) {
#pragma unroll
        for (int r = 0; r < 16; ++r) w2[r] = P.in[13][(size_t)(li * 16 + r) * 256 + h * 32 + c32];
        gkb = P.in[14][li * 256 + h * 32 + c32]; onorm = P.in[15][li * 64 + c];
    }
    for (int j = 0; j < NC + 2; ++j) {
        if (wid >= 4) {
            if (j < NC) {
                LAS float* qs = (LAS float*)(lds + (j & 1) * SET); LAS float* ks = qs + 1024; LAS float* gs = qs + 2048; LAS float* vs = qs + 3072;
                const int t0 = j * MX_CH + pw * 8;
                if (t0 < L) {
                    const int g4 = (lane >> 5) * 4;
                    float rv[8], rq[4], rk[4]; f32x4 lrv[4][4];
#pragma unroll
                    for (int i = 0; i < 8; ++i) rv[i] = bf2f(PROJ[(size_t)(rowbase + t0 + i) * ABIN + 2576 + h * 64 + c]);
#pragma unroll
                    for (int i = 0; i < 4; ++i) { const size_t row = (size_t)(rowbase + t0 + g4 + i); const bf16_t* pr = PROJ + row * ABIN;
                        rq[i] = bf2f(pr[2064 + h * 32 + c32]); rk[i] = bf2f(pr[2320 + h * 32 + c32]);
#pragma unroll
                        for (int r = 0; r < 4; ++r) lrv[i][r] = *(const f32x4*)(GATES + row * 32 + 16 + 4 * r); }
#pragma unroll
                    for (int i = 0; i < 8; ++i) vs[(pw * 8 + i) * 64 + c] = rv[i];
#pragma unroll
                    for (int i = 0; i < 4; ++i) {
                        const int tok = pw * 8 + g4 + i;
                        float z = gkb;
#pragma unroll
                        for (int r = 0; r < 4; ++r) z += (lrv[i][r][0] * w2[4 * r] + lrv[i][r][1] * w2[4 * r + 1]) + (lrv[i][r][2] * w2[4 * r + 2] + lrv[i][r][3] * w2[4 * r + 3]);
                        const float ls = -softplus_f(-z);
                        qs[tok * 32 + c32] = rq[i] * 0.17677669529663687f; ks[tok * 32 + c32] = rk[i]; gs[tok * 32 + c32] = __expf(ls * (1.0f / 16.0f));
                    }
                }
            }
            if (j >= 2) {
                LAS float* os = (LAS float*)(lds + (j & 1) * SET) + 3072 + 2048;
                const int t0 = (j - 2) * MX_CH + pw * 8;
                if (t0 < L) {
#pragma unroll
                    for (int i = 0; i < 8; ++i) {
                        const int tok = pw * 8 + i; const size_t row = (size_t)(rowbase + t0 + i);
                        MIX[row * DM + 512 + h * 64 + c] = (bf16_t)f2bf(os[tok * 64 + c]);
                    }
                }
            }
        } else if (j >= 1 && j <= NC) {
            LAS float* qs = (LAS float*)(lds + ((j - 1) & 1) * SET); LAS float* ks = qs + 1024; LAS float* gs = qs + 2048; LAS float* vs = qs + 3072; LAS float* os = qs + 3072 + 2048;
            const int ntok = min(MX_CH, L - (j - 1) * MX_CH);
            f32x4 kk[2], qq[2], gg[2]; float ve;
#pragma unroll
            for (int i = 0; i < 2; ++i) { kk[i] = *(const LAS f32x4*)(ks + 8 * dq + 4 * i); qq[i] = *(const LAS f32x4*)(qs + 8 * dq + 4 * i); gg[i] = *(const LAS f32x4*)(gs + 8 * dq + 4 * i); }
            ve = vs[e];
            for (int tok = 0; tok < ntok; ++tok) {
                const int tn = min(tok + 1, ntok - 1);
                f32x4 kn[2], qn[2], gn[2];
#pragma unroll
                for (int i = 0; i < 2; ++i) { kn[i] = *(const LAS f32x4*)(ks + tn * 32 + 8 * dq + 4 * i); qn[i] = *(const LAS f32x4*)(qs + tn * 32 + 8 * dq + 4 * i); gn[i] = *(const LAS f32x4*)(gs + tn * 32 + 8 * dq + 4 * i); }
                const float vn = vs[tn * 64 + e];
                const f32x2 v2 = (f32x2){ve, ve};
                f32x2 oa[2];
#pragma unroll
                for (int i = 0; i < 2; ++i) {
                    S[2 * i] = S[2 * i] * (f32x2){gg[i][0], gg[i][1]} + (f32x2){kk[i][0], kk[i][1]} * v2; S[2 * i + 1] = S[2 * i + 1] * (f32x2){gg[i][2], gg[i][3]} + (f32x2){kk[i][2], kk[i][3]} * v2;
                    oa[i] = (f32x2){qq[i][0], qq[i][1]} * S[2 * i] + (f32x2){qq[i][2], qq[i][3]} * S[2 * i + 1];
                }
                const f32x2 os2 = oa[0] + oa[1];
                const float o = quad_sum(os2[0] + os2[1]);
                if (dq == 0) os[tok * 64 + e] = o;
#pragma unroll
                for (int i = 0; i < 2; ++i) { kk[i] = kn[i]; qq[i] = qn[i]; gg[i] = gn[i]; }
                ve = vn;
            }
        }
        __syncthreads();
    }
    if (wid < 4) {
#pragma unroll
        for (int j = 0; j < 4; ++j) { sout[(8 * dq + 2 * j) * 64 + e] = S[j][0]; sout[(8 * dq + 2 * j + 1) * 64 + e] = S[j][1]; }
    }
    __builtin_amdgcn_s_setprio(0);
}

__device__ __forceinline__ void phase_fixup(const Params& P, int li, int gw, int ngw, int lane) {
    bf16_t* MIX = (bf16_t*)(P.ws + WS_MIX); const bf16_t* PROJ = (const bf16_t*)(P.ws + WS_R1);
    const float* on = (lane < 32 ? P.in[12] : P.in[15]) + li * 64 + 16 * (lane & 3);
    float g[16];
#pragma unroll
    for (int j = 0; j < 16; ++j) g[j] = on[j];
    const int gcol = (lane < 32) ? 1552 + 16 * lane : 3104 + 16 * (lane - 32);
    for (int row = gw; row < TR; row += ngw) {
        u32x4* mp = (u32x4*)(MIX + (size_t)row * DM + 16 * lane);
        const u32x4* gp = (const u32x4*)(PROJ + (size_t)row * ABIN + gcol);
        const u32x4 m0 = mp[0], m1 = mp[1], g0 = gp[0], g1 = gp[1];
        float o[16], gt[16];
#pragma unroll
        for (int j = 0; j < 4; ++j) { o[2 * j] = __builtin_bit_cast(float, m0[j] << 16); o[2 * j + 1] = __builtin_bit_cast(float, m0[j] & 0xffff0000u); o[8 + 2 * j] = __builtin_bit_cast(float, m1[j] << 16); o[8 + 2 * j + 1] = __builtin_bit_cast(float, m1[j] & 0xffff0000u);
            gt[2 * j] = __builtin_bit_cast(float, g0[j] << 16); gt[2 * j + 1] = __builtin_bit_cast(float, g0[j] & 0xffff0000u); gt[8 + 2 * j] = __builtin_bit_cast(float, g1[j] << 16); gt[8 + 2 * j + 1] = __builtin_bit_cast(float, g1[j] & 0xffff0000u); }
        float ss = 0.f;
#pragma unroll
        for (int j = 0; j < 16; ++j) ss += o[j] * o[j];
        ss = quad_sum(ss);
        const float rstd = rsqrtf(ss * (1.0f / 64.0f) + EPS);
        float r[16];
#pragma unroll
        for (int j = 0; j < 16; ++j) r[j] = o[j] * rstd * g[j] * silu_f(gt[j]);
        u32x4 w0, w1;
#pragma unroll
        for (int j = 0; j < 4; ++j) { w0[j] = pk2(r[2 * j], r[2 * j + 1]); w1[j] = pk2(r[8 + 2 * j], r[8 + 2 * j + 1]); }
        mp[0] = w0; mp[1] = w1;
    }
}

constexpr int AT_KOFF = 0, AT_VOFF = 2 * 9216, AT_BIAS = 4 * 9216;
__device__ __forceinline__ int vpos(int kv) { return 16 * (kv >> 4) + 8 * ((kv >> 2) & 1) + 4 * ((kv >> 3) & 1) + (kv & 3); }
__device__ __forceinline__ void attn_build_bias(const Params& P, LAS unsigned char* lds, int li, int h, const int tid) {
    const float* tb = P.in[19] + (size_t)(li * 16 + h) * 257;
    LAS float* bt = (LAS float*)(lds + AT_BIAS);
    for (int i = tid; i < 4 * 2 * 64 * 32; i += 512) {
        const int r = i & 31, lane = (i >> 5) & 63, par = (i >> 11) & 1, dist = i >> 12, hi = lane >> 5, r32 = lane & 31;
        const int kv = ((r & 3) + 8 * ((r & 15) >> 2) + 4 * hi) + 32 * (r >> 4), rel = r32 + 32 * par - kv + 64 * dist;
        const float v = (dist == 3) ? tb[256] : tb[min(rel, 128) + 128];
        bt[(((dist * 2 + par) * 8 + (r >> 2)) * 64 + lane) * 4 + (r & 3)] = v * 8.0f;
    }
}
__device__ __forceinline__ void attn_tile(const LAS unsigned char* Kb, const LAS unsigned char* Vb, const LAS f32x4* bp, const bf16x8 (&qr)[4], f32x16 (&o)[2], float& m, float& l, int r32, int hi) {
    const float C2 = 0.125f * LOG2E;
    f32x16 p0, p1;
#pragma unroll
    for (int j = 0; j < 4; ++j) { const f32x4 t0 = bp[j * 64], t1 = bp[(4 + j) * 64];
        p0[4 * j] = t0[0]; p0[4 * j + 1] = t0[1]; p0[4 * j + 2] = t0[2]; p0[4 * j + 3] = t0[3]; p1[4 * j] = t1[0]; p1[4 * j + 1] = t1[1]; p1[4 * j + 2] = t1[2]; p1[4 * j + 3] = t1[3]; }
#pragma unroll
    for (int d0 = 0; d0 < 4; ++d0) {
        const bf16x8 a0 = *(const LAS bf16x8*)(Kb + r32 * 144 + d0 * 32 + hi * 16);
        const bf16x8 a1 = *(const LAS bf16x8*)(Kb + (32 + r32) * 144 + d0 * 32 + hi * 16);
        p0 = __builtin_amdgcn_mfma_f32_32x32x16_bf16(a0, qr[d0], p0, 0, 0, 0);
        p1 = __builtin_amdgcn_mfma_f32_32x32x16_bf16(a1, qr[d0], p1, 0, 0, 0);
    }
    float mx = fmaxf(p0[0], p1[0]);
#pragma unroll
    for (int r = 1; r < 16; ++r) mx = fmaxf(mx, fmaxf(p0[r], p1[r]));
    mx = fmaxf(mx, __shfl_xor(mx, 32)) * C2;
    if (__any(mx > m + 8.0f)) {
        const float mn = fmaxf(m, mx), scl = __builtin_amdgcn_exp2f(m - mn); m = mn; l *= scl;
#pragma unroll
        for (int r = 0; r < 16; ++r) { o[0][r] *= scl; o[1][r] *= scl; }
    }
    float ls = 0.f; const float nm = -m;
#pragma unroll
    for (int r = 0; r < 16; ++r) { p0[r] = __builtin_amdgcn_exp2f(p0[r] * C2 + nm); p1[r] = __builtin_amdgcn_exp2f(p1[r] * C2 + nm); ls += p0[r] + p1[r]; }
    l += ls;
    u32x4 pw[4];
#pragma unroll
    for (int s = 0; s < 2; ++s) {
        pw[s] = (u32x4){pk2(p0[8 * s], p0[8 * s + 1]), pk2(p0[8 * s + 2], p0[8 * s + 3]), pk2(p0[8 * s + 4], p0[8 * s + 5]), pk2(p0[8 * s + 6], p0[8 * s + 7])};
        pw[2 + s] = (u32x4){pk2(p1[8 * s], p1[8 * s + 1]), pk2(p1[8 * s + 2], p1[8 * s + 3]), pk2(p1[8 * s + 4], p1[8 * s + 5]), pk2(p1[8 * s + 6], p1[8 * s + 7])};
    }
#pragma unroll
    for (int dh = 0; dh < 2; ++dh)
#pragma unroll
        for (int ks = 0; ks < 4; ++ks) {
            const bf16x8 vf = *(const LAS bf16x8*)(Vb + (32 * dh + r32) * 144 + (16 * ks + 8 * hi) * 2);
            o[dh] = __builtin_amdgcn_mfma_f32_32x32x16_bf16(vf, __builtin_bit_cast(bf16x8, pw[ks]), o[dh], 0, 0, 0);
        }
}
__device__ __forceinline__ void attn_prompt_unit(const Params& P, LAS unsigned char* lds, int li, int b, int h, int g4, const int tid) {
    const int lane = tid & 63, wid = __builtin_amdgcn_readfirstlane(tid >> 6), r32 = lane & 31, hi = lane >> 5;
    const bf16_t* QKV = (const bf16_t*)(P.ws + WS_R1); bf16_t* MIX = (bf16_t*)(P.ws + WS_MIX);
    const int cw = 4 * g4 + (wid >> 1);
    const size_t qrow = (size_t)b * SEQ + 256 * g4 + 32 * wid + r32;
    bf16x8 qr[4];
#pragma unroll
    for (int d0 = 0; d0 < 4; ++d0) qr[d0] = *(const bf16x8*)(QKV + qrow * NQKV + h * 64 + d0 * 16 + hi * 8);
    const int kt_lo = max(0, 4 * g4 - 8), kt_hi = 4 * g4 + 3;
    const int srow = tid & 63, sch = tid >> 6;
    const bf16_t* kvsrc = QKV + ((size_t)b * SEQ + srow) * NQKV + 1024 + h * 64 + 8 * sch;
    const int vp = vpos(srow);
    bf16x8 kA, vA, kB, vB;
#define AT_LOAD(K_, V_, kt) do { const bf16_t* s_ = kvsrc + (size_t)(kt) * 64 * NQKV; K_ = *(const bf16x8*)s_; V_ = *(const bf16x8*)(s_ + 1024); } while (0)
#define AT_STORE(K_, V_, buf) do { *(LAS bf16x8*)(lds + AT_KOFF + (buf) * 9216 + srow * 144 + sch * 16) = K_; \
        _Pragma("unroll") for (int j_ = 0; j_ < 8; ++j_) *(LAS short*)(lds + AT_VOFF + (buf) * 9216 + (8 * sch + j_) * 144 + vp * 2) = V_[j_]; } while (0)
    AT_LOAD(kA, vA, kt_lo); AT_LOAD(kB, vB, kt_lo + 1);
    AT_STORE(kA, vA, 0);
    LDS_BARRIER();
    float m = -1e30f, l = 0.f; f32x16 o[2];
#pragma unroll
    for (int r = 0; r < 16; ++r) { o[0][r] = 0.f; o[1][r] = 0.f; }
    const LAS f32x4* btl = (const LAS f32x4*)(lds + AT_BIAS) + (wid & 1) * 512 + lane;
    for (int kt = kt_lo; kt <= kt_hi; kt += 2) {
        if (kt + 2 <= kt_hi) AT_LOAD(kA, vA, kt + 2);
        if (kt >= cw - 8 && kt <= cw) attn_tile(lds + AT_KOFF, lds + AT_VOFF, btl + min(cw - kt, 3) * 1024, qr, o, m, l, r32, hi);
        AT_STORE(kB, vB, 1);
        LDS_BARRIER();
        if (kt + 3 <= kt_hi) AT_LOAD(kB, vB, kt + 3);
        if (kt + 1 >= cw - 8 && kt + 1 <= cw) attn_tile(lds + AT_KOFF + 9216, lds + AT_VOFF + 9216, btl + min(cw - kt - 1, 3) * 1024, qr, o, m, l, r32, hi);
        if (kt + 2 <= kt_hi) AT_STORE(kA, vA, 0);
        LDS_BARRIER();
    }
#undef AT_LOAD
#undef AT_STORE
    l += __shfl_xor(l, 32);
    const float rl = 1.0f / l;
    bf16_t* op = MIX + qrow * DM + h * 64;
#pragma unroll
    for (int dh = 0; dh < 2; ++dh)
#pragma unroll
        for (int r4 = 0; r4 < 4; ++r4) {
            u32x2 w; w.x = pk2(o[dh][4 * r4] * rl, o[dh][4 * r4 + 1] * rl); w.y = pk2(o[dh][4 * r4 + 2] * rl, o[dh][4 * r4 + 3] * rl);
            *(u32x2*)(op + 32 * dh + 8 * r4 + 4 * hi) = w;
        }
}
__device__ __forceinline__ void attn_sample_unit(const Params& P, LAS unsigned char* lds, int li, int b, int h, const int tid) {
    const int lane = tid & 63, wid = tid >> 6;
    const bf16_t* QKV = (const bf16_t*)(P.ws + WS_R1); bf16_t* MIX = (bf16_t*)(P.ws + WS_MIX);
    LAS float* qs = (LAS float*)lds;
    LAS float* sc = qs + 1024;
    LAS float* tab = sc + 16 * 528;
    const size_t rb = (size_t)TP + b * SSEQ;
    for (int i = tid; i < 1024; i += 512) qs[i] = bf2f(QKV[(rb + (i >> 6)) * NQKV + h * 64 + (i & 63)]);
    if (tid < 257) tab[tid] = P.in[19][(size_t)(li * 16 + h) * 257 + tid];
    __syncthreads();
    const float* kc = P.in[5] + ((size_t)(li * 8 + b) * 512) * 1024 + h * 64;
    const float* vc = P.in[6] + ((size_t)(li * 8 + b) * 512) * 1024 + h * 64;
    for (int j = tid; j < 528; j += 512) {
        float kr[64];
        if (j < 512) {
#pragma unroll
            for (int d = 0; d < 16; ++d) { const f32x4 t = *(const f32x4*)(kc + (size_t)j * 1024 + 4 * d); kr[4 * d] = t[0]; kr[4 * d + 1] = t[1]; kr[4 * d + 2] = t[2]; kr[4 * d + 3] = t[3]; }
        } else {
#pragma unroll
            for (int d = 0; d < 64; ++d) kr[d] = bf2f(QKV[(rb + (j - 512)) * NQKV + 1024 + h * 64 + d]);
        }
        for (int q = 0; q < 16; ++q) {
            float s = 0.f;
#pragma unroll
            for (int d = 0; d < 64; ++d) s += qs[q * 64 + d] * kr[d];
            const int rel = (j < 512) ? (512 + q - j) : (q - (j - 512));
            sc[q * 528 + j] = s * 0.125f + tab[min(max(rel, -128), 128) + 128];
        }
    }
    __syncthreads();
    for (int q = 2 * wid; q < 2 * wid + 2; ++q) {
        float mx = -1e30f;
        for (int j = lane; j < 528; j += 64) mx = fmaxf(mx, sc[q * 528 + j]);
#pragma unroll
        for (int o = 1; o < 64; o <<= 1) mx = fmaxf(mx, __shfl_xor(mx, o));
        float sm = 0.f;
        for (int j = lane; j < 528; j += 64) { const float p = __expf(sc[q * 528 + j] - mx); sc[q * 528 + j] = p; sm += p; }
        sm = wave_sum(sm);
        const float inv = 1.0f / sm;
        for (int j = lane; j < 528; j += 64) sc[q * 528 + j] *= inv;
    }
    __syncthreads();
    {
        const int q = tid >> 5, d = 2 * (tid & 31);
        float a0 = 0.f, a1 = 0.f;
        for (int j = 0; j < 512; ++j) { const f32x2 v = *(const f32x2*)(vc + (size_t)j * 1024 + d); const float p = sc[q * 528 + j]; a0 += p * v[0]; a1 += p * v[1]; }
        for (int j = 0; j < 16; ++j) { const bf16_t* vp = QKV + (rb + j) * NQKV + 2048 + h * 64 + d; const float p = sc[q * 528 + 512 + j]; a0 += p * bf2f(vp[0]); a1 += p * bf2f(vp[1]); }
        *(unsigned*)(MIX + (rb + q) * DM + h * 64 + d) = pk2(a0, a1);
    }
    __syncthreads();
}

#define XB_TMO      128
#define XB_XCNT(j)  (256  + 64 * (j))
#define XB_XSUB(j)  (1280 + 64 * (j))
#define XB_XGEN(j)  (2304 + 64 * (j))
#define XB_TOP      3328
#define XB_TOPGEN   3392
#define XCD_BAR_WORDS 3456
#define XB_SPIN_CAP (1u << 20)
__device__ __forceinline__ unsigned xb_ld(unsigned* p)              { return __hip_atomic_load(p, __ATOMIC_RELAXED, __HIP_MEMORY_SCOPE_AGENT); }
__device__ __forceinline__ unsigned xb_add(unsigned* p, unsigned v) { return __hip_atomic_fetch_add(p, v, __ATOMIC_RELAXED, __HIP_MEMORY_SCOPE_AGENT); }
__device__ __forceinline__ unsigned xb_xcc_id() { return (unsigned)__builtin_amdgcn_s_getreg((3 << 11) | 20) & 0xFu; }
#define XB_SPIN(cond, bar) do { unsigned _sp = 0; while (cond) { __builtin_amdgcn_s_sleep(1); \
    if ((++_sp & 255u) == 0u) { if (xb_ld(&(bar)[XB_TMO])) break; if (_sp > XB_SPIN_CAP) { atomicAdd(&(bar)[XB_TMO], 1u); break; } } } } while (0)
struct XcdBarrier { unsigned* bar; unsigned x; volatile LAS unsigned* st; };
__device__ __forceinline__ XcdBarrier xcd_barrier_post(unsigned* bar, volatile LAS unsigned* st) {
    XcdBarrier b; b.bar = bar; b.x = xb_xcc_id(); b.st = st;
    if (threadIdx.x == 0) (void)xb_add(&bar[XB_XCNT(b.x)], 1u);
    return b;
}
__device__ __forceinline__ void xcd_barrier_complete(unsigned* bar, unsigned x, unsigned& nloc, unsigned& nx) {
    const unsigned G = gridDim.x * gridDim.y * gridDim.z;
    unsigned sum, cnt, mine, sp = 0u;
    for (;;) {
        sum = 0u; cnt = 0u; mine = 0u;
#pragma unroll
        for (unsigned j = 0; j < 16; ++j) { const unsigned c = xb_ld(&bar[XB_XCNT(j)]); sum += c; cnt += (c > 0u) ? 1u : 0u; mine = (j == x) ? c : mine; }
        if (sum == G) break;
        __builtin_amdgcn_s_sleep(1);
        if ((++sp & 255u) == 0u) { if (xb_ld(&bar[XB_TMO])) break; if (sp > XB_SPIN_CAP) { atomicAdd(&bar[XB_TMO], 1u); break; } }
    }
    nloc = mine > 0u ? mine : 1u; nx = cnt > 0u ? cnt : 1u;
}
__device__ __forceinline__ void xcd_barrier(const XcdBarrier& b) {
    asm volatile("s_waitcnt vmcnt(0)" ::: "memory");
    __syncthreads();
    if (threadIdx.x == 0) {
        unsigned* bar = b.bar;
        __builtin_amdgcn_s_waitcnt(0);
        unsigned nloc = b.st[0], nx = b.st[1];
        if (nloc == 0u) { xcd_barrier_complete(bar, b.x, nloc, nx); b.st[0] = nloc; b.st[1] = nx; }
        const unsigned old = xb_add(&bar[XB_XSUB(b.x)], 1u);
        const unsigned gen = old / nloc;
        if (old + 1u == (gen + 1u) * nloc) {
            __builtin_amdgcn_fence(__ATOMIC_RELEASE, "agent");
            asm volatile("s_waitcnt vmcnt(0)" ::: "memory");
            const unsigned og = xb_add(&bar[XB_TOP], 1u);
            const unsigned tg = og / nx;
            if (og + 1u == (tg + 1u) * nx) xb_add(&bar[XB_TOPGEN], 1u);
            else XB_SPIN(xb_ld(&bar[XB_TOPGEN]) == tg, bar);
            __builtin_amdgcn_fence(__ATOMIC_ACQUIRE, "agent");
            xb_add(&bar[XB_XGEN(b.x)], 1u);
            asm volatile("s_waitcnt vmcnt(0)" ::: "memory");
        } else {
            XB_SPIN(xb_ld(&bar[XB_XGEN(b.x)]) == gen, bar);
            __builtin_amdgcn_fence(__ATOMIC_ACQUIRE, "agent");
            asm volatile("s_waitcnt vmcnt(0)" ::: "memory");
        }
    }
    __syncthreads();
}

__global__ void __launch_bounds__(512, 2) hybrid_fwd(Params P) {
    extern __shared__ __attribute__((aligned(16))) unsigned char lds_raw[];
    LAS unsigned char* lds = (LAS unsigned char*)lds_raw;
    const int G = gridDim.x;
    volatile LAS unsigned* xst = (volatile LAS unsigned*)(lds + 131072 + 256);
    if (threadIdx.x < 2) xst[threadIdx.x] = 0u;
    __syncthreads();
    XcdBarrier xbar = xcd_barrier_post((unsigned*)(P.ws + WS_CTL), xst);
    int ph = P.ph_lo, rep = 0;
    while (ph < P.ph_hi) {
        int tid = threadIdx.x; asm volatile("" : "+v"(tid));
        int wg = blockIdx.x; asm volatile("" : "+s"(wg));
        const Params& Q = P;
        const int lane = tid & 63, wid = __builtin_amdgcn_readfirstlane(tid >> 6), gw = wg * 8 + wid, ngw = G * 8;
        unsigned char* ws = Q.ws;
        bf16_t* Xb = (bf16_t*)(ws + WS_XB); bf16_t* R1 = (bf16_t*)(ws + WS_R1); bf16_t* MIX = (bf16_t*)(ws + WS_MIX);
        float* GATES = (float*)(ws + WS_GATES); float* SSP = (float*)(ws + WS_SSP);
        int nrep = 1;
        if (ph == 0) nrep = REP_PRO; else if (ph != NPHASE - 1) { const int q_ = (ph - 1) % 11; if (q_ == 1) nrep = REP_MIX; else if (q_ == 7) nrep = REP_ATT; else if (q_ == 0 || q_ == 4 || q_ == 6 || q_ == 9) nrep = REP_PROJ; }
        if (ph == 0) phase_prologue(Q, lds, gw, ngw, wid, lane);
        else if (ph == NPHASE - 1) phase_final(Q, gw, ngw, lane);
        else {
            int layer, sub;
            { const int r_ = ph - 1, pair_ = r_ / 11, q_ = r_ % 11; if (q_ < 6) { layer = 2 * pair_; sub = (q_ < 2) ? q_ : (q_ == 2 ? 5 : q_ - 1); } else { layer = 2 * pair_ + 1; sub = q_ - 6; } }
            const int li = layer >> 1, odd = layer & 1;
            if (sub == 5) phase_fixup(Q, li, gw, ngw, lane);
            else if (sub == 1) {
                if (!odd) {
                    if (G == 256) {
                        if (wg < 128) delta_unit(Q, lds, li, false, wg >> 4, (wg >> 1) & 7, wg & 1, tid);
                        else if (wg < 192) { const int u = wg - 128; gla_unit(Q, lds, li, false, u >> 3, u & 7, tid); }
                        else { const int u = wg - 192; delta_unit(Q, lds, li, true, u >> 3, u & 7, 0, tid); delta_unit(Q, lds, li, true, u >> 3, u & 7, 1, tid); gla_unit(Q, lds, li, true, u >> 3, u & 7, tid);
                            if (layer == 0 && rep == 0) convert_mats(Q, lds, 1, 16, (wg - 192) * 8 + wid, 512, wid, lane); }
                    }
                } else {
                    attn_build_bias(Q, lds, li, (wg >> 1) & 15, tid);
                    for (int u = wg * 8; u < wg * 8 + 8; ++u) attn_prompt_unit(Q, lds, li, u >> 8, (u >> 4) & 15, u & 15, tid);
                    if (wg < 128) attn_sample_unit(Q, lds, li, wg >> 4, wg & 15, tid);
                }
            } else {
                pg8::Gemm g; int mode, Npos;
                g.M = TP;
                LAS unsigned long long* eap = (LAS unsigned long long*)(lds + EA_OFF);
#define EA_SET(i, p) eap[i] = (unsigned long long)(p)
                if (sub == 0) {
                    g.A = Xb; g.K = 1024;
                    if (!odd) { mode = 0; Npos = ABPAD; g.Bt = (const bf16_t*)(ws + WS_WIN + li * SZ_WIN);
                        if (tid == 0) { EA_SET(0, R1); EA_SET(1, SSP); EA_SET(2, GATES); EA_SET(3, Q.out + O_CONVP + (size_t)li * 8 * 3 * DNQKV); EA_SET(4, Q.out + O_CONVS + (size_t)li * 8 * 3 * DNQKV); } }
                    else { mode = 1; Npos = NQKV; g.Bt = (const bf16_t*)(ws + WS_WQKV + li * SZ_WQKV);
                        if (tid == 0) { EA_SET(0, R1); EA_SET(1, SSP); EA_SET(3, Q.out + O_CKP + (size_t)li * 8 * 512 * 1024); EA_SET(4, Q.out + O_CVP + (size_t)li * 8 * 512 * 1024); EA_SET(5, Q.out + O_CKS + (size_t)li * 8 * 16 * 1024); EA_SET(6, Q.out + O_CVS + (size_t)li * 8 * 16 * 1024); } }
                } else if (sub == 2) {
                    mode = 2; Npos = 1024; g.A = MIX; g.K = 1024; g.Bt = (const bf16_t*)(ws + (odd ? WS_WCOUT : WS_WOUT) + li * SZ_W1K);
                    if (tid == 0) { EA_SET(7, (layer == 0) ? Q.in[0] : Q.out); EA_SET(8, (layer == 0) ? Q.in[1] : Q.out + (size_t)TP * DM); EA_SET(9, Q.out); EA_SET(10, Xb); EA_SET(11, SSP); }
                } else if (sub == 3) {
                    mode = 3; Npos = NGU; g.A = Xb; g.K = 1024; g.Bt = (const bf16_t*)(ws + WS_WGU + layer * SZ_WGU);
                    if (tid == 0) { EA_SET(0, R1); EA_SET(1, SSP); }
                } else {
                    mode = 2; Npos = 1024; g.A = R1; g.K = DFF; g.Bt = (const bf16_t*)(ws + WS_WDN + layer * SZ_WDN);
                    if (tid == 0) { EA_SET(7, Q.out); EA_SET(8, Q.out + (size_t)TP * DM); EA_SET(9, Q.out); EA_SET(10, Xb); EA_SET(11, SSP); }
                }
#undef EA_SET
                g.N = Npos;
                __syncthreads();
                pg8::StaticOrder S; S.init(TP, Npos, G, wg);
                if (mode == 0) { small_gemm<0>(g.A, g.Bt, Npos, g.K, eap, lds, wg, G, wid, lane); Epi<0> E{eap}; pg8::gemm_phase<Epi<0>, true, true>(lds, g, S, E, tid); }
                else if (mode == 1) { small_gemm<1>(g.A, g.Bt, Npos, g.K, eap, lds, wg, G, wid, lane); Epi<1> E{eap}; pg8::gemm_phase<Epi<1>, true, true>(lds, g, S, E, tid); }
                else if (mode == 2) { small_gemm<2>(g.A, g.Bt, Npos, g.K, eap, lds, wg, G, wid, lane); Epi<2> E{eap}; pg8::gemm_phase<Epi<2>, true, true>(lds, g, S, E, tid); }
                else { small_gemm<3>(g.A, g.Bt, Npos, g.K, eap, lds, wg, G, wid, lane); Epi<3> E{eap}; pg8::gemm_phase<Epi<3>, true, true>(lds, g, S, E, tid); }
            }
        }
        if (++rep >= nrep) { rep = 0; ++ph; }
        if (ph < P.ph_hi) { if (ph == 1 && rep == 0) cg::this_grid().sync(); else xcd_barrier(xbar); }
    }
}

extern "C" void kernel_launch(void* const* d_in, const int* in_sizes, int n_in, void* d_out, int out_size, void* d_ws, size_t ws_size, hipStream_t stream) {
    static int grid = 0;
    if (grid == 0) {
        if (n_in != 25 || (size_t)out_size != O_END || ws_size < WS_END) { fprintf(stderr, "kernel_launch: unexpected sizes n_in %d out %d ws %zu (need %zu)\n", n_in, out_size, ws_size, (size_t)WS_END); grid = -1; return; }
        if (hipFuncSetAttribute((const void*)hybrid_fwd, hipFuncAttributeMaxDynamicSharedMemorySize, LDS_BYTES) != hipSuccess) { fprintf(stderr, "kernel_launch: hipFuncSetAttribute failed\n"); grid = -1; return; }
        int dev = 0, cus = 0, per_cu = 0;
        hipGetDevice(&dev); hipDeviceGetAttribute(&cus, hipDeviceAttributeMultiprocessorCount, dev);
        hipOccupancyMaxActiveBlocksPerMultiprocessor(&per_cu, (const void*)hybrid_fwd, 512, LDS_BYTES);
        (void)hipGetLastError();
        if (cus != 256 || per_cu < 1) fprintf(stderr, "kernel_launch: note: cus %d per_cu %d\n", cus, per_cu);
        grid = 256;
    }
    if (grid < 0) return;
    Params p{};
    for (int i = 0; i < 25; ++i) p.in[i] = (const float*)d_in[i];
    p.out = (float*)d_out; p.ws = (unsigned char*)d_ws;
#if MK_MULTI
    for (int ph = 0; ph < NPHASE; ++ph) { p.ph_lo = ph; p.ph_hi = ph + 1; hipLaunchKernelGGL(hybrid_fwd, dim3(grid), dim3(512), LDS_BYTES, stream, p); }
#else
    (void)hipMemsetAsync((char*)d_ws + WS_CTL, 0, CTL_BYTES, stream);
    p.ph_lo = 0; p.ph_hi = NPHASE;
    void* args[] = {&p};
    hipError_t e = hipLaunchCooperativeKernel((const void*)hybrid_fwd, dim3(grid), dim3(512), args, LDS_BYTES, stream);
    if (e != hipSuccess) fprintf(stderr, "cooperative launch failed: %s\n", hipGetErrorString(e));
#endif
}
```
